# Optimizing an MI355X kernel written in HIP

```python
import math
import jax, jax.numpy as jnp
from jax import lax
import numpy as np

D_MODEL = 1024
BATCH = 8
SEQ = 8192
DEPTH = 4

N_MEM = 256
EPS = 1e-6
SEQ_WIDTH = 2 * D_MODEL
XA_HEADS = 4
XA_HEAD_DIM = D_MODEL // XA_HEADS
XA_WIDTH = XA_HEADS * XA_HEAD_DIM
MIX_WIDTH = SEQ_WIDTH + XA_WIDTH
GLA_HEADS = 4
GLA_DK = (D_MODEL // 2) // GLA_HEADS
GLA_DV = SEQ_WIDTH // GLA_HEADS
GLA_RANK = 16
GLA_TAU = 16.0
GLA_CHUNK = 64
S5_GROUP = 16
S5_GROUPS = SEQ_WIDTH // S5_GROUP
S5_STATE = 64
S5_CHUNK = 128
S5_DT_MIN = 1e-3
S5_DT_MAX = 1e-1
GLA_IN = 2 * GLA_HEADS * GLA_DK + SEQ_WIDTH + GLA_RANK + MIX_WIDTH + XA_WIDTH
S5_IN = SEQ_WIDTH + MIX_WIDTH + XA_WIDTH
N_GLA = (DEPTH + 1) // 2
N_S5 = DEPTH // 2

kernel_name = "hybrid_gla_s5_memxattn_trunk"


def rms_norm(x, w):
    xf = x.astype(jnp.float32)
    y = xf * lax.rsqrt(jnp.mean(xf * xf, axis=-1, keepdims=True) + EPS)
    return (y * w.astype(jnp.float32)).astype(x.dtype)


def split_cols(t, sizes):
    idx = np.cumsum(sizes)[:-1].tolist()
    return jnp.split(t, idx, axis=-1)


def memory_attention(q, mem_n, w_kv):
    b_, l_, _ = q.shape
    k, v = jnp.split(mem_n @ w_kv, 2, axis=-1)
    qh = q.reshape(b_, l_, XA_HEADS, XA_HEAD_DIM)
    kh = k.reshape(b_, -1, XA_HEADS, XA_HEAD_DIM)
    vh = v.reshape(b_, -1, XA_HEADS, XA_HEAD_DIM)
    s = jnp.einsum('blhd,bmhd->bhlm', qh, kh).astype(jnp.float32) * (XA_HEAD_DIM ** -0.5)
    p = jax.nn.softmax(s, axis=-1).astype(v.dtype)
    o = jnp.einsum('bhlm,bmhd->blhd', p, vh)
    return o.reshape(b_, l_, XA_WIDTH)


def gla_chunked(q, k, v, g):
    b_, l_, h_, dk = q.shape
    dv = v.shape[-1]
    nc = l_ // GLA_CHUNK

    def to_chunks(t):
        return t.reshape(b_, nc, GLA_CHUNK, h_, t.shape[-1]).transpose(1, 0, 3, 2, 4)

    qc, kc, vc, gc = to_chunks(q), to_chunks(k), to_chunks(v), to_chunks(g)
    causal = jnp.tril(jnp.ones((GLA_CHUNK, GLA_CHUNK), dtype=bool))

    def step(state, inp):
        qi, ki, vi, gi = inp
        qf, kf, vf = qi.astype(jnp.float32), ki.astype(jnp.float32), vi.astype(jnp.float32)
        bcum = jnp.cumsum(gi.astype(jnp.float32), axis=-2)
        b_last = bcum[..., -1:, :]
        q_dec = qf * jnp.exp(bcum)
        k_inv = kf * jnp.exp(-bcum)
        k_end = kf * jnp.exp(b_last - bcum)
        att = jnp.where(causal, jnp.einsum('bhcd,bhsd->bhcs', q_dec, k_inv), 0.0)
        o = jnp.einsum('bhcs,bhse->bhce', att, vf) + jnp.einsum('bhcd,bhde->bhce', q_dec, state)
        state = jnp.exp(b_last[..., 0, :])[..., None] * state + jnp.einsum('bhcd,bhce->bhde', k_end, vf)
        return state, o.astype(v.dtype)

    s0 = jnp.zeros((b_, h_, dk, dv), jnp.float32)
    _, o = lax.scan(step, s0, (qc, kc, vc, gc))
    return o.transpose(1, 0, 3, 2, 4).reshape(b_, l_, h_, dv)


def gla_branch(h, w_in, w_gate_up, gate_bias, out_norm_w):
    b_, l_, _ = h.shape
    qk = GLA_HEADS * GLA_DK
    q, k, v, r, z, xq = split_cols(h @ w_in, [qk, qk, SEQ_WIDTH, GLA_RANK, MIX_WIDTH, XA_WIDTH])
    g = jax.nn.log_sigmoid((r @ w_gate_up + gate_bias).astype(jnp.float32)) / GLA_TAU
    o = gla_chunked(q.reshape(b_, l_, GLA_HEADS, GLA_DK) * (GLA_DK ** -0.5),
                    k.reshape(b_, l_, GLA_HEADS, GLA_DK),
                    v.reshape(b_, l_, GLA_HEADS, GLA_DV),
                    g.reshape(b_, l_, GLA_HEADS, GLA_DK))
    o = rms_norm(o, out_norm_w).reshape(b_, l_, SEQ_WIDTH)
    return o.astype(h.dtype), z, xq


def s5_discretize(lam_re, lam_im, log_step, b_re, b_im):
    lam_re = lam_re.astype(jnp.float32)
    lam_im = lam_im.astype(jnp.float32)
    dt = jnp.exp(log_step.astype(jnp.float32))[:, None]
    mag = jnp.exp(lam_re * dt)
    ab_re = mag * jnp.cos(lam_im * dt)
    ab_im = mag * jnp.sin(lam_im * dt)
    den = lam_re * lam_re + lam_im * lam_im
    nr, ni = ab_re - 1.0, ab_im
    coef_re = ((nr * lam_re + ni * lam_im) / den)[..., None]
    coef_im = ((ni * lam_re - nr * lam_im) / den)[..., None]
    br, bi = b_re.astype(jnp.float32), b_im.astype(jnp.float32)
    bb_re = coef_re * br - coef_im * bi
    bb_im = coef_re * bi + coef_im * br
    return ab_re, ab_im, bb_re, bb_im


def _linrec_combine(e1, e2):
    a1r, a1i, x1r, x1i = e1
    a2r, a2i, x2r, x2i = e2
    return (a1r * a2r - a1i * a2i,
            a1r * a2i + a1i * a2r,
            a2r * x1r - a2i * x1i + x2r,
            a2r * x1i + a2i * x1r + x2i)


def s5_chunked(u, ab_re, ab_im, bb_re, bb_im, c_re, c_im):
    b_, l_, g_, hg = u.shape
    nc = l_ // S5_CHUNK
    uc = u.reshape(b_, nc, S5_CHUNK, g_, hg).transpose(1, 0, 2, 3, 4)

    def step(carry, u_i):
        cr, ci = carry
        bu_re = jnp.einsum('bcgh,gph->bcgp', u_i, bb_re)
        bu_im = jnp.einsum('bcgh,gph->bcgp', u_i, bb_im)
        a_r = jnp.broadcast_to(ab_re, bu_re.shape)
        a_i = jnp.broadcast_to(ab_im, bu_im.shape)
        acum_r, acum_i, x_r, x_i = lax.associative_scan(_linrec_combine, (a_r, a_i, bu_re, bu_im), axis=1)
        x_r = x_r + acum_r * cr[:, None] - acum_i * ci[:, None]
        x_i = x_i + acum_r * ci[:, None] + acum_i * cr[:, None]
        y = jnp.einsum('bcgp,ghp->bcgh', x_r, c_re) - jnp.einsum('bcgp,ghp->bcgh', x_i, c_im)
        return (x_r[:, -1], x_i[:, -1]), y

    zeros = jnp.zeros((b_, g_, S5_STATE), jnp.float32)
    _, y = lax.scan(step, (zeros, zeros), uc)
    return y.transpose(1, 0, 2, 3, 4).reshape(b_, l_, g_, hg)


def s5_branch(h, w_in, lam_re, lam_im, log_step, b_re, b_im, c_re, c_im, d, w_glu, b_glu):
    b_, l_, _ = h.shape
    u, z, xq = split_cols(h @ w_in, [SEQ_WIDTH, MIX_WIDTH, XA_WIDTH])
    ab_re, ab_im, bb_re, bb_im = s5_discretize(lam_re, lam_im, log_step, b_re, b_im)
    uf = u.astype(jnp.float32)
    y = s5_chunked(uf.reshape(b_, l_, S5_GROUPS, S5_GROUP), ab_re, ab_im, bb_re, bb_im,
                   c_re.astype(jnp.float32), c_im.astype(jnp.float32))
    y = y.reshape(b_, l_, SEQ_WIDTH) + d.astype(jnp.float32) * uf
    y = jax.nn.gelu(y).astype(h.dtype)
    y = y * jax.nn.sigmoid(y @ w_glu + b_glu)
    return y, z, xq


def setup_inputs(seed: int = 0) -> dict:
    key = jax.random.key(seed)
    ks = jax.random.split(key, 24)
    nrm = jax.random.normal
    inv = lambda n: 1.0 / math.sqrt(n)
    n_idx = jnp.arange(S5_STATE, dtype=jnp.float32)
    lam_re = -0.5 * jnp.exp(0.02 * nrm(ks[8], (N_S5, S5_GROUPS, S5_STATE), jnp.float32))
    lam_im = jnp.broadcast_to(math.pi * n_idx, (N_S5, S5_GROUPS, S5_STATE)).astype(jnp.float32)
    log_step = jax.random.uniform(ks[9], (N_S5, S5_GROUPS), jnp.float32,
                                  math.log(S5_DT_MIN), math.log(S5_DT_MAX))
    return {
        "x": nrm(ks[0], (BATCH, SEQ, D_MODEL), jnp.float32),
        "mem": nrm(ks[1], (BATCH, N_MEM, D_MODEL), jnp.float32),
        "norm_w": 1.0 + 0.02 * nrm(ks[2], (DEPTH, D_MODEL), jnp.float32),
        "mem_norm_w": 1.0 + 0.02 * nrm(ks[3], (D_MODEL,), jnp.float32),
        "gla_w_in": nrm(ks[4], (N_GLA, D_MODEL, GLA_IN), jnp.float32) * inv(D_MODEL),
        "gla_w_gate_up": nrm(ks[5], (N_GLA, GLA_RANK, GLA_HEADS * GLA_DK), jnp.float32) * inv(GLA_RANK),
        "gla_gate_bias": 0.1 * nrm(ks[6], (N_GLA, GLA_HEADS * GLA_DK), jnp.float32),
        "gla_out_norm_w": 1.0 + 0.02 * nrm(ks[7], (N_GLA, GLA_DV), jnp.float32),
        "s5_w_in": nrm(ks[10], (N_S5, D_MODEL, S5_IN), jnp.float32) * inv(D_MODEL),
        "s5_lam_re": lam_re,
        "s5_lam_im": lam_im,
        "s5_log_step": log_step,
        "s5_b_re": nrm(ks[11], (N_S5, S5_GROUPS, S5_STATE, S5_GROUP), jnp.float32) * inv(2 * S5_GROUP),
        "s5_b_im": nrm(ks[12], (N_S5, S5_GROUPS, S5_STATE, S5_GROUP), jnp.float32) * inv(2 * S5_GROUP),
        "s5_c_re": 0.5 * nrm(ks[13], (N_S5, S5_GROUPS, S5_GROUP, S5_STATE), jnp.float32),
        "s5_c_im": 0.5 * nrm(ks[14], (N_S5, S5_GROUPS, S5_GROUP, S5_STATE), jnp.float32),
        "s5_d": nrm(ks[15], (N_S5, SEQ_WIDTH), jnp.float32),
        "s5_w_glu": nrm(ks[16], (N_S5, SEQ_WIDTH, SEQ_WIDTH), jnp.float32) * inv(SEQ_WIDTH),
        "s5_b_glu": 0.01 * nrm(ks[17], (N_S5, SEQ_WIDTH), jnp.float32),
        "xa_w_kv": nrm(ks[18], (DEPTH, D_MODEL, 2 * XA_WIDTH), jnp.float32) * inv(D_MODEL),
        "w_out": nrm(ks[19], (DEPTH, MIX_WIDTH, D_MODEL), jnp.float32) * inv(MIX_WIDTH),
        "final_norm_w": 1.0 + 0.02 * nrm(ks[20], (D_MODEL,), jnp.float32),
    }


def reference(x, mem, norm_w, mem_norm_w, gla_w_in, gla_w_gate_up, gla_gate_bias, gla_out_norm_w,
              s5_w_in, s5_lam_re, s5_lam_im, s5_log_step, s5_b_re, s5_b_im, s5_c_re, s5_c_im,
              s5_d, s5_w_glu, s5_b_glu, xa_w_kv, w_out, final_norm_w):
    mem_n = rms_norm(mem, mem_norm_w)
    for i in range(DEPTH):
        h = rms_norm(x, norm_w[i])
        j = i // 2
        if i % 2 == 0:
            seq_out, z, xq = gla_branch(h, gla_w_in[j], gla_w_gate_up[j], gla_gate_bias[j], gla_out_norm_w[j])
        else:
            seq_out, z, xq = s5_branch(h, s5_w_in[j], s5_lam_re[j], s5_lam_im[j], s5_log_step[j],
                                       s5_b_re[j], s5_b_im[j], s5_c_re[j], s5_c_im[j],
                                       s5_d[j], s5_w_glu[j], s5_b_glu[j])
        xa = memory_attention(xq, mem_n, xa_w_kv[i])
        y = jnp.concatenate([seq_out.astype(x.dtype), xa.astype(x.dtype)], axis=-1) * jax.nn.silu(z)
        x = x + y @ w_out[i]
    return rms_norm(x, final_norm_w)
```

```cpp
#include <hip/hip_runtime.h>
#include <hip/hip_cooperative_groups.h>
#include <cstdio>
#include <cstdint>
namespace cg = cooperative_groups;

#ifndef MK_COOP
#define MK_COOP 1
#endif
#ifndef PROBE_DUP
#define PROBE_DUP 0
#endif
#ifndef PROBE_ABL
#define PROBE_ABL 0
#endif

#define LAS __attribute__((address_space(3)))
typedef unsigned short bf16_t;
typedef short bf16x8 __attribute__((ext_vector_type(8)));
typedef float f32x4 __attribute__((ext_vector_type(4)));
typedef float f32x2 __attribute__((ext_vector_type(2)));
typedef unsigned u32x4 __attribute__((ext_vector_type(4)));
typedef unsigned u32x2 __attribute__((ext_vector_type(2)));

constexpr int T_TOK = 65536;
constexpr int SEQ_L = 8192;
constexpr int DM = 1024;
constexpr int GLA_IN_W = 7184, S5_IN_W = 6144;
constexpr float EPSN = 1e-6f;
constexpr float L2E = 1.4426950408889634f;

constexpr size_t MiB = 1024ull * 1024ull;
constexpr size_t WS_H = 0;
constexpr size_t WS_QK = 128 * MiB;
constexpr size_t WS_G = 256 * MiB;
constexpr size_t WS_MIX = 384 * MiB;
constexpr size_t WS_KMEM = 768 * MiB;
constexpr size_t WS_VT = 784 * MiB;
constexpr size_t WS_MEMN = 800 * MiB;
constexpr size_t WS_SUMSQ = 804 * MiB;
constexpr size_t WS_CTL = 806 * MiB;
constexpr size_t WS_WT = 807 * MiB;
constexpr size_t WT_GLA_PER = (size_t)(4608 + 3072) * 1024;
constexpr size_t WT_GLA_A2 = (size_t)4608 * 1024;
constexpr size_t WT_S5_BASE = 2 * WT_GLA_PER;
constexpr size_t WT_S5_PER = (size_t)6144 * 1024 + (size_t)2048 * 2048;
constexpr size_t WT_S5_A2 = (size_t)3072 * 1024;
constexpr size_t WT_S5_GLU = (size_t)6144 * 1024;
constexpr size_t WT_OUT_BASE = WT_S5_BASE + 2 * WT_S5_PER;
constexpr size_t WT_OUT_PER = (size_t)1024 * 3072;
constexpr size_t WT_K_BASE = WT_OUT_BASE + 4 * WT_OUT_PER;
constexpr size_t WT_V_BASE = WT_K_BASE + (size_t)4096 * 1024;
constexpr size_t WT_TOTAL = WT_V_BASE + (size_t)4096 * 1024;
constexpr size_t WS_END = WS_WT + WT_TOTAL * 2;
constexpr size_t WS_PART = 920 * MiB;
static_assert(WS_END <= WS_PART && WS_PART + (size_t)T_TOK * 64 * 4 <= 1024 * MiB, "workspace map");

constexpr int LDS_BYTES = 144 * 1024;
constexpr int NTHREADS = 512;

struct Params {
    const float* in[22];
    float* out;
    unsigned char* ws;
    int ph_lo, ph_hi;
};

typedef __bf16 bf16x2_t __attribute__((ext_vector_type(2)));
__device__ __forceinline__ unsigned pk2(float lo, float hi) { f32x2 v = {lo, hi}; bf16x2_t b = __builtin_convertvector(v, bf16x2_t); return __builtin_bit_cast(unsigned, b); }
__device__ __forceinline__ bf16_t bf1(float v) { return (bf16_t)(pk2(v, 0.f) & 0xffffu); }
__device__ __forceinline__ float bflo(unsigned u) { return __uint_as_float(u << 16); }
__device__ __forceinline__ float bfhi(unsigned u) { return __uint_as_float(u & 0xffff0000u); }
__device__ __forceinline__ float wave_sum(float v) {
#pragma unroll
    for (int o = 1; o < 64; o <<= 1) v += __shfl_xor(v, o);
    return v;
}
__device__ __forceinline__ float fexp(float x) { return __builtin_amdgcn_exp2f(x * L2E); }
__device__ __forceinline__ float frcp(float x) { return __builtin_amdgcn_rcpf(x); }
__device__ __forceinline__ float fsigmoid(float x) { return frcp(1.f + fexp(-x)); }
__device__ __forceinline__ void wave_sync() { asm volatile("s_waitcnt lgkmcnt(0)" ::: "memory"); __builtin_amdgcn_wave_barrier(); }
#define LDS_BAR() do { asm volatile("s_waitcnt lgkmcnt(0)" ::: "memory"); __builtin_amdgcn_s_barrier(); asm volatile("" ::: "memory"); } while (0)
__device__ __forceinline__ void st_global_b64(void* ptr, u32x2 v) { asm volatile("global_store_dwordx2 %0, %1, off" :: "v"(ptr), "v"(v) : "memory"); }
__device__ __forceinline__ void st_global_b128(void* ptr, u32x4 v) { asm volatile("global_store_dwordx4 %0, %1, off\n\ts_nop 1" :: "v"(ptr), "v"(v) : "memory"); }
__device__ __forceinline__ void st_global_f128(void* ptr, f32x4 v) { asm volatile("global_store_dwordx4 %0, %1, off\n\ts_nop 1" :: "v"(ptr), "v"(v) : "memory"); }
__device__ __forceinline__ float fma_s(float a, float b, float c) { float d; asm("v_fma_f32 %0, %1, %2, %3" : "=v"(d) : "v"(a), "v"(b), "v"(c)); return d; }
__device__ __forceinline__ void st_global_b32(void* ptr, float v) { asm volatile("global_store_dword %0, %1, off" :: "v"(ptr), "v"(v) : "memory"); }
__device__ __forceinline__ void atomic_add_u64_noret(unsigned long long* ptr, unsigned long long v) { asm volatile("global_atomic_add_x2 %0, %1, off" :: "v"(ptr), "v"(v) : "memory"); }
#define MFMA16(a, b, c) __builtin_amdgcn_mfma_f32_16x16x32_bf16((a), (b), (c), 0, 0, 0)

namespace pg8 {
constexpr int BM = 256, BK = 64, HALF = 128, HTB = HALF * BK * 2, STAGE_BYTES = 8 * HTB, NXCD = 8, WGM = 8;
__device__ __forceinline__ int lds_byte(int r, int c) { const int st = (r >> 4) * 2 + (c >> 5), rr = r & 15, cc = c & 31, ob = rr * 64 + cc * 2; return st * 1024 + (ob ^ (((ob >> 9) & 1) << 5)); }
__device__ __forceinline__ void stage_rc(int b, int& R, int& C) { const int st = b / 1024, sb = b % 1024, swz = sb ^ (((sb >> 9) & 1) << 5); R = (st >> 1) * 16 + swz / 64; C = (st & 1) * 32 + (swz % 64) / 2; }
__device__ __forceinline__ int perm32(int rho) { const int n = rho >> 4, i = rho & 15; return 8 * (i >> 2) + 4 * n + (i & 3); }
struct Unit { int pm, pn; };
struct Gemm { const bf16_t* A; const bf16_t* Bt; int M, N, K; };
struct StaticOrder {
    int nM, nN, nwg, G, c;
    __device__ void init(int M, int N, int G_, int c_) { nM = M / BM; nN = N / BM; nwg = nM * nN; G = G_; c = c_; }
    __device__ bool next(int i, Unit& u) const {
        const long L = (long)i * G + c; if (L >= nwg) return false;
        int wgid = (int)L; { const int q = nwg / NXCD, r = nwg % NXCD, xcd = wgid % NXCD, off = wgid / NXCD; wgid = (xcd < r ? xcd * (q + 1) : r * (q + 1) + (xcd - r) * q) + off; }
        const int nig = WGM * nN, gid = wgid / nig, fm = gid * WGM, gsz = (nM - fm) < WGM ? (nM - fm) : WGM;
        u.pm = fm + ((wgid % nig) % gsz); u.pn = (wgid % nig) / gsz; return true;
    }
};

enum { EM_BF16 = 0, EM_A1GLA = 1, EM_GATE = 2, EM_GLU = 3, EM_RESID = 4 };
struct Epi {
    int mode;
    bf16_t* o0; int ld0;
    bf16_t* qk; float* g; const float* gbias; bf16_t* mix;
    const float* part; const float* onw; int is_gla;
    const bf16_t* y5; const float* bglu;
    const float* xin; float* xout;
    __device__ __forceinline__ void operator()(const f32x4 (&acc)[2][2][4][2], const Unit& u, int wr, int wc, int fr, int fq) const {
        const int row0 = u.pm * BM + wr * 64 + fr;
        const int cb = u.pn * BM + wc * 32 + 8 * fq;
#define EPI_ROW(it) ((size_t)(row0 + ((it) >> 3) * HALF + (((it) >> 1) & 3) * 16))
#define EPI_COL(it) (cb + ((it) & 1) * HALF)
#define EPI_V0(it) acc[(it) >> 3][(it) & 1][((it) >> 1) & 3][0]
#define EPI_V1(it) acc[(it) >> 3][(it) & 1][((it) >> 1) & 3][1]
        if (mode == EM_BF16) {
#pragma unroll
            for (int it = 0; it < 16; ++it) { const f32x4 v0 = EPI_V0(it), v1 = EPI_V1(it);
                u32x4 o; o.x = pk2(v0[0], v0[1]); o.y = pk2(v0[2], v0[3]); o.z = pk2(v1[0], v1[1]); o.w = pk2(v1[2], v1[3]);
                *(u32x4*)(o0 + EPI_ROW(it) * ld0 + EPI_COL(it)) = o; }
        } else if (mode == EM_A1GLA) {
            if (u.pn < 4) {
                const float sc = (u.pn < 2) ? 0.08838834764831845f : 1.f;
#pragma unroll
                for (int it = 0; it < 16; ++it) { const f32x4 v0 = EPI_V0(it), v1 = EPI_V1(it);
                    u32x4 o; o.x = pk2(v0[0] * sc, v0[1] * sc); o.y = pk2(v0[2] * sc, v0[3] * sc); o.z = pk2(v1[0] * sc, v1[1] * sc); o.w = pk2(v1[2] * sc, v1[3] * sc);
                    *(u32x4*)(qk + EPI_ROW(it) * 1024 + EPI_COL(it)) = o; }
            } else if (u.pn < 6) {
                f32x4 bia[2][2];
#pragma unroll
                for (int bj = 0; bj < 2; ++bj) { bia[bj][0] = *(const f32x4*)(gbias + cb + bj * HALF - 1024); bia[bj][1] = *(const f32x4*)(gbias + cb + bj * HALF - 1024 + 4); }
#pragma unroll
                for (int it = 0; it < 16; ++it) { const f32x4 v0 = EPI_V0(it), v1 = EPI_V1(it); const int gc = EPI_COL(it) - 1024;
                    f32x4 r0, r1;
#pragma unroll
                    for (int e = 0; e < 4; ++e) {
                        const float x0 = v0[e] + bia[it & 1][0][e], x1 = v1[e] + bia[it & 1][1][e];
                        r0[e] = (fminf(x0, 0.f) - __logf(1.f + fexp(-fabsf(x0)))) * 0.0625f;
                        r1[e] = (fminf(x1, 0.f) - __logf(1.f + fexp(-fabsf(x1)))) * 0.0625f;
                    }
                    *(f32x4*)(g + EPI_ROW(it) * 512 + gc) = r0; *(f32x4*)(g + EPI_ROW(it) * 512 + gc + 4) = r1; }
            } else {
#pragma unroll
                for (int it = 0; it < 16; ++it) { const f32x4 v0 = EPI_V0(it), v1 = EPI_V1(it);
                    u32x4 o; o.x = pk2(v0[0], v0[1]); o.y = pk2(v0[2], v0[3]); o.z = pk2(v1[0], v1[1]); o.w = pk2(v1[2], v1[3]);
                    *(u32x4*)(mix + EPI_ROW(it) * 3072 + (EPI_COL(it) - 1536)) = o; }
            }
        } else if (mode == EM_GATE) {
            const bool nrm = is_gla && (cb < 2048);
            float rs[8]; f32x4 wv[2][2];
#pragma unroll
            for (int i = 0; i < 8; ++i) rs[i] = 1.f;
#pragma unroll
            for (int bj = 0; bj < 2; ++bj) { wv[bj][0] = (f32x4){1.f, 1.f, 1.f, 1.f}; wv[bj][1] = (f32x4){1.f, 1.f, 1.f, 1.f}; }
            if (nrm) {
#pragma unroll
                for (int i = 0; i < 8; ++i) {
                    const f32x4* pp = (const f32x4*)(part + (EPI_ROW(2 * i) * 4 + (cb >> 9)) * 16);
                    const f32x4 p0 = pp[0], p1 = pp[1], p2 = pp[2], p3 = pp[3];
                    const float ssum = ((p0[0] + p0[1]) + (p0[2] + p0[3])) + ((p1[0] + p1[1]) + (p1[2] + p1[3])) + ((p2[0] + p2[1]) + (p2[2] + p2[3])) + ((p3[0] + p3[1]) + (p3[2] + p3[3]));
                    rs[i] = rsqrtf(ssum * (1.f / 512.f) + EPSN);
                }
#pragma unroll
                for (int bj = 0; bj < 2; ++bj) { wv[bj][0] = *(const f32x4*)(onw + ((cb + bj * HALF) & 511)); wv[bj][1] = *(const f32x4*)(onw + ((cb + bj * HALF) & 511) + 4); }
            }
#pragma unroll
            for (int hb = 0; hb < 4; ++hb) {
            u32x4 mva[4];
#pragma unroll
            for (int i = 0; i < 4; ++i) mva[i] = *(const u32x4*)(mix + EPI_ROW(hb * 4 + i) * 3072 + EPI_COL(hb * 4 + i));
#pragma unroll
            for (int i = 0; i < 4; ++i) { const int it = hb * 4 + i;
                const u32x4 mv = mva[i];
                const f32x4 v0 = EPI_V0(it), v1 = EPI_V1(it);
                const float f[8] = { bflo(mv.x), bfhi(mv.x), bflo(mv.y), bfhi(mv.y), bflo(mv.z), bfhi(mv.z), bflo(mv.w), bfhi(mv.w) };
                const float r = rs[it >> 1];
                float y[8];
#pragma unroll
                for (int e = 0; e < 4; ++e) { y[e] = f[e] * (r * wv[it & 1][0][e]) * v0[e] * fsigmoid(v0[e]); y[4 + e] = f[4 + e] * (r * wv[it & 1][1][e]) * v1[e] * fsigmoid(v1[e]); }
                u32x4 o; o.x = pk2(y[0], y[1]); o.y = pk2(y[2], y[3]); o.z = pk2(y[4], y[5]); o.w = pk2(y[6], y[7]);
                st_global_b128(mix + EPI_ROW(it) * 3072 + EPI_COL(it), o);
            }
            }
        } else if (mode == EM_GLU) {
            f32x4 bia[2][2];
#pragma unroll
            for (int bj = 0; bj < 2; ++bj) { bia[bj][0] = *(const f32x4*)(bglu + cb + bj * HALF); bia[bj][1] = *(const f32x4*)(bglu + cb + bj * HALF + 4); }
#pragma unroll
            for (int hb = 0; hb < 2; ++hb) {
            u32x4 mva[8];
#pragma unroll
            for (int i = 0; i < 8; ++i) mva[i] = *(const u32x4*)(y5 + EPI_ROW(hb * 8 + i) * 2048 + EPI_COL(hb * 8 + i));
#pragma unroll
            for (int i = 0; i < 8; ++i) { const int it = hb * 8 + i;
                const u32x4 mv = mva[i];
                const f32x4 v0 = EPI_V0(it), v1 = EPI_V1(it);
                const float f[8] = { bflo(mv.x), bfhi(mv.x), bflo(mv.y), bfhi(mv.y), bflo(mv.z), bfhi(mv.z), bflo(mv.w), bfhi(mv.w) };
                float y[8];
#pragma unroll
                for (int e = 0; e < 4; ++e) { y[e] = f[e] * fsigmoid(v0[e] + bia[it & 1][0][e]); y[4 + e] = f[4 + e] * fsigmoid(v1[e] + bia[it & 1][1][e]); }
                u32x4 o; o.x = pk2(y[0], y[1]); o.y = pk2(y[2], y[3]); o.z = pk2(y[4], y[5]); o.w = pk2(y[6], y[7]);
                st_global_b128(mix + EPI_ROW(it) * 3072 + EPI_COL(it), o);
            }
            }
        } else {
#pragma unroll
            for (int hb = 0; hb < 4; ++hb) {
                f32x4 xa[4][2];
#pragma unroll
                for (int i = 0; i < 4; ++i) { const int it = hb * 4 + i; xa[i][0] = *(const f32x4*)(xin + EPI_ROW(it) * 1024 + EPI_COL(it)); xa[i][1] = *(const f32x4*)(xin + EPI_ROW(it) * 1024 + EPI_COL(it) + 4); }
#pragma unroll
                for (int i = 0; i < 4; ++i) { const int it = hb * 4 + i;
                    st_global_f128(xout + EPI_ROW(it) * 1024 + EPI_COL(it), xa[i][0] + EPI_V0(it)); st_global_f128(xout + EPI_ROW(it) * 1024 + EPI_COL(it) + 4, xa[i][1] + EPI_V1(it)); }
            }
        }
#undef EPI_ROW
#undef EPI_COL
#undef EPI_V0
#undef EPI_V1
    }
};

__device__ __forceinline__ void gemm_phase(LAS unsigned char* lds, const Gemm g, const StaticOrder& S, const Epi& E) {
    int tid_ = threadIdx.x; asm volatile("" : "+v"(tid_));
    const int tid = tid_, wid = __builtin_amdgcn_readfirstlane(tid >> 6), lane = tid & 63, wr = wid >> 2, wc = wid & 3, fr = lane & 15, fq = lane >> 4;
    const int K = g.K, nt = K / BK;
    unsigned voffA[2], voffB[2];
#pragma unroll
    for (int i = 0; i < 2; ++i) { int R, C; stage_rc(tid * 16 + i * 8192, R, C); const int Rb = (R & ~31) + perm32(R & 31);
        voffA[i] = (unsigned)(R * K + C) * 2u; voffB[i] = (unsigned)(Rb * K + C) * 2u; }
    const size_t kstep = (size_t)(BK * 2);
    const size_t hstep = (size_t)HALF * K * 2;
    const size_t tstep = 2 * hstep;
    const unsigned ldsw = (unsigned)wid * 1024u;
    const int aoff = lds_byte(wr * 64 + fr, fq * 8), boff = lds_byte(wc * 32 + fr, fq * 8);
#define PG8_SA(b, h) (((b) * 2 + (h)) * HTB)
#define PG8_SB(b, h) ((4 + (b) * 2 + (h)) * HTB)
#define PG8_STAGE(bufoff, gbase, voff) do { _Pragma("unroll") for (int _i = 0; _i < 2; ++_i) \
        __builtin_amdgcn_global_load_lds((const unsigned*)((const char*)(gbase) + (voff)[_i]), (LAS unsigned*)(lds + (bufoff) + ldsw + _i * 8192), 16, 0, 0); } while (0)
#define PG8_LDA(dst, b, h) do { _Pragma("unroll") for (int m = 0; m < 4; ++m) _Pragma("unroll") for (int k = 0; k < 2; ++k) dst[m][k] = *(const LAS bf16x8*)(lds + PG8_SA(b, h) + aoff + m * 2048 + k * 1024); } while (0)
#define PG8_LDB(dst, b, h) do { _Pragma("unroll") for (int n = 0; n < 2; ++n) _Pragma("unroll") for (int k = 0; k < 2; ++k) dst[n][k] = *(const LAS bf16x8*)(lds + PG8_SB(b, h) + boff + n * 2048 + k * 1024); } while (0)
#define PG8_MMA(ai, bj, At, Bt) do { __builtin_amdgcn_s_setprio(1); _Pragma("unroll") for (int m = 0; m < 4; ++m) _Pragma("unroll") for (int n = 0; n < 2; ++n) _Pragma("unroll") for (int k = 0; k < 2; ++k) \
        acc[ai][bj][m][n] = __builtin_amdgcn_mfma_f32_16x16x32_bf16(Bt[n][k], At[m][k], acc[ai][bj][m][n], 0, 0, 0); __builtin_amdgcn_s_setprio(0); } while (0)
#define PG8_WAIT_V(n) asm volatile("s_waitcnt vmcnt(" #n ")" ::: "memory")
#define PG8_WAIT_L(n) asm volatile("s_waitcnt lgkmcnt(" #n ")" ::: "memory")
#define PG8_BAR __builtin_amdgcn_s_barrier()
#define PG8_SCHED __builtin_amdgcn_sched_barrier(0)
    Unit cur, nxt; int ui = 0;
    if (!S.next(0, cur)) return;
    f32x4 acc[2][2][4][2];
#pragma unroll
    for (int a = 0; a < 2; ++a)
#pragma unroll
        for (int b = 0; b < 2; ++b)
#pragma unroll
            for (int m = 0; m < 4; ++m)
#pragma unroll
                for (int n = 0; n < 2; ++n) acc[a][b][m][n] = (f32x4){0.f, 0.f, 0.f, 0.f};
    bf16x8 At[4][2], B0[2][2], B1[2][2];
    const char* cA = (const char*)g.A + (size_t)cur.pm * tstep; const char* cB = (const char*)g.Bt + (size_t)cur.pn * tstep;
    PG8_STAGE(PG8_SB(0, 0), cB, voffB); PG8_STAGE(PG8_SA(0, 0), cA, voffA); PG8_STAGE(PG8_SB(0, 1), cB + hstep, voffB); PG8_STAGE(PG8_SA(0, 1), cA + hstep, voffA);
    if (wr == 1) PG8_BAR;
    PG8_WAIT_V(4); PG8_BAR;
    PG8_STAGE(PG8_SB(1, 0), cB + kstep, voffB); PG8_STAGE(PG8_SA(1, 0), cA + kstep, voffA); PG8_STAGE(PG8_SB(1, 1), cB + hstep + kstep, voffB);
    PG8_WAIT_V(6); PG8_BAR;
    for (;;) {
        const bool has_next = S.next(ui + 1, nxt);
        const char* nA = has_next ? (const char*)g.A + (size_t)nxt.pm * tstep : cA; const char* nB = has_next ? (const char*)g.Bt + (size_t)nxt.pn * tstep : cB;
        for (int t = 0; t < nt; t += 2) {
            const bool last = (t == nt - 2);
            const char* a1 = cA + (size_t)(t + 1) * kstep;
            const char* a2 = last ? nA : cA + (size_t)(t + 2) * kstep; const char* b2 = last ? nB : cB + (size_t)(t + 2) * kstep;
            const char* a3 = a2 + kstep; const char* b3 = b2 + kstep;
            PG8_LDB(B0, 0, 0); PG8_SCHED; PG8_LDA(At, 0, 0); PG8_STAGE(PG8_SA(1, 1), a1 + hstep, voffA);
            PG8_WAIT_L(8); PG8_BAR; PG8_WAIT_L(0); PG8_MMA(0, 0, At, B0); PG8_BAR; PG8_SCHED;
            PG8_LDB(B1, 0, 1); PG8_STAGE(PG8_SB(0, 0), b2, voffB);
            PG8_BAR; PG8_WAIT_L(0); PG8_MMA(0, 1, At, B1); PG8_BAR;
            PG8_LDA(At, 0, 1); PG8_STAGE(PG8_SA(0, 0), a2, voffA);
            PG8_BAR; PG8_WAIT_L(0); PG8_MMA(1, 0, At, B0); PG8_BAR; PG8_SCHED;
            PG8_STAGE(PG8_SB(0, 1), b2 + hstep, voffB);
            PG8_WAIT_V(6); PG8_BAR; PG8_MMA(1, 1, At, B1); PG8_BAR;
            PG8_LDB(B0, 1, 0); PG8_SCHED; PG8_LDA(At, 1, 0); PG8_STAGE(PG8_SA(0, 1), a2 + hstep, voffA);
            PG8_WAIT_L(8); PG8_BAR; PG8_WAIT_L(0); PG8_MMA(0, 0, At, B0); PG8_BAR; PG8_SCHED;
            PG8_LDB(B1, 1, 1); PG8_STAGE(PG8_SB(1, 0), b3, voffB);
            PG8_BAR; PG8_WAIT_L(0); PG8_MMA(0, 1, At, B1); PG8_BAR;
            PG8_LDA(At, 1, 1); PG8_STAGE(PG8_SA(1, 0), a3, voffA);
            PG8_BAR; PG8_WAIT_L(0); PG8_MMA(1, 0, At, B0); PG8_BAR; PG8_SCHED;
            PG8_STAGE(PG8_SB(1, 1), b3 + hstep, voffB);
            PG8_WAIT_V(6); PG8_BAR; PG8_MMA(1, 1, At, B1); PG8_BAR;
        }
        E(acc, cur, wr, wc, fr, fq);
        if (!has_next) break;
#pragma unroll
        for (int a = 0; a < 2; ++a)
#pragma unroll
            for (int b = 0; b < 2; ++b)
#pragma unroll
                for (int m = 0; m < 4; ++m)
#pragma unroll
                    for (int n = 0; n < 2; ++n) acc[a][b][m][n] = (f32x4){0.f, 0.f, 0.f, 0.f};
        cur = nxt; cA = nA; cB = nB; ++ui;
    }
    PG8_WAIT_V(0);
    if (wr == 0) PG8_BAR;
    PG8_BAR;
#undef PG8_SA
#undef PG8_SB
#undef PG8_STAGE
#undef PG8_LDA
#undef PG8_LDB
#undef PG8_MMA
#undef PG8_WAIT_V
#undef PG8_WAIT_L
#undef PG8_BAR
#undef PG8_SCHED
}
}

struct TJob { const float* src; int ld, K, c0, nc; bf16_t* dst; };
constexpr int N_TITEMS = 13824;

__device__ __forceinline__ void rms_rows(const float* x, const float* w, bf16_t* out_bf, float* out_f, int nrows, bool grouped = false) {
    int tid_ = threadIdx.x; asm volatile("" : "+v"(tid_));
    const int lane = tid_ & 63, wave = tid_ >> 6;
    int gw = blockIdx.x * 8 + wave, ngw = gridDim.x * 8;
    if (grouped) {
        const int per = nrows >> 3, lw = (int)(blockIdx.x >> 3) * 8 + wave, nlw = (int)(gridDim.x >> 3) * 8;
        x += (size_t)(blockIdx.x & 7) * per * 1024;
        if (out_bf) out_bf += (size_t)(blockIdx.x & 7) * per * 1024;
        if (out_f) out_f += (size_t)(blockIdx.x & 7) * per * 1024;
        nrows = per; gw = lw; ngw = nlw;
    }
    f32x4 wv[4];
#pragma unroll
    for (int j = 0; j < 4; ++j) wv[j] = ((const f32x4*)w)[lane + 64 * j];
    f32x4 vn[4];
    if (gw < nrows) {
        const f32x4* xr = (const f32x4*)(x + (size_t)gw * 1024) + lane;
#pragma unroll
        for (int j = 0; j < 4; ++j) vn[j] = xr[64 * j];
    }
    for (int r = gw; r < nrows; r += ngw) {
        f32x4 v[4];
#pragma unroll
        for (int j = 0; j < 4; ++j) v[j] = vn[j];
        const int rn = (r + ngw < nrows) ? r + ngw : r;
        {
            const f32x4* xr = (const f32x4*)(x + (size_t)rn * 1024) + lane;
#pragma unroll
            for (int j = 0; j < 4; ++j) vn[j] = xr[64 * j];
        }
        float s = 0.f;
#pragma unroll
        for (int j = 0; j < 4; ++j) s += (v[j][0] * v[j][0] + v[j][1] * v[j][1]) + (v[j][2] * v[j][2] + v[j][3] * v[j][3]);
        s = wave_sum(s);
        const float rs = rsqrtf(s * (1.f / 1024.f) + EPSN);
#pragma unroll
        for (int j = 0; j < 4; ++j) {
            f32x4 o; o[0] = v[j][0] * rs * wv[j][0]; o[1] = v[j][1] * rs * wv[j][1]; o[2] = v[j][2] * rs * wv[j][2]; o[3] = v[j][3] * rs * wv[j][3];
            if (out_bf) { u32x2 pk; pk.x = pk2(o[0], o[1]); pk.y = pk2(o[2], o[3]); st_global_b64(out_bf + (size_t)r * 1024 + (size_t)(lane + 64 * j) * 4, pk); }
            else st_global_f128(out_f + (size_t)r * 1024 + (size_t)(lane + 64 * j) * 4, o);
        }
    }
}

__device__ __forceinline__ void prep_phase(const Params& p, unsigned char* smem) {
    bf16_t* WT = (bf16_t*)(p.ws + WS_WT);
    float* tile = (float*)smem;
    int tid_ = threadIdx.x; asm volatile("" : "+v"(tid_)); const int tid = tid_;
    for (int it = blockIdx.x; it < N_TITEMS; it += gridDim.x) {
        int r = it; bool found = false; TJob jb; jb.src = nullptr; jb.ld = 0; jb.K = 0; jb.c0 = 0; jb.nc = 0; jb.dst = nullptr;
        auto tj = [&](const float* src, int ld, int K, int c0, int nc, bf16_t* dst) {
            if (!found) { const int ni = (K / 64) * (nc / 64); if (r < ni) { jb.src = src; jb.ld = ld; jb.K = K; jb.c0 = c0; jb.nc = nc; jb.dst = dst; found = true; } else r -= ni; } };
        for (int j = 0; j < 2; ++j) {
            const float* w = p.in[4] + (size_t)j * 1024 * GLA_IN_W; bf16_t* a1 = WT + j * WT_GLA_PER;
            tj(w, GLA_IN_W, 1024, 0, 1024, a1);
            tj(w, GLA_IN_W, 1024, 1024, 2048, a1 + (size_t)1536 * 1024);
            tj(w, GLA_IN_W, 1024, 6160, 1024, a1 + (size_t)3584 * 1024);
            tj(w, GLA_IN_W, 1024, 3088, 3072, a1 + WT_GLA_A2);
        }
        for (int j = 0; j < 2; ++j) {
            const float* w = p.in[8] + (size_t)j * 1024 * S5_IN_W; bf16_t* a1 = WT + WT_S5_BASE + j * WT_S5_PER;
            tj(w, S5_IN_W, 1024, 0, 2048, a1);
            tj(w, S5_IN_W, 1024, 5120, 1024, a1 + (size_t)2048 * 1024);
            tj(w, S5_IN_W, 1024, 2048, 3072, a1 + WT_S5_A2);
            tj(p.in[17] + (size_t)j * 2048 * 2048, 2048, 2048, 0, 2048, a1 + WT_S5_GLU);
        }
        for (int i = 0; i < 4; ++i) tj(p.in[20] + (size_t)i * 3072 * 1024, 1024, 3072, 0, 1024, WT + WT_OUT_BASE + i * WT_OUT_PER);
        for (int i = 0; i < 4; ++i) {
            const float* w = p.in[19] + (size_t)i * 1024 * 2048;
            tj(w, 2048, 1024, 0, 1024, WT + WT_K_BASE + (size_t)i * 1024 * 1024);
            tj(w, 2048, 1024, 1024, 1024, WT + WT_V_BASE + (size_t)i * 1024 * 1024);
        }
        if (found) {
            const int nblk = jb.nc / 64, kb = r / nblk, nb = r % nblk, k0 = kb * 64, n0 = nb * 64;
#pragma unroll
            for (int i = 0; i < 2; ++i) {
                const int kk = (tid >> 4) + 32 * i, c4 = (tid & 15) * 4;
                const f32x4 v = *(const f32x4*)(jb.src + (size_t)(k0 + kk) * jb.ld + jb.c0 + n0 + c4);
                tile[kk * 65 + c4 + 0] = v[0]; tile[kk * 65 + c4 + 1] = v[1]; tile[kk * 65 + c4 + 2] = v[2]; tile[kk * 65 + c4 + 3] = v[3];
            }
            __syncthreads();
            const int n = tid >> 3, kc = (tid & 7) * 8;
            u32x4 o;
            o.x = pk2(tile[(kc + 0) * 65 + n], tile[(kc + 1) * 65 + n]); o.y = pk2(tile[(kc + 2) * 65 + n], tile[(kc + 3) * 65 + n]);
            o.z = pk2(tile[(kc + 4) * 65 + n], tile[(kc + 5) * 65 + n]); o.w = pk2(tile[(kc + 6) * 65 + n], tile[(kc + 7) * 65 + n]);
            *(u32x4*)(jb.dst + (size_t)(n0 + n) * jb.K + k0 + kc) = o;
        }
        __syncthreads();
    }
    for (int idx = blockIdx.x * NTHREADS + tid; idx < 2 * 512 * 1024; idx += gridDim.x * NTHREADS) {
        const int j = idx >> 19, n = (idx >> 10) & 511, k = idx & 1023;
        const float* wr_ = p.in[4] + (size_t)j * 1024 * GLA_IN_W + (size_t)k * GLA_IN_W + 3072;
        const float* wg = p.in[5] + (size_t)j * 16 * 512 + n;
        float s = 0.f;
#pragma unroll
        for (int r = 0; r < 16; ++r) s += wr_[r] * wg[r * 512];
        WT[j * WT_GLA_PER + (size_t)(1024 + n) * 1024 + k] = bf1(s);
    }
    rms_rows(p.in[1], p.in[3], (bf16_t*)(p.ws + WS_MEMN), nullptr, 2048);
}

__device__ __forceinline__ void norm_phase(const Params& p, int layer) {
    const float* x = (layer == 0) ? p.in[0] : p.out;
    rms_rows(x, p.in[2] + layer * 1024, (bf16_t*)(p.ws + WS_H), nullptr, T_TOK, layer > 0);
    unsigned long long* ss = (unsigned long long*)(p.ws + WS_SUMSQ);
    for (int i = blockIdx.x * NTHREADS + threadIdx.x; i < T_TOK * 4; i += gridDim.x * NTHREADS) ss[i] = 0ull;
}

__device__ __forceinline__ void attn_phase(const Params& p, int layer, unsigned char* smem) {
    bf16_t* mix = (bf16_t*)(p.ws + WS_MIX);
    const bf16_t* kmem = (const bf16_t*)(p.ws + WS_KMEM);
    const bf16_t* vt = (const bf16_t*)(p.ws + WS_VT);
    bf16_t* KV = (bf16_t*)smem;
    bf16_t* PB = (bf16_t*)(smem + 67584);
    float* RS = (float*)(smem + 135168);
    int tid_ = threadIdx.x; asm volatile("" : "+v"(tid_));
    const int tid = tid_, wave = tid >> 6, lane = tid & 63, fr = lane & 15, fq = lane >> 4;
    const int sr = tid >> 5, sc8 = (tid & 31) * 8;
    u32x4 stg[8];
#define ATT_SRC(unit_, ti_) (((ti_) < 2) \
        ? (kmem + (size_t)((((unit_) >> 2) >> 6) * 256 + (ti_) * 128 + sr) * 4096 + layer * 1024 + ((unit_) & 3) * 256 + sc8) \
        : (vt + (size_t)(layer * 1024 + ((unit_) & 3) * 256 + ((ti_) - 2) * 128 + sr) * 2048 + (((unit_) >> 2) >> 6) * 256 + sc8))
#define ATT_LOAD(unit_, ti_) do { const bf16_t* sp_ = ATT_SRC(unit_, ti_); const size_t rp_ = ((ti_) < 2) ? (size_t)16 * 4096 : (size_t)16 * 2048; \
        _Pragma("unroll") for (int i = 0; i < 8; ++i) stg[i] = *(const u32x4*)(sp_ + i * rp_); } while (0)
#define ATT_STAGE() do { _Pragma("unroll") for (int i = 0; i < 8; ++i) *(u32x4*)(KV + (sr + 16 * i) * 264 + sc8) = stg[i]; } while (0)
    const int ab = blockIdx.x & 7, astep = (int)(gridDim.x >> 3);
#define ATT_UNIT(u_) ((((ab << 6) + ((u_) >> 2)) << 2) | ((u_) & 3))
    int au = blockIdx.x >> 3;
    int unit = (au < 256) ? ATT_UNIT(au) : 2048;
    if (unit < 2048) ATT_LOAD(unit, 0);
    __syncthreads();
    for (; au < 256; au += astep, unit = (au < 256) ? ATT_UNIT(au) : 2048) {
        const int h = unit & 3, tile = unit >> 2;
        const size_t t0 = (size_t)tile * 128;
        const int unext = (au + astep < 256) ? ATT_UNIT(au + astep) : unit;
        bf16x8 qf[8];
        {
            const bf16_t* qrow = mix + (t0 + wave * 16 + fr) * 3072 + 2048 + h * 256 + fq * 8;
#pragma unroll
            for (int ks = 0; ks < 8; ++ks) qf[ks] = *(const bf16x8*)(qrow + ks * 32);
        }
        f32x4 sacc[16];
#pragma unroll
        for (int half = 0; half < 2; ++half) {
            ATT_STAGE();
            LDS_BAR();
            ATT_LOAD(unit, half + 1);
#pragma unroll
            for (int mb = 0; mb < 8; ++mb) {
                f32x4 a = (f32x4){0.f, 0.f, 0.f, 0.f};
#pragma unroll
                for (int ks = 0; ks < 8; ++ks) { const bf16x8 bfr = *(const bf16x8*)(KV + (mb * 16 + fr) * 264 + ks * 32 + fq * 8); a = MFMA16(qf[ks], bfr, a); }
                sacc[half * 8 + mb] = a;
            }
            LDS_BAR();
        }
        const float sc = 0.0625f * L2E;
#pragma unroll
        for (int j = 0; j < 4; ++j) {
            float mx = sacc[0][j];
#pragma unroll
            for (int i = 1; i < 16; ++i) mx = fmaxf(mx, sacc[i][j]);
            mx = fmaxf(mx, __shfl_xor(mx, 1)); mx = fmaxf(mx, __shfl_xor(mx, 2)); mx = fmaxf(mx, __shfl_xor(mx, 4)); mx = fmaxf(mx, __shfl_xor(mx, 8));
            float sum = 0.f;
#pragma unroll
            for (int i = 0; i < 16; ++i) { const float e = __builtin_amdgcn_exp2f((sacc[i][j] - mx) * sc); sacc[i][j] = e; sum += e; }
            sum += __shfl_xor(sum, 1); sum += __shfl_xor(sum, 2); sum += __shfl_xor(sum, 4); sum += __shfl_xor(sum, 8);
            if (fr == 0) RS[wave * 16 + fq * 4 + j] = 1.f / sum;
#pragma unroll
            for (int i = 0; i < 16; ++i) PB[(wave * 16 + fq * 4 + j) * 264 + i * 16 + fr] = bf1(sacc[i][j]);
        }
        ATT_STAGE();
        LDS_BAR();
        bf16x8 pf[8];
#pragma unroll
        for (int ks = 0; ks < 8; ++ks) pf[ks] = *(const bf16x8*)(PB + (wave * 16 + fr) * 264 + ks * 32 + fq * 8);
        const float rinv = RS[wave * 16 + fr];
#pragma unroll
        for (int half = 0; half < 2; ++half) {
            if (half == 0) ATT_LOAD(unit, 3); else ATT_LOAD(unext, 0);
#pragma unroll
            for (int db = 0; db < 8; ++db) {
                f32x4 a = (f32x4){0.f, 0.f, 0.f, 0.f};
#pragma unroll
                for (int ks = 0; ks < 8; ++ks) { const bf16x8 bfr = *(const bf16x8*)(KV + (db * 16 + fr) * 264 + ks * 32 + fq * 8); a = MFMA16(bfr, pf[ks], a); }
                u32x2 o; o.x = pk2(a[0] * rinv, a[1] * rinv); o.y = pk2(a[2] * rinv, a[3] * rinv);
                st_global_b64(mix + (t0 + wave * 16 + fr) * 3072 + 2048 + h * 256 + half * 128 + db * 16 + fq * 4, o);
            }
            LDS_BAR();
            if (half == 0) { ATT_STAGE(); LDS_BAR(); }
        }
    }
#undef ATT_UNIT
#undef ATT_SRC
#undef ATT_LOAD
#undef ATT_STAGE
    asm volatile("s_waitcnt vmcnt(0)" ::: "memory");
    __syncthreads();
}

__device__ __forceinline__ void gla_pre_phase(const Params& p, unsigned char* smem, bool dry = false) {
    bf16_t* qk = (bf16_t*)(p.ws + WS_QK);
    unsigned char* Gb = p.ws + WS_G;
    float* BC = (float*)smem;
    float* SEG = (float*)(smem + 32768);
    float* BL = (float*)(smem + 32768 + 2048);
    bf16_t* QD = (bf16_t*)(smem + 35328);
    bf16_t* KI = QD + 64 * 136;
    bf16_t* KET = KI + 64 * 136;
    bf16_t* ATT = KET + 128 * 72;
    int tid_ = threadIdx.x; asm volatile("" : "+v"(tid_));
    const int tid = tid_, w = tid >> 6, lane = tid & 63, fr = lane & 15, fq = lane >> 4;
    const int cd = tid & 127, seg = tid >> 7;
    const int es = tid >> 3, dseg = tid & 7;
    const int cb = w >> 1;
    for (int pu = blockIdx.x >> 3; pu < 512; pu += (int)(gridDim.x >> 3)) {
        const int h = pu & 3, bc = (int)(blockIdx.x & 7) * 128 + (pu >> 2);
        const size_t t0 = (size_t)bc * 64;
        const float* G = (const float*)Gb;
        float gpre[16];
#pragma unroll
        for (int i = 0; i < 16; ++i) gpre[i] = G[(t0 + seg * 16 + i) * 512 + h * 128 + cd];
        bf16_t* qp = qk + (t0 + es) * 1024 + h * 128 + dseg * 16;
        const u32x4 q0 = *(const u32x4*)qp, q1 = *(const u32x4*)(qp + 8), k0 = *(const u32x4*)(qp + 512), k1 = *(const u32x4*)(qp + 520);
        float run = 0.f;
#pragma unroll
        for (int i = 0; i < 16; ++i) { run += gpre[i]; gpre[i] = run; }
        SEG[seg * 128 + cd] = run;
        __syncthreads();
        {
            const float s0 = SEG[cd], s1 = SEG[128 + cd], s2 = SEG[256 + cd];
            const float off = (seg > 0 ? s0 : 0.f) + (seg > 1 ? s1 : 0.f) + (seg > 2 ? s2 : 0.f);
#pragma unroll
            for (int i = 0; i < 16; ++i) BC[(seg * 16 + i) * 128 + cd] = gpre[i] + off;
            if (seg == 3) BL[cd] = run + off;
        }
        __syncthreads();
        {
            float bc_[16], bl[16];
#pragma unroll
            for (int e4 = 0; e4 < 4; ++e4) {
                const f32x4 t1 = *(const f32x4*)(BC + es * 128 + dseg * 16 + e4 * 4); const f32x4 t2 = *(const f32x4*)(BL + dseg * 16 + e4 * 4);
                bc_[e4 * 4 + 0] = t1[0]; bc_[e4 * 4 + 1] = t1[1]; bc_[e4 * 4 + 2] = t1[2]; bc_[e4 * 4 + 3] = t1[3];
                bl[e4 * 4 + 0] = t2[0]; bl[e4 * 4 + 1] = t2[1]; bl[e4 * 4 + 2] = t2[2]; bl[e4 * 4 + 3] = t2[3];
            }
            const unsigned qw[8] = { q0.x, q0.y, q0.z, q0.w, q1.x, q1.y, q1.z, q1.w };
            const unsigned kw[8] = { k0.x, k0.y, k0.z, k0.w, k1.x, k1.y, k1.z, k1.w };
            unsigned qo[8], ko[8];
#pragma unroll
            for (int e2 = 0; e2 < 8; ++e2) {
                const float e1a = fexp(bc_[2 * e2]), e1b = fexp(bc_[2 * e2 + 1]);
                const float ia = frcp(e1a), ib = frcp(e1b);
                const float e3a = fexp(bl[2 * e2] - bc_[2 * e2]), e3b = fexp(bl[2 * e2 + 1] - bc_[2 * e2 + 1]);
                const float qa = bflo(qw[e2]), qb = bfhi(qw[e2]), ka = bflo(kw[e2]), kb = bfhi(kw[e2]);
                qo[e2] = pk2(qa * e1a, qb * e1b);
                ko[e2] = pk2(ka * ia, kb * ib);
                const unsigned ke = pk2(ka * e3a, kb * e3b);
                KET[(dseg * 16 + 2 * e2) * 72 + es] = (bf16_t)(ke & 0xffffu);
                KET[(dseg * 16 + 2 * e2 + 1) * 72 + es] = (bf16_t)(ke >> 16);
            }
            u32x4 t; t.x = qo[0]; t.y = qo[1]; t.z = qo[2]; t.w = qo[3]; *(u32x4*)(QD + es * 136 + dseg * 16) = t; if (!dry) *(u32x4*)qp = t;
            t.x = qo[4]; t.y = qo[5]; t.z = qo[6]; t.w = qo[7]; *(u32x4*)(QD + es * 136 + dseg * 16 + 8) = t; if (!dry) *(u32x4*)(qp + 8) = t;
            t.x = ko[0]; t.y = ko[1]; t.z = ko[2]; t.w = ko[3]; *(u32x4*)(KI + es * 136 + dseg * 16) = t;
            t.x = ko[4]; t.y = ko[5]; t.z = ko[6]; t.w = ko[7]; *(u32x4*)(KI + es * 136 + dseg * 16 + 8) = t;
        }
        __syncthreads();
#pragma unroll
        for (int n = 0; n < 2; ++n) {
            const int sb = (w & 1) * 2 + n;
            f32x4 a = (f32x4){0.f, 0.f, 0.f, 0.f};
            if (sb <= cb) {
#pragma unroll
                for (int ks = 0; ks < 4; ++ks) {
                    const bf16x8 af = *(const bf16x8*)(QD + (cb * 16 + fr) * 136 + ks * 32 + fq * 8);
                    const bf16x8 bfr = *(const bf16x8*)(KI + (sb * 16 + fr) * 136 + ks * 32 + fq * 8);
                    a = MFMA16(af, bfr, a);
                }
            }
#pragma unroll
            for (int jj = 0; jj < 4; ++jj) {
                const int cc = cb * 16 + fq * 4 + jj, ss = sb * 16 + fr;
                ATT[cc * 72 + ss] = bf1(ss <= cc ? a[jj] : 0.f);
            }
        }
        __syncthreads();
        unsigned char* gbase = Gb + ((t0 * 512) + (size_t)h * 128) * 4;
#pragma unroll
        for (int i = 0; i < 2; ++i) {
            const int idx = tid + i * 512, d = idx >> 3, pc = idx & 7;
            const u32x4 v = *(const u32x4*)(KET + d * 72 + pc * 8);
            if (!dry) *(u32x4*)(gbase + (size_t)(d >> 2) * 2048 + (d & 3) * 128 + pc * 16) = v;
        }
        {
            const int c = tid >> 3, pc = tid & 7;
            const u32x4 v = *(const u32x4*)(ATT + c * 72 + pc * 8);
            if (!dry) *(u32x4*)(gbase + (size_t)(32 + (c >> 2)) * 2048 + (c & 3) * 128 + pc * 16) = v;
        }
        if (tid < 128 && !dry) *(float*)(gbase + (size_t)48 * 2048 + tid * 4) = fexp(BL[tid]);
        __syncthreads();
    }
}

__device__ __forceinline__ void gla_phase(const Params& p, unsigned char* smem, bool dry = false) {
    const unsigned char* qkb = p.ws + WS_QK;
    const unsigned char* Gb = p.ws + WS_G;
    bf16_t* mix = (bf16_t*)(p.ws + WS_MIX);
    float* part = (float*)(p.ws + WS_PART);
    bf16_t* ST = (bf16_t*)smem;
    bf16_t* VT = ST + 64 * 136;
    constexpr int OPB = 26624, OPSZ = 41984, O_KET = 0, O_QD = 16384, O_ATT = 32768, O_DEC = 40960;
    LAS unsigned char* lds = (LAS unsigned char*)smem;
    int tid_ = threadIdx.x; asm volatile("" : "+v"(tid_));
    const int tid = tid_, w = __builtin_amdgcn_readfirstlane(tid >> 6), lane = tid & 63, fr = lane & 15, fq = lane >> 4;
    const int es = tid >> 3, dseg = tid & 7;
    const int cb = w >> 1, wh = w & 1;
    const int crow = cb * 16 + fr;
    unsigned koff[2], qoff[2], aoff, doff;
#pragma unroll
    for (int i = 0; i < 2; ++i) {
        const int P = (2 * w + i) * 64 + lane;
        { const int r = P >> 3, s_ = P & 7, q = s_ ^ (r & 7); koff[i] = (unsigned)((r >> 2) * 2048 + (r & 3) * 128 + q * 16); }
        { const int r = P >> 4, s_ = P & 15, q = s_ ^ (r & 15); qoff[i] = (unsigned)(r * 2048 + q * 16); }
    }
    { const int P = w * 64 + lane, r = P >> 3, s_ = P & 7, q = s_ ^ (r & 7); aoff = (unsigned)((32 + (r >> 2)) * 2048 + (r & 3) * 128 + q * 16); }
    doff = (unsigned)(48 * 2048 + (lane & 31) * 16);
    int r_att[2], r_qd[4], r_ket[4][2], r_dec[4];
#pragma unroll
    for (int ks = 0; ks < 2; ++ks) r_att[ks] = O_ATT + (crow * 8 + ((ks * 4 + fq) ^ (crow & 7))) * 16;
#pragma unroll
    for (int ks = 0; ks < 4; ++ks) r_qd[ks] = O_QD + (crow * 16 + ((ks * 4 + fq) ^ (crow & 15))) * 16;
#pragma unroll
    for (int n = 0; n < 4; ++n) { const int d = (wh * 4 + n) * 16 + fr; r_dec[n] = O_DEC + d * 4;
#pragma unroll
        for (int ks = 0; ks < 2; ++ks) r_ket[n][ks] = O_KET + (d * 8 + ((ks * 4 + fq) ^ (d & 7))) * 16; }
    for (int unit = blockIdx.x; unit < 256; unit += gridDim.x) {
        const int ux = unit & 7, uy = unit >> 3;
        const int bh = ux * 4 + (uy >> 3), sl = uy & 7, h = bh & 3, b = bh >> 2;
        const size_t tb = (size_t)b * SEQ_L;
        f32x4 st[4];
#pragma unroll
        for (int n = 0; n < 4; ++n) st[n] = (f32x4){0.f, 0.f, 0.f, 0.f};
        u32x4 vpre;
#define GLA_DMA(t1, bufoff) do { const unsigned char* gb_ = Gb + (((t1) * 512) + (size_t)h * 128) * 4; const unsigned char* qb_ = qkb + (((t1) * 1024) + (size_t)h * 128) * 2; \
            _Pragma("unroll") for (int i = 0; i < 2; ++i) { \
                __builtin_amdgcn_global_load_lds((const unsigned*)(gb_ + koff[i]), (LAS unsigned*)(lds + (bufoff) + O_KET + (2 * w + i) * 1024), 16, 0, 0); \
                __builtin_amdgcn_global_load_lds((const unsigned*)(qb_ + qoff[i]), (LAS unsigned*)(lds + (bufoff) + O_QD + (2 * w + i) * 1024), 16, 0, 0); } \
            __builtin_amdgcn_global_load_lds((const unsigned*)(gb_ + aoff), (LAS unsigned*)(lds + (bufoff) + O_ATT + w * 1024), 16, 0, 0); \
            if (w == 7) __builtin_amdgcn_global_load_lds((const unsigned*)(gb_ + doff), (LAS unsigned*)(lds + (bufoff) + O_DEC), 16, 0, 0); } while (0)
#define GLA_LOAD_V(t1) vpre = *(const u32x4*)(mix + ((t1) + es) * 3072 + h * 512 + sl * 64 + dseg * 8)
        __syncthreads();
        GLA_DMA(tb, OPB); GLA_LOAD_V(tb);
        u32x2 po[2]; po[0] = (u32x2){0u, 0u}; po[1] = (u32x2){0u, 0u}; float pssq = 0.f;
        for (int c = 0; c < 128; ++c) {
            const size_t t0 = tb + (size_t)c * 64;
            const size_t tn = tb + (size_t)(c < 127 ? c + 1 : 127) * 64;
            const size_t tp = tb + (size_t)(c > 0 ? c - 1 : 0) * 64;
            const int bcur = OPB + (c & 1) * OPSZ, bnxt = OPB + ((c & 1) ^ 1) * OPSZ;
            const unsigned char* OB = smem + bcur;
            {
                const unsigned vw[4] = { vpre.x, vpre.y, vpre.z, vpre.w };
#pragma unroll
                for (int e2 = 0; e2 < 4; ++e2) {
                    VT[(dseg * 8 + 2 * e2) * 72 + es] = (bf16_t)(vw[e2] & 0xffffu);
                    VT[(dseg * 8 + 2 * e2 + 1) * 72 + es] = (bf16_t)(vw[e2] >> 16);
                }
#pragma unroll
                for (int n = 0; n < 4; ++n) {
                    const int db = wh * 4 + n;
#pragma unroll
                    for (int jj = 0; jj < 4; ++jj) ST[(cb * 16 + fq * 4 + jj) * 136 + db * 16 + fr] = bf1(st[n][jj]);
                }
            }
            asm volatile("s_waitcnt vmcnt(0) lgkmcnt(0)" ::: "memory"); __builtin_amdgcn_s_barrier(); asm volatile("" ::: "memory");
            if (!(dry && (PROBE_ABL & 1))) { GLA_DMA(tn, bnxt); GLA_LOAD_V(tn); }
            {
                bf16_t* op = mix + (tp + crow) * 3072 + h * 512 + sl * 64 + wh * 32 + fq * 4;
                if (!dry) { st_global_b64(op, po[0]); st_global_b64(op + 16, po[1]);
                st_global_b32(part + ((tp + crow) * 4 + h) * 16 + sl * 2 + wh, pssq); }
            }
            {
                bf16x8 A_vt[2];
#pragma unroll
                for (int ks = 0; ks < 2; ++ks) A_vt[ks] = *(const bf16x8*)(VT + (cb * 16 + fr) * 72 + ks * 32 + fq * 8);
#pragma unroll
                for (int n = 0; n < 4; ++n) {
                    const float dcn = *(const float*)(OB + r_dec[n]);
                    st[n][0] *= dcn; st[n][1] *= dcn; st[n][2] *= dcn; st[n][3] *= dcn;
#pragma unroll
                    for (int ks = 0; ks < 2; ++ks) st[n] = MFMA16(A_vt[ks], *(const bf16x8*)(OB + r_ket[n][ks]), st[n]);
                }
            }
            {
                bf16x8 A_att[2], A_qd[4];
#pragma unroll
                for (int ks = 0; ks < 2; ++ks) A_att[ks] = *(const bf16x8*)(OB + r_att[ks]);
#pragma unroll
                for (int ks = 0; ks < 4; ++ks) A_qd[ks] = *(const bf16x8*)(OB + r_qd[ks]);
                float ssq = 0.f;
#pragma unroll
                for (int n = 0; n < 2; ++n) {
                    const int eb = wh * 2 + n;
                    f32x4 a = (f32x4){0.f, 0.f, 0.f, 0.f};
#pragma unroll
                    for (int ks = 0; ks < 2; ++ks) { const bf16x8 bfr = *(const bf16x8*)(VT + (eb * 16 + fr) * 72 + ks * 32 + fq * 8); a = MFMA16(bfr, A_att[ks], a); }
#pragma unroll
                    for (int ks = 0; ks < 4; ++ks) { const bf16x8 bfr = *(const bf16x8*)(ST + (eb * 16 + fr) * 136 + ks * 32 + fq * 8); a = MFMA16(bfr, A_qd[ks], a); }
                    po[n].x = pk2(a[0], a[1]); po[n].y = pk2(a[2], a[3]);
                    ssq += (a[0] * a[0] + a[1] * a[1]) + (a[2] * a[2] + a[3] * a[3]);
                }
                ssq += __shfl_xor(ssq, 16); ssq += __shfl_xor(ssq, 32); pssq = ssq;
            }
            LDS_BAR();
        }
        {
            const size_t t0 = tb + (size_t)127 * 64;
            bf16_t* op = mix + (t0 + crow) * 3072 + h * 512 + sl * 64 + wh * 32 + fq * 4;
            if (!dry) { st_global_b64(op, po[0]); st_global_b64(op + 16, po[1]);
            st_global_b32(part + ((t0 + crow) * 4 + h) * 16 + sl * 2 + wh, pssq); }
        }
        asm volatile("s_waitcnt vmcnt(0)" ::: "memory");
#undef GLA_DMA
#undef GLA_LOAD_V
        __syncthreads();
    }
}

#define S5_BAR() LDS_BAR()
__device__ __forceinline__ void s5_phase(const Params& p, int j, unsigned char* smem) {
    const bf16_t* mix = (const bf16_t*)(p.ws + WS_MIX);
    bf16_t* y5 = (bf16_t*)(p.ws + WS_QK);
    int tid_ = threadIdx.x; asm volatile("" : "+v"(tid_));
    const int tid = tid_, w = __builtin_amdgcn_readfirstlane(tid >> 6), lane = tid & 63, fr = lane & 15, fq = lane >> 4;
    const int wp = w & 3;
    float* BUF = (float*)(smem + wp * 25600);
    bf16_t* XB = (bf16_t*)(smem + wp * 25600 + 8448);
    for (int ub = blockIdx.x; ub < 256; ub += gridDim.x) {
        const int b = ub & 7, g = (ub >> 3) * 4 + wp;
        const int jg = j * 128 + g;
        const float lr = p.in[9][jg * 64 + lane], li = p.in[10][jg * 64 + lane];
        const float dt = __expf(p.in[11][jg]);
        const float mag = __expf(lr * dt);
        float rev = li * dt * 0.15915494309189535f; rev -= floorf(rev);
        const float ar = mag * __builtin_amdgcn_cosf(rev), ai = mag * __builtin_amdgcn_sinf(rev);
        const size_t tb0 = (size_t)b * SEQ_L;
        if (w < 4) {
            float xr = 0.f, xi = 0.f; const float nai = -ai;
            S5_BAR();
            for (int step2 = 0; step2 < 512; step2 += 2) {
#pragma unroll
                for (int k = 0; k < 2; ++k) {
                    const float* BUFc = BUF + k * 3200; bf16_t* XBc = XB + k * 6400;
                    f32x2 bu[16];
#pragma unroll
                    for (int t = 0; t < 16; ++t) bu[t] = *(const f32x2*)(BUFc + t * 132 + 2 * lane);
#pragma unroll
                    for (int t = 0; t < 16; ++t) {
                        const float t1 = fma_s(nai, xi, bu[t][0]);
                        const float t2 = fma_s(ai, xr, bu[t][1]);
                        const float nxr = fma_s(ar, xr, t1);
                        const float nxi = fma_s(ar, xi, t2);
                        xr = nxr; xi = nxi;
                        *(unsigned*)(XBc + t * 136 + 2 * lane) = pk2(xr, xi);
                    }
                    S5_BAR();
                }
            }
        } else {
            const float nr = ar - 1.f, ni = ai, den = lr * lr + li * li;
            const float cre = (nr * lr + ni * li) / den, cim = (ni * lr - nr * li) / den;
            bf16x8 bbf[8];
#pragma unroll
            for (int nb = 0; nb < 8; ++nb) {
                const int pp = nb * 8 + (fr >> 1);
                const float c_re = __shfl(cre, pp), c_im = __shfl(cim, pp);
                const int fqc = fq & 1;
                const float* br = p.in[12] + ((size_t)jg * 64 + pp) * 16 + fqc * 8;
                const float* bi = p.in[13] + ((size_t)jg * 64 + pp) * 16 + fqc * 8;
                const f32x4 br0 = *(const f32x4*)br, br1 = *(const f32x4*)(br + 4), bi0 = *(const f32x4*)bi, bi1 = *(const f32x4*)(bi + 4);
                float v[8];
#pragma unroll
                for (int e = 0; e < 4; ++e) {
                    v[e] = (fr & 1) ? (c_re * bi0[e] + c_im * br0[e]) : (c_re * br0[e] - c_im * bi0[e]);
                    v[4 + e] = (fr & 1) ? (c_re * bi1[e] + c_im * br1[e]) : (c_re * br1[e] - c_im * bi1[e]);
                }
                u32x4 t; t.x = pk2(v[0], v[1]); t.y = pk2(v[2], v[3]); t.z = pk2(v[4], v[5]); t.w = pk2(v[6], v[7]);
                if (fq >= 2) { t.x = 0u; t.y = 0u; t.z = 0u; t.w = 0u; }
                bbf[nb] = __builtin_bit_cast(bf16x8, t);
            }
            bf16x8 cf[4];
#pragma unroll
            for (int ks = 0; ks < 4; ++ks) {
                const int pb = ks * 16 + fq * 4;
                const f32x4 cr = *(const f32x4*)(p.in[14] + ((size_t)jg * 16 + fr) * 64 + pb);
                const f32x4 ci = *(const f32x4*)(p.in[15] + ((size_t)jg * 16 + fr) * 64 + pb);
                u32x4 t; t.x = pk2(cr[0], -ci[0]); t.y = pk2(cr[1], -ci[1]); t.z = pk2(cr[2], -ci[2]); t.w = pk2(cr[3], -ci[3]);
                cf[ks] = __builtin_bit_cast(bf16x8, t);
            }
            const f32x4 dv = *(const f32x4*)(p.in[16] + j * 2048 + g * 16 + fq * 4);
            const bf16_t* ubase = mix + (tb0 + fr) * 3072 + g * 16;
            bf16_t* ybase = y5 + (tb0 + fr) * 2048 + g * 16 + fq * 4;
            const bool pad = (fq >= 2);
            u32x4 ufq[4]; u32x2 uoq[4];
            {
                u32x4 uf0 = *(const u32x4*)(ubase + (fq & 1) * 8);
                if (pad) { uf0.x = 0u; uf0.y = 0u; uf0.z = 0u; uf0.w = 0u; }
                const bf16x8 uf = __builtin_bit_cast(bf16x8, uf0);
#pragma unroll
                for (int nb = 0; nb < 8; ++nb) { const f32x4 a = MFMA16(bbf[nb], uf, ((f32x4){0.f, 0.f, 0.f, 0.f})); *(f32x4*)(BUF + fr * 132 + nb * 16 + fq * 4) = a; }
#pragma unroll
                for (int q = 1; q <= 4; ++q) ufq[q & 3] = *(const u32x4*)(ubase + (size_t)q * 16 * 3072 + (fq & 1) * 8);
#pragma unroll
                for (int q = 0; q < 3; ++q) uoq[q] = *(const u32x2*)(ubase + (size_t)q * 16 * 3072 + fq * 4);
                uoq[3] = uoq[0];
                S5_BAR();
            }
            for (int step4 = 0; step4 < 512; step4 += 4) {
#pragma unroll
                for (int k = 0; k < 4; ++k) {
                    const int step = step4 + k;
                    const int cur = k & 1, nxt = cur ^ 1;
                    float* BUFn = BUF + nxt * 3200; const bf16_t* XBn = XB + nxt * 6400;
                    u32x4 ufc = ufq[(k + 1) & 3]; if (pad) { ufc.x = 0u; ufc.y = 0u; ufc.z = 0u; ufc.w = 0u; }
                    { const int s5 = (step + 5 < 512) ? step + 5 : 511; ufq[(k + 1) & 3] = *(const u32x4*)(ubase + (size_t)s5 * 16 * 3072 + (fq & 1) * 8); }
                    const bf16x8 uf = __builtin_bit_cast(bf16x8, ufc);
                    f32x4 ya = (f32x4){0.f, 0.f, 0.f, 0.f};
#pragma unroll
                    for (int ks = 0; ks < 4; ++ks) { const bf16x8 xf = *(const bf16x8*)(XBn + fr * 136 + ks * 32 + fq * 8); ya = MFMA16(cf[ks], xf, ya); }
#pragma unroll
                    for (int nb = 0; nb < 8; ++nb) { const f32x4 a = MFMA16(bbf[nb], uf, ((f32x4){0.f, 0.f, 0.f, 0.f})); *(f32x4*)(BUFn + fr * 132 + nb * 16 + fq * 4) = a; }
                    const u32x2 uo = uoq[(k + 3) & 3];
                    { const int s3 = (step + 3 < 512) ? step + 3 : 511; uoq[(k + 3) & 3] = *(const u32x2*)(ubase + (size_t)s3 * 16 * 3072 + fq * 4); }
                    if (step > 0) {
                        const float u0 = bflo(uo.x), u1 = bfhi(uo.x), u2 = bflo(uo.y), u3 = bfhi(uo.y);
                        float yv[4] = { ya[0] + dv[0] * u0, ya[1] + dv[1] * u1, ya[2] + dv[2] * u2, ya[3] + dv[3] * u3 };
#pragma unroll
                        for (int e = 0; e < 4; ++e) { const float v = yv[e]; const float z = 0.7978845608028654f * (v + 0.044715f * v * v * v); yv[e] = v * fsigmoid(2.f * z); }
                        u32x2 o; o.x = pk2(yv[0], yv[1]); o.y = pk2(yv[2], yv[3]);
                        st_global_b64(ybase + (size_t)(step - 1) * 16 * 2048, o);
                    }
                    S5_BAR();
                }
            }
            {
                const u32x2 uo = uoq[3];
                const bf16_t* XBn = XB + 6400;
                f32x4 ya = (f32x4){0.f, 0.f, 0.f, 0.f};
#pragma unroll
                for (int ks = 0; ks < 4; ++ks) { const bf16x8 xf = *(const bf16x8*)(XBn + fr * 136 + ks * 32 + fq * 8); ya = MFMA16(cf[ks], xf, ya); }
                const float u0 = bflo(uo.x), u1 = bfhi(uo.x), u2 = bflo(uo.y), u3 = bfhi(uo.y);
                float yv[4] = { ya[0] + dv[0] * u0, ya[1] + dv[1] * u1, ya[2] + dv[2] * u2, ya[3] + dv[3] * u3 };
#pragma unroll
                for (int e = 0; e < 4; ++e) { const float v = yv[e]; const float z = 0.7978845608028654f * (v + 0.044715f * v * v * v); yv[e] = v * fsigmoid(2.f * z); }
                u32x2 o; o.x = pk2(yv[0], yv[1]); o.y = pk2(yv[2], yv[3]);
                st_global_b64(ybase + (size_t)511 * 16 * 2048, o);
            }
        }
        __syncthreads();
    }
    __syncthreads();
}

enum { K_PREP = 0, K_KV, K_NORM, K_A1, K_MIX, K_GLU, K_A2, K_A3, K_FINAL, K_MIXB };
constexpr int N_PHASES = 25;
__device__ __forceinline__ void decode_phase(int ph, int& kind, int& layer) {
    if (ph == 0) { kind = K_PREP; layer = 0; return; }
    if (ph >= 24) { kind = K_FINAL; layer = 0; return; }
    int q;
    if (ph < 6) { layer = 0; q = ph; } else { const int q0 = ph - 6; layer = 1 + q0 / 6; q = q0 - (layer - 1) * 6; }
    if (layer & 1) kind = (q == 0) ? K_NORM : (q == 1) ? K_A1 : (q == 2) ? K_MIX : (q == 3) ? K_GLU : (q == 4) ? K_A2 : K_A3;
    else kind = (q == 0) ? K_NORM : (q == 1) ? K_A1 : (q == 2) ? K_MIX : (q == 3) ? K_MIXB : (q == 4) ? K_A2 : K_A3;
}

__device__ __forceinline__ void run_phase(const Params& p, int ph, unsigned char* smem) {
    int kind, layer; decode_phase(ph, kind, layer);
    const int j = layer >> 1; const bool is_gla = !(layer & 1);
    bf16_t* WT = (bf16_t*)(p.ws + WS_WT);
    bf16_t* H = (bf16_t*)(p.ws + WS_H);
    bf16_t* MIX = (bf16_t*)(p.ws + WS_MIX);
#ifndef NO_PREP
    if (kind == K_PREP) { prep_phase(p, smem); norm_phase(p, 0); return; }
#endif
    if (kind == K_NORM) { norm_phase(p, layer); return; }
    if (kind == K_FINAL) { rms_rows(p.out, p.in[21], nullptr, p.out, T_TOK, true); return; }
    if (kind == K_MIX) {
        if (is_gla) { if (PROBE_DUP & 2) { gla_pre_phase(p, smem, true); __syncthreads(); } gla_pre_phase(p, smem); } else s5_phase(p, j, smem);
        __syncthreads();
        attn_phase(p, layer, smem);
        return;
    }
    if (kind == K_MIXB) { if (PROBE_DUP & 1) { gla_phase(p, smem, true); __syncthreads(); } gla_phase(p, smem); return; }
    const bool withkv = (kind == K_A1 && layer == 0);
    const int ngemm = withkv ? 3 : 1;
    for (int q = 0; q < ngemm; ++q) {
        pg8::Gemm g; pg8::Epi E;
        E.mode = pg8::EM_BF16; E.o0 = nullptr; E.ld0 = 0; E.qk = nullptr; E.g = nullptr; E.gbias = nullptr; E.mix = MIX; E.part = nullptr; E.onw = nullptr; E.is_gla = 0;
        E.y5 = nullptr; E.bglu = nullptr; E.xin = nullptr; E.xout = nullptr;
        int ord_c = (int)blockIdx.x;
        if (withkv && q < 2) {
            if (q == 1) ord_c = (int)((blockIdx.x + gridDim.x / 2) % gridDim.x);
            if (q == 0) { g.A = (const bf16_t*)(p.ws + WS_MEMN); g.Bt = WT + WT_K_BASE; g.M = 2048; g.N = 4096; g.K = 1024; E.o0 = (bf16_t*)(p.ws + WS_KMEM); E.ld0 = 4096; }
            else { g.A = WT + WT_V_BASE; g.Bt = (const bf16_t*)(p.ws + WS_MEMN); g.M = 4096; g.N = 2048; g.K = 1024; E.o0 = (bf16_t*)(p.ws + WS_VT); E.ld0 = 2048; }
        } else if (kind == K_A1) {
            g.A = H; g.M = T_TOK; g.K = 1024;
            if (is_gla) { g.Bt = WT + j * WT_GLA_PER; g.N = 4608; E.mode = pg8::EM_A1GLA; E.qk = (bf16_t*)(p.ws + WS_QK); E.g = (float*)(p.ws + WS_G); E.gbias = p.in[6] + j * 512; }
            else { g.Bt = WT + WT_S5_BASE + j * WT_S5_PER; g.N = 3072; E.o0 = MIX; E.ld0 = 3072; }
        } else if (kind == K_A2) {
            g.A = H; g.M = T_TOK; g.K = 1024; g.N = 3072;
            g.Bt = is_gla ? (WT + j * WT_GLA_PER + WT_GLA_A2) : (WT + WT_S5_BASE + j * WT_S5_PER + WT_S5_A2);
            E.mode = pg8::EM_GATE; E.part = (const float*)(p.ws + WS_PART); E.onw = p.in[7] + j * 512; E.is_gla = is_gla ? 1 : 0;
        } else if (kind == K_GLU) {
            g.A = (const bf16_t*)(p.ws + WS_QK); g.M = T_TOK; g.K = 2048; g.N = 2048; g.Bt = WT + WT_S5_BASE + j * WT_S5_PER + WT_S5_GLU;
            E.mode = pg8::EM_GLU; E.y5 = (const bf16_t*)(p.ws + WS_QK); E.bglu = p.in[18] + j * 2048;
        } else {
            g.A = MIX; g.M = T_TOK; g.K = 3072; g.N = 1024; g.Bt = WT + WT_OUT_BASE + layer * WT_OUT_PER;
            E.mode = pg8::EM_RESID; E.xin = (layer == 0) ? p.in[0] : p.out; E.xout = p.out;
        }
        pg8::StaticOrder S; S.init(g.M, g.N, (int)gridDim.x, ord_c);
#ifndef NO_GEMM
        pg8::gemm_phase((LAS unsigned char*)smem, g, S, E);
#endif
        __syncthreads();
    }
}

__device__ __forceinline__ void grid_barrier(unsigned* ctr, unsigned target) {
    __syncthreads();
    if (threadIdx.x == 0) {
        __threadfence();
        atomicAdd(ctr, 1u);
        while (__hip_atomic_load(ctr, __ATOMIC_RELAXED, __HIP_MEMORY_SCOPE_AGENT) < target) __builtin_amdgcn_s_sleep(2);
        __threadfence();
    }
    __syncthreads();
}

__global__ void __launch_bounds__(NTHREADS, 2) mega(Params p) {
    extern __shared__ __attribute__((aligned(16))) unsigned char smem[];
    cg::grid_group grid = cg::this_grid();
    unsigned* ctr = (unsigned*)(p.ws + WS_CTL);
    unsigned nbar = 0, ngrp = 0;
    for (int ph = p.ph_lo; ph < p.ph_hi; ++ph) {
        run_phase(p, ph, smem);
        if (ph + 1 < p.ph_hi) {
            if (ph == p.ph_lo) grid.sync();
            else if (ph == 1 || (gridDim.x & 7) != 0) { ++nbar; grid_barrier(ctr, nbar * gridDim.x); }
            else { ++ngrp; grid_barrier(ctr + 16 * (1 + (blockIdx.x & 7)), ngrp * (gridDim.x >> 3)); }
        }
    }
}

extern "C" void kernel_launch(void* const* d_in, const int* in_sizes, int n_in, void* d_out, int out_size, void* d_ws, size_t ws_size, hipStream_t stream) {
    static int grid = 0;
    if (grid == 0) {
        if (n_in != 22 || out_size != T_TOK * DM || ws_size < WS_END) {
            fprintf(stderr, "kernel_launch: unexpected shapes: n_in %d out %d ws %zu (need %zu)\n", n_in, out_size, ws_size, (size_t)WS_END); grid = -1; return; }
        int dev = 0, cus = 0, per_cu = 0;
        if (hipGetDevice(&dev) != hipSuccess || hipDeviceGetAttribute(&cus, hipDeviceAttributeMultiprocessorCount, dev) != hipSuccess) { grid = -1; return; }
        if (hipFuncSetAttribute((const void*)mega, hipFuncAttributeMaxDynamicSharedMemorySize, LDS_BYTES) != hipSuccess) { fprintf(stderr, "kernel_launch: hipFuncSetAttribute failed\n"); grid = -1; return; }
        if (hipOccupancyMaxActiveBlocksPerMultiprocessor(&per_cu, (const void*)mega, NTHREADS, LDS_BYTES) != hipSuccess || per_cu < 1) { fprintf(stderr, "kernel_launch: occupancy query says %d\n", per_cu); per_cu = 1; }
        (void)hipGetLastError();
        grid = cus * 1;
    }
    if (grid < 0) return;
    if (hipMemsetAsync((char*)d_ws + WS_CTL, 0, 1024, stream) != hipSuccess) { fprintf(stderr, "kernel_launch: memset failed\n"); return; }
    Params p{};
    for (int i = 0; i < 22; ++i) p.in[i] = (const float*)d_in[i];
    p.out = (float*)d_out; p.ws = (unsigned char*)d_ws;
#if MK_COOP
    p.ph_lo = 0; p.ph_hi = N_PHASES;
    void* args[] = { &p };
    hipError_t e = hipLaunchCooperativeKernel((const void*)mega, dim3(grid), dim3(NTHREADS), args, LDS_BYTES, stream);
    if (e != hipSuccess) fprintf(stderr, "cooperative launch failed: %s (grid %d)\n", hipGetErrorString(e), grid);
#else
    for (int ph = 0; ph < N_PHASES; ++ph) {
        p.ph_lo = ph; p.ph_hi = ph + 1;
        hipLaunchKernelGGL(mega, dim3(grid), dim3(NTHREADS), LDS_BYTES, stream, p);
    }
#endif
}
```

```cpp
#include <hip/hip_runtime.h>
#include <hip/hip_cooperative_groups.h>
#include <cstdio>
#include <cstdint>
namespace cg = cooperative_groups;

#ifndef MK_COOP
#define MK_COOP 1
#endif
#ifndef PROBE_DUP
#define PROBE_DUP 0
#endif
#ifndef PROBE_ABL
#define PROBE_ABL 0
#endif

#define LAS __attribute__((address_space(3)))
typedef unsigned short bf16_t;
typedef short bf16x8 __attribute__((ext_vector_type(8)));
typedef float f32x4 __attribute__((ext_vector_type(4)));
typedef float f32x2 __attribute__((ext_vector_type(2)));
typedef unsigned u32x4 __attribute__((ext_vector_type(4)));
typedef unsigned u32x2 __attribute__((ext_vector_type(2)));

constexpr int T_TOK = 65536;
constexpr int SEQ_L = 8192;
constexpr int DM = 1024;
constexpr int GLA_IN_W = 7184, S5_IN_W = 6144;
constexpr float EPSN = 1e-6f;
constexpr float L2E = 1.4426950408889634f;

constexpr size_t MiB = 1024ull * 1024ull;
constexpr size_t WS_H = 0;
constexpr size_t WS_QK = 128 * MiB;
constexpr size_t WS_G = 256 * MiB;
constexpr size_t WS_MIX = 384 * MiB;
constexpr size_t WS_KMEM = 768 * MiB;
constexpr size_t WS_VT = 784 * MiB;
constexpr size_t WS_MEMN = 800 * MiB;
constexpr size_t WS_SUMSQ = 804 * MiB;
constexpr size_t WS_CTL = 806 * MiB;
constexpr size_t WS_WT = 807 * MiB;
constexpr size_t WT_GLA_PER = (size_t)(4608 + 3072) * 1024;
constexpr size_t WT_GLA_A2 = (size_t)4608 * 1024;
constexpr size_t WT_S5_BASE = 2 * WT_GLA_PER;
constexpr size_t WT_S5_PER = (size_t)6144 * 1024 + (size_t)2048 * 2048;
constexpr size_t WT_S5_A2 = (size_t)3072 * 1024;
constexpr size_t WT_S5_GLU = (size_t)6144 * 1024;
constexpr size_t WT_OUT_BASE = WT_S5_BASE + 2 * WT_S5_PER;
constexpr size_t WT_OUT_PER = (size_t)1024 * 3072;
constexpr size_t WT_K_BASE = WT_OUT_BASE + 4 * WT_OUT_PER;
constexpr size_t WT_V_BASE = WT_K_BASE + (size_t)4096 * 1024;
constexpr size_t WT_TOTAL = WT_V_BASE + (size_t)4096 * 1024;
constexpr size_t WS_END = WS_WT + WT_TOTAL * 2;
constexpr size_t WS_PART = 920 * MiB;
static_assert(WS_END <= WS_PART && WS_PART + (size_t)T_TOK * 64 * 4 <= 1024 * MiB, "workspace map");

constexpr int LDS_BYTES = 144 * 1024;
constexpr int NTHREADS = 512;

struct Params {
    const float* in[22];
    float* out;
    unsigned char* ws;
    int ph_lo, ph_hi;
};

typedef __bf16 bf16x2_t __attribute__((ext_vector_type(2)));
__device__ __forceinline__ unsigned pk2(float lo, float hi) { f32x2 v = {lo, hi}; bf16x2_t b = __builtin_convertvector(v, bf16x2_t); return __builtin_bit_cast(unsigned, b); }
__device__ __forceinline__ bf16_t bf1(float v) { return (bf16_t)(pk2(v, 0.f) & 0xffffu); }
__device__ __forceinline__ float bflo(unsigned u) { return __uint_as_float(u << 16); }
__device__ __forceinline__ float bfhi(unsigned u) { return __uint_as_float(u & 0xffff0000u); }
__device__ __forceinline__ float wave_sum(float v) {
#pragma unroll
    for (int o = 1; o < 64; o <<= 1) v += __shfl_xor(v, o);
    return v;
}
__device__ __forceinline__ float fexp(float x) { return __builtin_amdgcn_exp2f(x * L2E); }
__device__ __forceinline__ float frcp(float x) { return __builtin_amdgcn_rcpf(x); }
__device__ __forceinline__ float fsigmoid(float x) { return frcp(1.f + fexp(-x)); }
__device__ __forceinline__ void wave_sync() { asm volatile("s_waitcnt lgkmcnt(0)" ::: "memory"); __builtin_amdgcn_wave_barrier(); }
#define LDS_BAR() do { asm volatile("s_waitcnt lgkmcnt(0)" ::: "memory"); __builtin_amdgcn_s_barrier(); asm volatile("" ::: "memory"); } while (0)
__device__ __forceinline__ void st_global_b64(void* ptr, u32x2 v) { asm volatile("global_store_dwordx2 %0, %1, off" :: "v"(ptr), "v"(v) : "memory"); }
__device__ __forceinline__ void st_global_b128(void* ptr, u32x4 v) { asm volatile("global_store_dwordx4 %0, %1, off\n\ts_nop 1" :: "v"(ptr), "v"(v) : "memory"); }
__device__ __forceinline__ void st_global_f128(void* ptr, f32x4 v) { asm volatile("global_store_dwordx4 %0, %1, off\n\ts_nop 1" :: "v"(ptr), "v"(v) : "memory"); }
__device__ __forceinline__ float fma_s(float a, float b, float c) { float d; asm("v_fma_f32 %0, %1, %2, %3" : "=v"(d) : "v"(a), "v"(b), "v"(c)); return d; }
__device__ __forceinline__ void st_global_b32(void* ptr, float v) { asm volatile("global_store_dword %0, %1, off" :: "v"(ptr), "v"(v) : "memory"); }
__device__ __forceinline__ void atomic_add_u64_noret(unsigned long long* ptr, unsigned long long v) { asm volatile("global_atomic_add_x2 %0, %1, off" :: "v"(ptr), "v"(v) : "memory"); }
#define MFMA16(a, b, c) __builtin_amdgcn_mfma_f32_16x16x32_bf16((a), (b), (c), 0, 0, 0)

namespace pg8 {
constexpr int BM = 256, BK = 64, HALF = 128, HTB = HALF * BK * 2, STAGE_BYTES = 8 * HTB, NXCD = 8, WGM = 8;
__device__ __forceinline__ int lds_byte(int r, int c) { const int st = (r >> 4) * 2 + (c >> 5), rr = r & 15, cc = c & 31, ob = rr * 64 + cc * 2; return st * 1024 + (ob ^ (((ob >> 9) & 1) << 5)); }
__device__ __forceinline__ void stage_rc(int b, int& R, int& C) { const int st = b / 1024, sb = b % 1024, swz = sb ^ (((sb >> 9) & 1) << 5); R = (st >> 1) * 16 + swz / 64; C = (st & 1) * 32 + (swz % 64) / 2; }
__device__ __forceinline__ int perm32(int rho) { const int n = rho >> 4, i = rho & 15; return 8 * (i >> 2) + 4 * n + (i & 3); }
struct Unit { int pm, pn; };
struct Gemm { const bf16_t* A; const bf16_t* Bt; int M, N, K; };
struct StaticOrder {
    int nM, nN, nwg, G, c;
    __device__ void init(int M, int N, int G_, int c_) { nM = M / BM; nN = N / BM; nwg = nM * nN; G = G_; c = c_; }
    __device__ bool next(int i, Unit& u) const {
        const long L = (long)i * G + c; if (L >= nwg) return false;
        int wgid = (int)L; { const int q = nwg / NXCD, r = nwg % NXCD, xcd = wgid % NXCD, off = wgid / NXCD; wgid = (xcd < r ? xcd * (q + 1) : r * (q + 1) + (xcd - r) * q) + off; }
        const int nig = WGM * nN, gid = wgid / nig, fm = gid * WGM, gsz = (nM - fm) < WGM ? (nM - fm) : WGM;
        u.pm = fm + ((wgid % nig) % gsz); u.pn = (wgid % nig) / gsz; return true;
    }
};

enum { EM_BF16 = 0, EM_A1GLA = 1, EM_GATE = 2, EM_GLU = 3, EM_RESID = 4 };
struct Epi {
    int mode;
    bf16_t* o0; int ld0;
    bf16_t* qk; float* g; const float* gbias; bf16_t* mix;
    const float* part; const float* onw; int is_gla;
    const bf16_t* y5; const float* bglu;
    const float* xin; float* xout;
    __device__ __forceinline__ void operator()(const f32x4 (&acc)[2][2][4][2], const Unit& u, int wr, int wc, int fr, int fq) const {
        const int row0 = u.pm * BM + wr * 64 + fr;
        const int cb = u.pn * BM + wc * 32 + 8 * fq;
#define EPI_ROW(it) ((size_t)(row0 + ((it) >> 3) * HALF + (((it) >> 1) & 3) * 16))
#define EPI_COL(it) (cb + ((it) & 1) * HALF)
#define EPI_V0(it) acc[(it) >> 3][(it) & 1][((it) >> 1) & 3][0]
#define EPI_V1(it) acc[(it) >> 3][(it) & 1][((it) >> 1) & 3][1]
        if (mode == EM_BF16) {
#pragma unroll
            for (int it = 0; it < 16; ++it) { const f32x4 v0 = EPI_V0(it), v1 = EPI_V1(it);
                u32x4 o; o.x = pk2(v0[0], v0[1]); o.y = pk2(v0[2], v0[3]); o.z = pk2(v1[0], v1[1]); o.w = pk2(v1[2], v1[3]);
                *(u32x4*)(o0 + EPI_ROW(it) * ld0 + EPI_COL(it)) = o; }
        } else if (mode == EM_A1GLA) {
            if (u.pn < 4) {
                const float sc = (u.pn < 2) ? 0.08838834764831845f : 1.f;
#pragma unroll
                for (int it = 0; it < 16; ++it) { const f32x4 v0 = EPI_V0(it), v1 = EPI_V1(it);
                    u32x4 o; o.x = pk2(v0[0] * sc, v0[1] * sc); o.y = pk2(v0[2] * sc, v0[3] * sc); o.z = pk2(v1[0] * sc, v1[1] * sc); o.w = pk2(v1[2] * sc, v1[3] * sc);
                    *(u32x4*)(qk + EPI_ROW(it) * 1024 + EPI_COL(it)) = o; }
            } else if (u.pn < 6) {
                f32x4 bia[2][2];
#pragma unroll
                for (int bj = 0; bj < 2; ++bj) { bia[bj][0] = *(const f32x4*)(gbias + cb + bj * HALF - 1024); bia[bj][1] = *(const f32x4*)(gbias + cb + bj * HALF - 1024 + 4); }
#pragma unroll
                for (int it = 0; it < 16; ++it) { const f32x4 v0 = EPI_V0(it), v1 = EPI_V1(it); const int gc = EPI_COL(it) - 1024;
                    f32x4 r0, r1;
#pragma unroll
                    for (int e = 0; e < 4; ++e) {
                        const float x0 = v0[e] + bia[it & 1][0][e], x1 = v1[e] + bia[it & 1][1][e];
                        r0[e] = (fminf(x0, 0.f) - __logf(1.f + fexp(-fabsf(x0)))) * 0.0625f;
                        r1[e] = (fminf(x1, 0.f) - __logf(1.f + fexp(-fabsf(x1)))) * 0.0625f;
                    }
                    *(f32x4*)(g + EPI_ROW(it) * 512 + gc) = r0; *(f32x4*)(g + EPI_ROW(it) * 512 + gc + 4) = r1; }
            } else {
#pragma unroll
                for (int it = 0; it < 16; ++it) { const f32x4 v0 = EPI_V0(it), v1 = EPI_V1(it);
                    u32x4 o; o.x = pk2(v0[0], v0[1]); o.y = pk2(v0[2], v0[3]); o.z = pk2(v1[0], v1[1]); o.w = pk2(v1[2], v1[3]);
                    *(u32x4*)(mix + EPI_ROW(it) * 3072 + (EPI_COL(it) - 1536)) = o; }
            }
        } else if (mode == EM_GATE) {
            const bool nrm = is_gla && (cb < 2048);
            float rs[8]; f32x4 wv[2][2];
#pragma unroll
            for (int i = 0; i < 8; ++i) rs[i] = 1.f;
#pragma unroll
            for (int bj = 0; bj < 2; ++bj) { wv[bj][0] = (f32x4){1.f, 1.f, 1.f, 1.f}; wv[bj][1] = (f32x4){1.f, 1.f, 1.f, 1.f}; }
            if (nrm) {
#pragma unroll
                for (int i = 0; i < 8; ++i) {
                    const f32x4* pp = (const f32x4*)(part + (EPI_ROW(2 * i) * 4 + (cb >> 9)) * 16);
                    const f32x4 p0 = pp[0], p1 = pp[1], p2 = pp[2], p3 = pp[3];
                    const float ssum = ((p0[0] + p0[1]) + (p0[2] + p0[3])) + ((p1[0] + p1[1]) + (p1[2] + p1[3])) + ((p2[0] + p2[1]) + (p2[2] + p2[3])) + ((p3[0] + p3[1]) + (p3[2] + p3[3]));
                    rs[i] = rsqrtf(ssum * (1.f / 512.f) + EPSN);
                }
#pragma unroll
                for (int bj = 0; bj < 2; ++bj) { wv[bj][0] = *(const f32x4*)(onw + ((cb + bj * HALF) & 511)); wv[bj][1] = *(const f32x4*)(onw + ((cb + bj * HALF) & 511) + 4); }
            }
#pragma unroll
            for (int hb = 0; hb < 4; ++hb) {
            u32x4 mva[4];
#pragma unroll
            for (int i = 0; i < 4; ++i) mva[i] = *(const u32x4*)(mix + EPI_ROW(hb * 4 + i) * 3072 + EPI_COL(hb * 4 + i));
#pragma unroll
            for (int i = 0; i < 4; ++i) { const int it = hb * 4 + i;
                const u32x4 mv = mva[i];
                const f32x4 v0 = EPI_V0(it), v1 = EPI_V1(it);
                const float f[8] = { bflo(mv.x), bfhi(mv.x), bflo(mv.y), bfhi(mv.y), bflo(mv.z), bfhi(mv.z), bflo(mv.w), bfhi(mv.w) };
                const float r = rs[it >> 1];
                float y[8];
#pragma unroll
                for (int e = 0; e < 4; ++e) { y[e] = f[e] * (r * wv[it & 1][0][e]) * v0[e] * fsigmoid(v0[e]); y[4 + e] = f[4 + e] * (r * wv[it & 1][1][e]) * v1[e] * fsigmoid(v1[e]); }
                u32x4 o; o.x = pk2(y[0], y[1]); o.y = pk2(y[2], y[3]); o.z = pk2(y[4], y[5]); o.w = pk2(y[6], y[7]);
                st_global_b128(mix + EPI_ROW(it) * 3072 + EPI_COL(it), o);
            }
            }
        } else if (mode == EM_GLU) {
            f32x4 bia[2][2];
#pragma unroll
            for (int bj = 0; bj < 2; ++bj) { bia[bj][0] = *(const f32x4*)(bglu + cb + bj * HALF); bia[bj][1] = *(const f32x4*)(bglu + cb + bj * HALF + 4); }
#pragma unroll
            for (int hb = 0; hb < 2; ++hb) {
            u32x4 mva[8];
#pragma unroll
            for (int i = 0; i < 8; ++i) mva[i] = *(const u32x4*)(y5 + EPI_ROW(hb * 8 + i) * 2048 + EPI_COL(hb * 8 + i));
#pragma unroll
            for (int i = 0; i < 8; ++i) { const int it = hb * 8 + i;
                const u32x4 mv = mva[i];
                const f32x4 v0 = EPI_V0(it), v1 = EPI_V1(it);
                const float f[8] = { bflo(mv.x), bfhi(mv.x), bflo(mv.y), bfhi(mv.y), bflo(mv.z), bfhi(mv.z), bflo(mv.w), bfhi(mv.w) };
                float y[8];
#pragma unroll
                for (int e = 0; e < 4; ++e) { y[e] = f[e] * fsigmoid(v0[e] + bia[it & 1][0][e]); y[4 + e] = f[4 + e] * fsigmoid(v1[e] + bia[it & 1][1][e]); }
                u32x4 o; o.x = pk2(y[0], y[1]); o.y = pk2(y[2], y[3]); o.z = pk2(y[4], y[5]); o.w = pk2(y[6], y[7]);
                st_global_b128(mix + EPI_ROW(it) * 3072 + EPI_COL(it), o);
            }
            }
        } else {
#pragma unroll
            for (int hb = 0; hb < 4; ++hb) {
                f32x4 xa[4][2];
#pragma unroll
                for (int i = 0; i < 4; ++i) { const int it = hb * 4 + i; xa[i][0] = *(const f32x4*)(xin + EPI_ROW(it) * 1024 + EPI_COL(it)); xa[i][1] = *(const f32x4*)(xin + EPI_ROW(it) * 1024 + EPI_COL(it) + 4); }
#pragma unroll
                for (int i = 0; i < 4; ++i) { const int it = hb * 4 + i;
                    st_global_f128(xout + EPI_ROW(it) * 1024 + EPI_COL(it), xa[i][0] + EPI_V0(it)); st_global_f128(xout + EPI_ROW(it) * 1024 + EPI_COL(it) + 4, xa[i][1] + EPI_V1(it)); }
            }
        }
#undef EPI_ROW
#undef EPI_COL
#undef EPI_V0
#undef EPI_V1
    }
};

__device__ __forceinline__ void gemm_phase(LAS unsigned char* lds, const Gemm g, const StaticOrder& S, const Epi& E) {
    int tid_ = threadIdx.x; asm volatile("" : "+v"(tid_));
    const int tid = tid_, wid = __builtin_amdgcn_readfirstlane(tid >> 6), lane = tid & 63, wr = wid >> 2, wc = wid & 3, fr = lane & 15, fq = lane >> 4;
    const int K = g.K, nt = K / BK;
    unsigned voffA[2], voffB[2];
#pragma unroll
    for (int i = 0; i < 2; ++i) { int R, C; stage_rc(tid * 16 + i * 8192, R, C); const int Rb = (R & ~31) + perm32(R & 31);
        voffA[i] = (unsigned)(R * K + C) * 2u; voffB[i] = (unsigned)(Rb * K + C) * 2u; }
    const size_t kstep = (size_t)(BK * 2);
    const size_t hstep = (size_t)HALF * K * 2;
    const size_t tstep = 2 * hstep;
    const unsigned ldsw = (unsigned)wid * 1024u;
    const int aoff = lds_byte(wr * 64 + fr, fq * 8), boff = lds_byte(wc * 32 + fr, fq * 8);
#define PG8_SA(b, h) (((b) * 2 + (h)) * HTB)
#define PG8_SB(b, h) ((4 + (b) * 2 + (h)) * HTB)
#define PG8_STAGE(bufoff, gbase, voff) do { _Pragma("unroll") for (int _i = 0; _i < 2; ++_i) \
        __builtin_amdgcn_global_load_lds((const unsigned*)((const char*)(gbase) + (voff)[_i]), (LAS unsigned*)(lds + (bufoff) + ldsw + _i * 8192), 16, 0, 0); } while (0)
#define PG8_LDA(dst, b, h) do { _Pragma("unroll") for (int m = 0; m < 4; ++m) _Pragma("unroll") for (int k = 0; k < 2; ++k) dst[m][k] = *(const LAS bf16x8*)(lds + PG8_SA(b, h) + aoff + m * 2048 + k * 1024); } while (0)
#define PG8_LDB(dst, b, h) do { _Pragma("unroll") for (int n = 0; n < 2; ++n) _Pragma("unroll") for (int k = 0; k < 2; ++k) dst[n][k] = *(const LAS bf16x8*)(lds + PG8_SB(b, h) + boff + n * 2048 + k * 1024); } while (0)
#define PG8_MMA(ai, bj, At, Bt) do { __builtin_amdgcn_s_setprio(1); _Pragma("unroll") for (int m = 0; m < 4; ++m) _Pragma("unroll") for (int n = 0; n < 2; ++n) _Pragma("unroll") for (int k = 0; k < 2; ++k) \
        acc[ai][bj][m][n] = __builtin_amdgcn_mfma_f32_16x16x32_bf16(Bt[n][k], At[m][k], acc[ai][bj][m][n], 0, 0, 0); __builtin_amdgcn_s_setprio(0); } while (0)
#define PG8_WAIT_V(n) asm volatile("s_waitcnt vmcnt(" #n ")" ::: "memory")
#define PG8_WAIT_L(n) asm volatile("s_waitcnt lgkmcnt(" #n ")" ::: "memory")
#define PG8_BAR __builtin_amdgcn_s_barrier()
#define PG8_SCHED __builtin_amdgcn_sched_barrier(0)
    Unit cur, nxt; int ui = 0;
    if (!S.next(0, cur)) return;
    f32x4 acc[2][2][4][2];
#pragma unroll
    for (int a = 0; a < 2; ++a)
#pragma unroll
        for (int b = 0; b < 2; ++b)
#pragma unroll
            for (int m = 0; m < 4; ++m)
#pragma unroll
                for (int n = 0; n < 2; ++n) acc[a][b][m][n] = (f32x4){0.f, 0.f, 0.f, 0.f};
    bf16x8 At[4][2], B0[2][2], B1[2][2];
    const char* cA = (const char*)g.A + (size_t)cur.pm * tstep; const char* cB = (const char*)g.Bt + (size_t)cur.pn * tstep;
    PG8_STAGE(PG8_SB(0, 0), cB, voffB); PG8_STAGE(PG8_SA(0, 0), cA, voffA); PG8_STAGE(PG8_SB(0, 1), cB + hstep, voffB); PG8_STAGE(PG8_SA(0, 1), cA + hstep, voffA);
    if (wr == 1) PG8_BAR;
    PG8_WAIT_V(4); PG8_BAR;
    PG8_STAGE(PG8_SB(1, 0), cB + kstep, voffB); PG8_STAGE(PG8_SA(1, 0), cA + kstep, voffA); PG8_STAGE(PG8_SB(1, 1), cB + hstep + kstep, voffB);
    PG8_WAIT_V(6); PG8_BAR;
    for (;;) {
        const bool has_next = S.next(ui + 1, nxt);
        const char* nA = has_next ? (const char*)g.A + (size_t)nxt.pm * tstep : cA; const char* nB = has_next ? (const char*)g.Bt + (size_t)nxt.pn * tstep : cB;
        for (int t = 0; t < nt; t += 2) {
            const bool last = (t == nt - 2);
            const char* a1 = cA + (size_t)(t + 1) * kstep;
            const char* a2 = last ? nA : cA + (size_t)(t + 2) * kstep; const char* b2 = last ? nB : cB + (size_t)(t + 2) * kstep;
            const char* a3 = a2 + kstep; const char* b3 = b2 + kstep;
            PG8_LDB(B0, 0, 0); PG8_SCHED; PG8_LDA(At, 0, 0); PG8_STAGE(PG8_SA(1, 1), a1 + hstep, voffA);
            PG8_WAIT_L(8); PG8_BAR; PG8_WAIT_L(0); PG8_MMA(0, 0, At, B0); PG8_BAR; PG8_SCHED;
            PG8_LDB(B1, 0, 1); PG8_STAGE(PG8_SB(0, 0), b2, voffB);
            PG8_BAR; PG8_WAIT_L(0); PG8_MMA(0, 1, At, B1); PG8_BAR;
            PG8_LDA(At, 0, 1); PG8_STAGE(PG8_SA(0, 0), a2, voffA);
            PG8_BAR; PG8_WAIT_L(0); PG8_MMA(1, 0, At, B0); PG8_BAR; PG8_SCHED;
            PG8_STAGE(PG8_SB(0, 1), b2 + hstep, voffB);
            PG8_WAIT_V(6); PG8_BAR; PG8_MMA(1, 1, At, B1); PG8_BAR;
            PG8_LDB(B0, 1, 0); PG8_SCHED; PG8_LDA(At, 1, 0); PG8_STAGE(PG8_SA(0, 1), a2 + hstep, voffA);
            PG8_WAIT_L(8); PG8_BAR; PG8_WAIT_L(0); PG8_MMA(0, 0, At, B0); PG8_BAR; PG8_SCHED;
            PG8_LDB(B1, 1, 1); PG8_STAGE(PG8_SB(1, 0), b3, voffB);
            PG8_BAR; PG8_WAIT_L(0); PG8_MMA(0, 1, At, B1); PG8_BAR;
            PG8_LDA(At, 1, 1); PG8_STAGE(PG8_SA(1, 0), a3, voffA);
            PG8_BAR; PG8_WAIT_L(0); PG8_MMA(1, 0, At, B0); PG8_BAR; PG8_SCHED;
            PG8_STAGE(PG8_SB(1, 1), b3 + hstep, voffB);
            PG8_WAIT_V(6); PG8_BAR; PG8_MMA(1, 1, At, B1); PG8_BAR;
        }
        E(acc, cur, wr, wc, fr, fq);
        if (!has_next) break;
#pragma unroll
        for (int a = 0; a < 2; ++a)
#pragma unroll
            for (int b = 0; b < 2; ++b)
#pragma unroll
                for (int m = 0; m < 4; ++m)
#pragma unroll
                    for (int n = 0; n < 2; ++n) acc[a][b][m][n] = (f32x4){0.f, 0.f, 0.f, 0.f};
        cur = nxt; cA = nA; cB = nB; ++ui;
    }
    PG8_WAIT_V(0);
    if (wr == 0) PG8_BAR;
    PG8_BAR;
#undef PG8_SA
#undef PG8_SB
#undef PG8_STAGE
#undef PG8_LDA
#undef PG8_LDB
#undef PG8_MMA
#undef PG8_WAIT_V
#undef PG8_WAIT_L
#undef PG8_BAR
#undef PG8_SCHED
}
}

struct TJob { const float* src; int ld, K, c0, nc; bf16_t* dst; };
constexpr int N_TITEMS = 13824;

__device__ __forceinline__ void rms_rows(const float* x, const float* w, bf16_t* out_bf, float* out_f, int nrows, bool grouped = false) {
    int tid_ = threadIdx.x; asm volatile("" : "+v"(tid_));
    const int lane = tid_ & 63, wave = tid_ >> 6;
    int gw = blockIdx.x * 8 + wave, ngw = gridDim.x * 8;
    if (grouped) {
        const int per = nrows >> 3, lw = (int)(blockIdx.x >> 3) * 8 + wave, nlw = (int)(gridDim.x >> 3) * 8;
        x += (size_t)(blockIdx.x & 7) * per * 1024;
        if (out_bf) out_bf += (size_t)(blockIdx.x & 7) * per * 1024;
        if (out_f) out_f += (size_t)(blockIdx.x & 7) * per * 1024;
        nrows = per; gw = lw; ngw = nlw;
    }
    f32x4 wv[4];
#pragma unroll
    for (int j = 0; j < 4; ++j) wv[j] = ((const f32x4*)w)[lane + 64 * j];
    f32x4 vn[4];
    if (gw < nrows) {
        const f32x4* xr = (const f32x4*)(x + (size_t)gw * 1024) + lane;
#pragma unroll
        for (int j = 0; j < 4; ++j) vn[j] = xr[64 * j];
    }
    for (int r = gw; r < nrows; r += ngw) {
        f32x4 v[4];
#pragma unroll
        for (int j = 0; j < 4; ++j) v[j] = vn[j];
        const int rn = (r + ngw < nrows) ? r + ngw : r;
        {
            const f32x4* xr = (const f32x4*)(x + (size_t)rn * 1024) + lane;
#pragma unroll
            for (int j = 0; j < 4; ++j) vn[j] = xr[64 * j];
        }
        float s = 0.f;
#pragma unroll
        for (int j = 0; j < 4; ++j) s += (v[j][0] * v[j][0] + v[j][1] * v[j][1]) + (v[j][2] * v[j][2] + v[j][3] * v[j][3]);
        s = wave_sum(s);
        const float rs = rsqrtf(s * (1.f / 1024.f) + EPSN);
#pragma unroll
        for (int j = 0; j < 4; ++j) {
            f32x4 o; o[0] = v[j][0] * rs * wv[j][0]; o[1] = v[j][1] * rs * wv[j][1]; o[2] = v[j][2] * rs * wv[j][2]; o[3] = v[j][3] * rs * wv[j][3];
            if (out_bf) { u32x2 pk; pk.x = pk2(o[0], o[1]); pk.y = pk2(o[2], o[3]); st_global_b64(out_bf + (size_t)r * 1024 + (size_t)(lane + 64 * j) * 4, pk); }
            else st_global_f128(out_f + (size_t)r * 1024 + (size_t)(lane + 64 * j) * 4, o);
        }
    }
}

__device__ __forceinline__ void prep_phase(const Params& p, unsigned char* smem) {
    bf16_t* WT = (bf16_t*)(p.ws + WS_WT);
    float* tile = (float*)smem;
    int tid_ = threadIdx.x; asm volatile("" : "+v"(tid_)); const int tid = tid_;
    for (int it = blockIdx.x; it < N_TITEMS; it += gridDim.x) {
        int r = it; bool found = false; TJob jb; jb.src = nullptr; jb.ld = 0; jb.K = 0; jb.c0 = 0; jb.nc = 0; jb.dst = nullptr;
        auto tj = [&](const float* src, int ld, int K, int c0, int nc, bf16_t* dst) {
            if (!found) { const int ni = (K / 64) * (nc / 64); if (r < ni) { jb.src = src; jb.ld = ld; jb.K = K; jb.c0 = c0; jb.nc = nc; jb.dst = dst; found = true; } else r -= ni; } };
        for (int j = 0; j < 2; ++j) {
            const float* w = p.in[4] + (size_t)j * 1024 * GLA_IN_W; bf16_t* a1 = WT + j * WT_GLA_PER;
            tj(w, GLA_IN_W, 1024, 0, 1024, a1);
            tj(w, GLA_IN_W, 1024, 1024, 2048, a1 + (size_t)1536 * 1024);
            tj(w, GLA_IN_W, 1024, 6160, 1024, a1 + (size_t)3584 * 1024);
            tj(w, GLA_IN_W, 1024, 3088, 3072, a1 + WT_GLA_A2);
        }
        for (int j = 0; j < 2; ++j) {
            const float* w = p.in[8] + (size_t)j * 1024 * S5_IN_W; bf16_t* a1 = WT + WT_S5_BASE + j * WT_S5_PER;
            tj(w, S5_IN_W, 1024, 0, 2048, a1);
            tj(w, S5_IN_W, 1024, 5120, 1024, a1 + (size_t)2048 * 1024);
            tj(w, S5_IN_W, 1024, 2048, 3072, a1 + WT_S5_A2);
            tj(p.in[17] + (size_t)j * 2048 * 2048, 2048, 2048, 0, 2048, a1 + WT_S5_GLU);
        }
        for (int i = 0; i < 4; ++i) tj(p.in[20] + (size_t)i * 3072 * 1024, 1024, 3072, 0, 1024, WT + WT_OUT_BASE + i * WT_OUT_PER);
        for (int i = 0; i < 4; ++i) {
            const float* w = p.in[19] + (size_t)i * 1024 * 2048;
            tj(w, 2048, 1024, 0, 1024, WT + WT_K_BASE + (size_t)i * 1024 * 1024);
            tj(w, 2048, 1024, 1024, 1024, WT + WT_V_BASE + (size_t)i * 1024 * 1024);
        }
        if (found) {
            const int nblk = jb.nc / 64, kb = r / nblk, nb = r % nblk, k0 = kb * 64, n0 = nb * 64;
#pragma unroll
            for (int i = 0; i < 2; ++i) {
                const int kk = (tid >> 4) + 32 * i, c4 = (tid & 15) * 4;
                const f32x4 v = *(const f32x4*)(jb.src + (size_t)(k0 + kk) * jb.ld + jb.c0 + n0 + c4);
                tile[kk * 65 + c4 + 0] = v[0]; tile[kk * 65 + c4 + 1] = v[1]; tile[kk * 65 + c4 + 2] = v[2]; tile[kk * 65 + c4 + 3] = v[3];
            }
            __syncthreads();
            const int n = tid >> 3, kc = (tid & 7) * 8;
            u32x4 o;
            o.x = pk2(tile[(kc + 0) * 65 + n], tile[(kc + 1) * 65 + n]); o.y = pk2(tile[(kc + 2) * 65 + n], tile[(kc + 3) * 65 + n]);
            o.z = pk2(tile[(kc + 4) * 65 + n], tile[(kc + 5) * 65 + n]); o.w = pk2(tile[(kc + 6) * 65 + n], tile[(kc + 7) * 65 + n]);
            *(u32x4*)(jb.dst + (size_t)(n0 + n) * jb.K + k0 + kc) = o;
        }
        __syncthreads();
    }
    for (int idx = blockIdx.x * NTHREADS + tid; idx < 2 * 512 * 1024; idx += gridDim.x * NTHREADS) {
        const int j = idx >> 19, n = (idx >> 10) & 511, k = idx & 1023;
        const float* wr_ = p.in[4] + (size_t)j * 1024 * GLA_IN_W + (size_t)k * GLA_IN_W + 3072;
        const float* wg = p.in[5] + (size_t)j * 16 * 512 + n;
        float s = 0.f;
#pragma unroll
        for (int r = 0; r < 16; ++r) s += wr_[r] * wg[r * 512];
        WT[j * WT_GLA_PER + (size_t)(1024 + n) * 1024 + k] = bf1(s);
    }
    rms_rows(p.in[1], p.in[3], (bf16_t*)(p.ws + WS_MEMN), nullptr, 2048);
}

__device__ __forceinline__ void norm_phase(const Params& p, int layer) {
    const float* x = (layer == 0) ? p.in[0] : p.out;
    rms_rows(x, p.in[2] + layer * 1024, (bf16_t*)(p.ws + WS_H), nullptr, T_TOK, layer > 0);
    unsigned long long* ss = (unsigned long long*)(p.ws + WS_SUMSQ);
    for (int i = blockIdx.x * NTHREADS + threadIdx.x; i < T_TOK * 4; i += gridDim.x * NTHREADS) ss[i] = 0ull;
}

__device__ __forceinline__ void attn_phase(const Params& p, int layer, unsigned char* smem) {
    bf16_t* mix = (bf16_t*)(p.ws + WS_MIX);
    const bf16_t* kmem = (const bf16_t*)(p.ws + WS_KMEM);
    const bf16_t* vt = (const bf16_t*)(p.ws + WS_VT);
    bf16_t* KV = (bf16_t*)smem;
    bf16_t* PB = (bf16_t*)(smem + 67584);
    float* RS = (float*)(smem + 135168);
    int tid_ = threadIdx.x; asm volatile("" : "+v"(tid_));
    const int tid = tid_, wave = tid >> 6, lane = tid & 63, fr = lane & 15, fq = lane >> 4;
    const int sr = tid >> 5, sc8 = (tid & 31) * 8;
    u32x4 stg[8];
#define ATT_SRC(unit_, ti_) (((ti_) < 2) \
        ? (kmem + (size_t)((((unit_) >> 2) >> 6) * 256 + (ti_) * 128 + sr) * 4096 + layer * 1024 + ((unit_) & 3) * 256 + sc8) \
        : (vt + (size_t)(layer * 1024 + ((unit_) & 3) * 256 + ((ti_) - 2) * 128 + sr) * 2048 + (((unit_) >> 2) >> 6) * 256 + sc8))
#define ATT_LOAD(unit_, ti_) do { const bf16_t* sp_ = ATT_SRC(unit_, ti_); const size_t rp_ = ((ti_) < 2) ? (size_t)16 * 4096 : (size_t)16 * 2048; \
        _Pragma("unroll") for (int i = 0; i < 8; ++i) stg[i] = *(const u32x4*)(sp_ + i * rp_); } while (0)
#define ATT_STAGE() do { _Pragma("unroll") for (int i = 0; i < 8; ++i) *(u32x4*)(KV + (sr + 16 * i) * 264 + sc8) = stg[i]; } while (0)
    const int ab = blockIdx.x & 7, astep = (int)(gridDim.x >> 3);
#define ATT_UNIT(u_) ((((ab << 6) + ((u_) >> 2)) << 2) | ((u_) & 3))
    int au = blockIdx.x >> 3;
    int unit = (au < 256) ? ATT_UNIT(au) : 2048;
    if (unit < 2048) ATT_LOAD(unit, 0);
    __syncthreads();
    for (; au < 256; au += astep, unit = (au < 256) ? ATT_UNIT(au) : 2048) {
        const int h = unit & 3, tile = unit >> 2;
        const size_t t0 = (size_t)tile * 128;
        const int unext = (au + astep < 256) ? ATT_UNIT(au + astep) : unit;
        bf16x8 qf[8];
        {
            const bf16_t* qrow = mix + (t0 + wave * 16 + fr) * 3072 + 2048 + h * 256 + fq * 8;
#pragma unroll
            for (int ks = 0; ks < 8; ++ks) qf[ks] = *(const bf16x8*)(qrow + ks * 32);
        }
        f32x4 sacc[16];
#pragma unroll
        for (int half = 0; half < 2; ++half) {
            ATT_STAGE();
            LDS_BAR();
            ATT_LOAD(unit, half + 1);
#pragma unroll
            for (int mb = 0; mb < 8; ++mb) {
                f32x4 a = (f32x4){0.f, 0.f, 0.f, 0.f};
#pragma unroll
                for (int ks = 0; ks < 8; ++ks) { const bf16x8 bfr = *(const bf16x8*)(KV + (mb * 16 + fr) * 264 + ks * 32 + fq * 8); a = MFMA16(qf[ks], bfr, a); }
                sacc[half * 8 + mb] = a;
            }
            LDS_BAR();
        }
        const float sc = 0.0625f * L2E;
#pragma unroll
        for (int j = 0; j < 4; ++j) {
            float mx = sacc[0][j];
#pragma unroll
            for (int i = 1; i < 16; ++i) mx = fmaxf(mx, sacc[i][j]);
            mx = fmaxf(mx, __shfl_xor(mx, 1)); mx = fmaxf(mx, __shfl_xor(mx, 2)); mx = fmaxf(mx, __shfl_xor(mx, 4)); mx = fmaxf(mx, __shfl_xor(mx, 8));
            float sum = 0.f;
#pragma unroll
            for (int i = 0; i < 16; ++i) { const float e = __builtin_amdgcn_exp2f((sacc[i][j] - mx) * sc); sacc[i][j] = e; sum += e; }
            sum += __shfl_xor(sum, 1); sum += __shfl_xor(sum, 2); sum += __shfl_xor(sum, 4); sum += __shfl_xor(sum, 8);
            if (fr == 0) RS[wave * 16 + fq * 4 + j] = 1.f / sum;
#pragma unroll
            for (int i = 0; i < 16; ++i) PB[(wave * 16 + fq * 4 + j) * 264 + i * 16 + fr] = bf1(sacc[i][j]);
        }
        ATT_STAGE();
        LDS_BAR();
        bf16x8 pf[8];
#pragma unroll
        for (int ks = 0; ks < 8; ++ks) pf[ks] = *(const bf16x8*)(PB + (wave * 16 + fr) * 264 + ks * 32 + fq * 8);
        const float rinv = RS[wave * 16 + fr];
#pragma unroll
        for (int half = 0; half < 2; ++half) {
            if (half == 0) ATT_LOAD(unit, 3); else ATT_LOAD(unext, 0);
#pragma unroll
            for (int db = 0; db < 8; ++db) {
                f32x4 a = (f32x4){0.f, 0.f, 0.f, 0.f};
#pragma unroll
                for (int ks = 0; ks < 8; ++ks) { const bf16x8 bfr = *(const bf16x8*)(KV + (db * 16 + fr) * 264 + ks * 32 + fq * 8); a = MFMA16(bfr, pf[ks], a); }
                u32x2 o; o.x = pk2(a[0] * rinv, a[1] * rinv); o.y = pk2(a[2] * rinv, a[3] * rinv);
                st_global_b64(mix + (t0 + wave * 16 + fr) * 3072 + 2048 + h * 256 + half * 128 + db * 16 + fq * 4, o);
            }
            LDS_BAR();
            if (half == 0) { ATT_STAGE(); LDS_BAR(); }
        }
    }
#undef ATT_UNIT
#undef ATT_SRC
#undef ATT_LOAD
#undef ATT_STAGE
    asm volatile("s_waitcnt vmcnt(0)" ::: "memory");
    __syncthreads();
}

__device__ __forceinline__ void gla_pre_phase(const Params& p, unsigned char* smem, bool dry = false) {
    bf16_t* qk = (bf16_t*)(p.ws + WS_QK);
    unsigned char* Gb = p.ws + WS_G;
    float* BC = (float*)smem;
    float* SEG = (float*)(smem + 32768);
    float* BL = (float*)(smem + 32768 + 2048);
    bf16_t* QD = (bf16_t*)(smem + 35328);
    bf16_t* KI = QD + 64 * 136;
    bf16_t* KET = KI + 64 * 136;
    bf16_t* ATT = KET + 128 * 72;
    int tid_ = threadIdx.x; asm volatile("" : "+v"(tid_));
    const int tid = tid_, w = tid >> 6, lane = tid & 63, fr = lane & 15, fq = lane >> 4;
    const int cd = tid & 127, seg = tid >> 7;
    const int es = tid >> 3, dseg = tid & 7;
    const int cb = w >> 1;
    for (int pu = blockIdx.x >> 3; pu < 512; pu += (int)(gridDim.x >> 3)) {
        const int h = pu & 3, bc = (int)(blockIdx.x & 7) * 128 + (pu >> 2);
        const size_t t0 = (size_t)bc * 64;
        const float* G = (const float*)Gb;
        float gpre[16];
#pragma unroll
        for (int i = 0; i < 16; ++i) gpre[i] = G[(t0 + seg * 16 + i) * 512 + h * 128 + cd];
        bf16_t* qp = qk + (t0 + es) * 1024 + h * 128 + dseg * 16;
        const u32x4 q0 = *(const u32x4*)qp, q1 = *(const u32x4*)(qp + 8), k0 = *(const u32x4*)(qp + 512), k1 = *(const u32x4*)(qp + 520);
        float run = 0.f;
#pragma unroll
        for (int i = 0; i < 16; ++i) { run += gpre[i]; gpre[i] = run; }
        SEG[seg * 128 + cd] = run;
        __syncthreads();
        {
            const float s0 = SEG[cd], s1 = SEG[128 + cd], s2 = SEG[256 + cd];
            const float off = (seg > 0 ? s0 : 0.f) + (seg > 1 ? s1 : 0.f) + (seg > 2 ? s2 : 0.f);
#pragma unroll
            for (int i = 0; i < 16; ++i) BC[(seg * 16 + i) * 128 + cd] = gpre[i] + off;
            if (seg == 3) BL[cd] = run + off;
        }
        __syncthreads();
        {
            float bc_[16], bl[16];
#pragma unroll
            for (int e4 = 0; e4 < 4; ++e4) {
                const f32x4 t1 = *(const f32x4*)(BC + es * 128 + dseg * 16 + e4 * 4); const f32x4 t2 = *(const f32x4*)(BL + dseg * 16 + e4 * 4);
                bc_[e4 * 4 + 0] = t1[0]; bc_[e4 * 4 + 1] = t1[1]; bc_[e4 * 4 + 2] = t1[2]; bc_[e4 * 4 + 3] = t1[3];
                bl[e4 * 4 + 0] = t2[0]; bl[e4 * 4 + 1] = t2[1]; bl[e4 * 4 + 2] = t2[2]; bl[e4 * 4 + 3] = t2[3];
            }
            const unsigned qw[8] = { q0.x, q0.y, q0.z, q0.w, q1.x, q1.y, q1.z, q1.w };
            const unsigned kw[8] = { k0.x, k0.y, k0.z, k0.w, k1.x, k1.y, k1.z, k1.w };
            unsigned qo[8], ko[8];
#pragma unroll
            for (int e2 = 0; e2 < 8; ++e2) {
                const float e1a = fexp(bc_[2 * e2]), e1b = fexp(bc_[2 * e2 + 1]);
                const float ia = frcp(e1a), ib = frcp(e1b);
                const float e3a = fexp(bl[2 * e2] - bc_[2 * e2]), e3b = fexp(bl[2 * e2 + 1] - bc_[2 * e2 + 1]);
                const float qa = bflo(qw[e2]), qb = bfhi(qw[e2]), ka = bflo(kw[e2]), kb = bfhi(kw[e2]);
                qo[e2] = pk2(qa * e1a, qb * e1b);
                ko[e2] = pk2(ka * ia, kb * ib);
                const unsigned ke = pk2(ka * e3a, kb * e3b);
                KET[(dseg * 16 + 2 * e2) * 72 + es] = (bf16_t)(ke & 0xffffu);
                KET[(dseg * 16 + 2 * e2 + 1) * 72 + es] = (bf16_t)(ke >> 16);
            }
            u32x4 t; t.x = qo[0]; t.y = qo[1]; t.z = qo[2]; t.w = qo[3]; *(u32x4*)(QD + es * 136 + dseg * 16) = t; if (!dry) *(u32x4*)qp = t;
            t.x = qo[4]; t.y = qo[5]; t.z = qo[6]; t.w = qo[7]; *(u32x4*)(QD + es * 136 + dseg * 16 + 8) = t; if (!dry) *(u32x4*)(qp + 8) = t;
            t.x = ko[0]; t.y = ko[1]; t.z = ko[2]; t.w = ko[3]; *(u32x4*)(KI + es * 136 + dseg * 16) = t;
            t.x = ko[4]; t.y = ko[5]; t.z = ko[6]; t.w = ko[7]; *(u32x4*)(KI + es * 136 + dseg * 16 + 8) = t;
        }
        __syncthreads();
#pragma unroll
        for (int n = 0; n < 2; ++n) {
            const int sb = (w & 1) * 2 + n;
            f32x4 a = (f32x4){0.f, 0.f, 0.f, 0.f};
            if (sb <= cb) {
#pragma unroll
                for (int ks = 0; ks < 4; ++ks) {
                    const bf16x8 af = *(const bf16x8*)(QD + (cb * 16 + fr) * 136 + ks * 32 + fq * 8);
                    const bf16x8 bfr = *(const bf16x8*)(KI + (sb * 16 + fr) * 136 + ks * 32 + fq * 8);
                    a = MFMA16(af, bfr, a);
                }
            }
#pragma unroll
            for (int jj = 0; jj < 4; ++jj) {
                const int cc = cb * 16 + fq * 4 + jj, ss = sb * 16 + fr;
                ATT[cc * 72 + ss] = bf1(ss <= cc ? a[jj] : 0.f);
            }
        }
        __syncthreads();
        unsigned char* gbase = Gb + ((t0 * 512) + (size_t)h * 128) * 4;
#pragma unroll
        for (int i = 0; i < 2; ++i) {
            const int idx = tid + i * 512, d = idx >> 3, pc = idx & 7;
            const u32x4 v = *(const u32x4*)(KET + d * 72 + pc * 8);
            if (!dry) *(u32x4*)(gbase + (size_t)(d >> 2) * 2048 + (d & 3) * 128 + pc * 16) = v;
        }
        {
            const int c = tid >> 3, pc = tid & 7;
            const u32x4 v = *(const u32x4*)(ATT + c * 72 + pc * 8);
            if (!dry) *(u32x4*)(gbase + (size_t)(32 + (c >> 2)) * 2048 + (c & 3) * 128 + pc * 16) = v;
        }
        if (tid < 128 && !dry) *(float*)(gbase + (size_t)48 * 2048 + tid * 4) = fexp(BL[tid]);
        __syncthreads();
    }
}

__device__ __forceinline__ void gla_phase(const Params& p, unsigned char* smem, bool dry = false) {
    const unsigned char* qkb = p.ws + WS_QK;
    const unsigned char* Gb = p.ws + WS_G;
    bf16_t* mix = (bf16_t*)(p.ws + WS_MIX);
    float* part = (float*)(p.ws + WS_PART);
    bf16_t* ST = (bf16_t*)smem;
    bf16_t* VT = ST + 64 * 136;
    constexpr int OPB = 26624, OPSZ = 41984, O_KET = 0, O_QD = 16384, O_ATT = 32768, O_DEC = 40960;
    LAS unsigned char* lds = (LAS unsigned char*)smem;
    int tid_ = threadIdx.x; asm volatile("" : "+v"(tid_));
    const int tid = tid_, w = __builtin_amdgcn_readfirstlane(tid >> 6), lane = tid & 63, fr = lane & 15, fq = lane >> 4;
    const int es = tid >> 3, dseg = tid & 7;
    const int cb = w >> 1, wh = w & 1;
    const int crow = cb * 16 + fr;
    unsigned koff[2], qoff[2], aoff, doff;
#pragma unroll
    for (int i = 0; i < 2; ++i) {
        const int P = (2 * w + i) * 64 + lane;
        { const int r = P >> 3, s_ = P & 7, q = s_ ^ (r & 7); koff[i] = (unsigned)((r >> 2) * 2048 + (r & 3) * 128 + q * 16); }
        { const int r = P >> 4, s_ = P & 15, q = s_ ^ (r & 15); qoff[i] = (unsigned)(r * 2048 + q * 16); }
    }
    { const int P = w * 64 + lane, r = P >> 3, s_ = P & 7, q = s_ ^ (r & 7); aoff = (unsigned)((32 + (r >> 2)) * 2048 + (r & 3) * 128 + q * 16); }
    doff = (unsigned)(48 * 2048 + (lane & 31) * 16);
    int r_att[2], r_qd[4], r_ket[4][2], r_dec[4];
#pragma unroll
    for (int ks = 0; ks < 2; ++ks) r_att[ks] = O_ATT + (crow * 8 + ((ks * 4 + fq) ^ (crow & 7))) * 16;
#pragma unroll
    for (int ks = 0; ks < 4; ++ks) r_qd[ks] = O_QD + (crow * 16 + ((ks * 4 + fq) ^ (crow & 15))) * 16;
#pragma unroll
    for (int n = 0; n < 4; ++n) { const int d = (wh * 4 + n) * 16 + fr; r_dec[n] = O_DEC + d * 4;
#pragma unroll
        for (int ks = 0; ks < 2; ++ks) r_ket[n][ks] = O_KET + (d * 8 + ((ks * 4 + fq) ^ (d & 7))) * 16; }
    for (int unit = blockIdx.x; unit < 256; unit += gridDim.x) {
        const int ux = unit & 7, uy = unit >> 3;
        const int bh = ux * 4 + (uy >> 3), sl = uy & 7, h = bh & 3, b = bh >> 2;
        const size_t tb = (size_t)b * SEQ_L;
        f32x4 st[4];
#pragma unroll
        for (int n = 0; n < 4; ++n) st[n] = (f32x4){0.f, 0.f, 0.f, 0.f};
        u32x4 vpre;
#define GLA_DMA(t1, bufoff) do { const unsigned char* gb_ = Gb + (((t1) * 512) + (size_t)h * 128) * 4; const unsigned char* qb_ = qkb + (((t1) * 1024) + (size_t)h * 128) * 2; \
            _Pragma("unroll") for (int i = 0; i < 2; ++i) { \
                __builtin_amdgcn_global_load_lds((const unsigned*)(gb_ + koff[i]), (LAS unsigned*)(lds + (bufoff) + O_KET + (2 * w + i) * 1024), 16, 0, 0); \
                __builtin_amdgcn_global_load_lds((const unsigned*)(qb_ + qoff[i]), (LAS unsigned*)(lds + (bufoff) + O_QD + (2 * w + i) * 1024), 16, 0, 0); } \
            __builtin_amdgcn_global_load_lds((const unsigned*)(gb_ + aoff), (LAS unsigned*)(lds + (bufoff) + O_ATT + w * 1024), 16, 0, 0); \
            if (w == 7) __builtin_amdgcn_global_load_lds((const unsigned*)(gb_ + doff), (LAS unsigned*)(lds + (bufoff) + O_DEC), 16, 0, 0); } while (0)
#define GLA_LOAD_V(t1) vpre = *(const u32x4*)(mix + ((t1) + es) * 3072 + h * 512 + sl * 64 + dseg * 8)
        __syncthreads();
        GLA_DMA(tb, OPB); GLA_LOAD_V(tb);
        u32x2 po[2]; po[0] = (u32x2){0u, 0u}; po[1] = (u32x2){0u, 0u}; float pssq = 0.f;
        for (int c = 0; c < 128; ++c) {
            const size_t t0 = tb + (size_t)c * 64;
            const size_t tn = tb + (size_t)(c < 127 ? c + 1 : 127) * 64;
            const size_t tp = tb + (size_t)(c > 0 ? c - 1 : 0) * 64;
            const int bcur = OPB + (c & 1) * OPSZ, bnxt = OPB + ((c & 1) ^ 1) * OPSZ;
            const unsigned char* OB = smem + bcur;
            {
                const unsigned vw[4] = { vpre.x, vpre.y, vpre.z, vpre.w };
#pragma unroll
                for (int e2 = 0; e2 < 4; ++e2) {
                    VT[(dseg * 8 + 2 * e2) * 72 + es] = (bf16_t)(vw[e2] & 0xffffu);
                    VT[(dseg * 8 + 2 * e2 + 1) * 72 + es] = (bf16_t)(vw[e2] >> 16);
                }
#pragma unroll
                for (int n = 0; n < 4; ++n) {
                    const int db = wh * 4 + n;
#pragma unroll
                    for (int jj = 0; jj < 4; ++jj) ST[(cb * 16 + fq * 4 + jj) * 136 + db * 16 + fr] = bf1(st[n][jj]);
                }
            }
            asm volatile("s_waitcnt vmcnt(0) lgkmcnt(0)" ::: "memory"); __builtin_amdgcn_s_barrier(); asm volatile("" ::: "memory");
            if (!(dry && (PROBE_ABL & 1))) { GLA_DMA(tn, bnxt); GLA_LOAD_V(tn); }
            {
                bf16_t* op = mix + (tp + crow) * 3072 + h * 512 + sl * 64 + wh * 32 + fq * 4;
                if (!dry) { st_global_b64(op, po[0]); st_global_b64(op + 16, po[1]);
                st_global_b32(part + ((tp + crow) * 4 + h) * 16 + sl * 2 + wh, pssq); }
            }
            {
                bf16x8 A_vt[2];
#pragma unroll
                for (int ks = 0; ks < 2; ++ks) A_vt[ks] = *(const bf16x8*)(VT + (cb * 16 + fr) * 72 + ks * 32 + fq * 8);
#pragma unroll
                for (int n = 0; n < 4; ++n) {
                    const float dcn = *(const float*)(OB + r_dec[n]);
                    st[n][0] *= dcn; st[n][1] *= dcn; st[n][2] *= dcn; st[n][3] *= dcn;
#pragma unroll
                    for (int ks = 0; ks < 2; ++ks) st[n] = MFMA16(A_vt[ks], *(const bf16x8*)(OB + r_ket[n][ks]), st[n]);
                }
            }
            {
                bf16x8 A_att[2], A_qd[4];
#pragma unroll
                for (int ks = 0; ks < 2; ++ks) A_att[ks] = *(const bf16x8*)(OB + r_att[ks]);
#pragma unroll
                for (int ks = 0; ks < 4; ++ks) A_qd[ks] = *(const bf16x8*)(OB + r_qd[ks]);
                float ssq = 0.f;
#pragma unroll
                for (int n = 0; n < 2; ++n) {
                    const int eb = wh * 2 + n;
                    f32x4 a = (f32x4){0.f, 0.f, 0.f, 0.f};
#pragma unroll
                    for (int ks = 0; ks < 2; ++ks) { const bf16x8 bfr = *(const bf16x8*)(VT + (eb * 16 + fr) * 72 + ks * 32 + fq * 8); a = MFMA16(bfr, A_att[ks], a); }
#pragma unroll
                    for (int ks = 0; ks < 4; ++ks) { const bf16x8 bfr = *(const bf16x8*)(ST + (eb * 16 + fr) * 136 + ks * 32 + fq * 8); a = MFMA16(bfr, A_qd[ks], a); }
                    po[n].x = pk2(a[0], a[1]); po[n].y = pk2(a[2], a[3]);
                    ssq += (a[0] * a[0] + a[1] * a[1]) + (a[2] * a[2] + a[3] * a[3]);
                }
                ssq += __shfl_xor(ssq, 16); ssq += __shfl_xor(ssq, 32); pssq = ssq;
            }
            LDS_BAR();
        }
        {
            const size_t t0 = tb + (size_t)127 * 64;
            bf16_t* op = mix + (t0 + crow) * 3072 + h * 512 + sl * 64 + wh * 32 + fq * 4;
            if (!dry) { st_global_b64(op, po[0]); st_global_b64(op + 16, po[1]);
            st_global_b32(part + ((t0 + crow) * 4 + h) * 16 + sl * 2 + wh, pssq); }
        }
        asm volatile("s_waitcnt vmcnt(0)" ::: "memory");
#undef GLA_DMA
#undef GLA_LOAD_V
        __syncthreads();
    }
}

#define S5_BAR() LDS_BAR()
__device__ __forceinline__ void s5_phase(const Params& p, int j, unsigned char* smem) {
    const bf16_t* mix = (const bf16_t*)(p.ws + WS_MIX);
    bf16_t* y5 = (bf16_t*)(p.ws + WS_QK);
    int tid_ = threadIdx.x; asm volatile("" : "+v"(tid_));
    const int tid = tid_, w = __builtin_amdgcn_readfirstlane(tid >> 6), lane = tid & 63, fr = lane & 15, fq = lane >> 4;
    const int wp = w & 3;
    float* BUF = (float*)(smem + wp * 25600);
    bf16_t* XB = (bf16_t*)(smem + wp * 25600 + 8448);
    for (int ub = blockIdx.x; ub < 256; ub += gridDim.x) {
        const int b = ub & 7, g = (ub >> 3) * 4 + wp;
        const int jg = j * 128 + g;
        const float lr = p.in[9][jg * 64 + lane], li = p.in[10][jg * 64 + lane];
        const float dt = __expf(p.in[11][jg]);
        const float mag = __expf(lr * dt);
        float rev = li * dt * 0.15915494309189535f; rev -= floorf(rev);
        const float ar = mag * __builtin_amdgcn_cosf(rev), ai = mag * __builtin_amdgcn_sinf(rev);
        const size_t tb0 = (size_t)b * SEQ_L;
        if (w < 4) {
            float xr = 0.f, xi = 0.f; const float nai = -ai;
            S5_BAR();
            for (int step2 = 0; step2 < 512; step2 += 2) {
#pragma unroll
                for (int k = 0; k < 2; ++k) {
                    const float* BUFc = BUF + k * 3200; bf16_t* XBc = XB + k * 6400;
                    f32x2 bu[16];
#pragma unroll
                    for (int t = 0; t < 16; ++t) bu[t] = *(const f32x2*)(BUFc + t * 132 + 2 * lane);
#pragma unroll
                    for (int t = 0; t < 16; ++t) {
                        const float t1 = fma_s(nai, xi, bu[t][0]);
                        const float t2 = fma_s(ai, xr, bu[t][1]);
                        const float nxr = fma_s(ar, xr, t1);
                        const float nxi = fma_s(ar, xi, t2);
                        xr = nxr; xi = nxi;
                        *(unsigned*)(XBc + t * 136 + 2 * lane) = pk2(xr, xi);
                    }
                    S5_BAR();
                }
            }
        } else {
            const float nr = ar - 1.f, ni = ai, den = lr * lr + li * li;
            const float cre = (nr * lr + ni * li) / den, cim = (ni * lr - nr * li) / den;
            bf16x8 bbf[8];
#pragma unroll
            for (int nb = 0; nb < 8; ++nb) {
                const int pp = nb * 8 + (fr >> 1);
                const float c_re = __shfl(cre, pp), c_im = __shfl(cim, pp);
                const int fqc = fq & 1;
                const float* br = p.in[12] + ((size_t)jg * 64 + pp) * 16 + fqc * 8;
                const float* bi = p.in[13] + ((size_t)jg * 64 + pp) * 16 + fqc * 8;
                const f32x4 br0 = *(const f32x4*)br, br1 = *(const f32x4*)(br + 4), bi0 = *(const f32x4*)bi, bi1 = *(const f32x4*)(bi + 4);
                float v[8];
#pragma unroll
                for (int e = 0; e < 4; ++e) {
                    v[e] = (fr & 1) ? (c_re * bi0[e] + c_im * br0[e]) : (c_re * br0[e] - c_im * bi0[e]);
                    v[4 + e] = (fr & 1) ? (c_re * bi1[e] + c_im * br1[e]) : (c_re * br1[e] - c_im * bi1[e]);
                }
                u32x4 t; t.x = pk2(v[0], v[1]); t.y = pk2(v[2], v[3]); t.z = pk2(v[4], v[5]); t.w = pk2(v[6], v[7]);
                if (fq >= 2) { t.x = 0u; t.y = 0u; t.z = 0u; t.w = 0u; }
                bbf[nb] = __builtin_bit_cast(bf16x8, t);
            }
            bf16x8 cf[4];
#pragma unroll
            for (int ks = 0; ks < 4; ++ks) {
                const int pb = ks * 16 + fq * 4;
                const f32x4 cr = *(const f32x4*)(p.in[14] + ((size_t)jg * 16 + fr) * 64 + pb);
                const f32x4 ci = *(const f32x4*)(p.in[15] + ((size_t)jg * 16 + fr) * 64 + pb);
                u32x4 t; t.x = pk2(cr[0], -ci[0]); t.y = pk2(cr[1], -ci[1]); t.z = pk2(cr[2], -ci[2]); t.w = pk2(cr[3], -ci[3]);
                cf[ks] = __builtin_bit_cast(bf16x8, t);
            }
            const f32x4 dv = *(const f32x4*)(p.in[16] + j * 2048 + g * 16 + fq * 4);
            const bf16_t* ubase = mix + (tb0 + fr) * 3072 + g * 16;
            bf16_t* ybase = y5 + (tb0 + fr) * 2048 + g * 16 + fq * 4;
            const bool pad = (fq >= 2);
            u32x4 ufq[4]; u32x2 uoq[4];
            {
                u32x4 uf0 = *(const u32x4*)(ubase + (fq & 1) * 8);
                if (pad) { uf0.x = 0u; uf0.y = 0u; uf0.z = 0u; uf0.w = 0u; }
                const bf16x8 uf = __builtin_bit_cast(bf16x8, uf0);
#pragma unroll
                for (int nb = 0; nb < 8; ++nb) { const f32x4 a = MFMA16(bbf[nb], uf, ((f32x4){0.f, 0.f, 0.f, 0.f})); *(f32x4*)(BUF + fr * 132 + nb * 16 + fq * 4) = a; }
#pragma unroll
                for (int q = 1; q <= 4; ++q) ufq[q & 3] = *(const u32x4*)(ubase + (size_t)q * 16 * 3072 + (fq & 1) * 8);
#pragma unroll
                for (int q = 0; q < 3; ++q) uoq[q] = *(const u32x2*)(ubase + (size_t)q * 16 * 3072 + fq * 4);
                uoq[3] = uoq[0];
                S5_BAR();
            }
            for (int step4 = 0; step4 < 512; step4 += 4) {
#pragma unroll
                for (int k = 0; k < 4; ++k) {
                    const int step = step4 + k;
                    const int cur = k & 1, nxt = cur ^ 1;
                    float* BUFn = BUF + nxt * 3200; const bf16_t* XBn = XB + nxt * 6400;
                    u32x4 ufc = ufq[(k + 1) & 3]; if (pad) { ufc.x = 0u; ufc.y = 0u; ufc.z = 0u; ufc.w = 0u; }
                    { const int s5 = (step + 5 < 512) ? step + 5 : 511; ufq[(k + 1) & 3] = *(const u32x4*)(ubase + (size_t)s5 * 16 * 3072 + (fq & 1) * 8); }
                    const bf16x8 uf = __builtin_bit_cast(bf16x8, ufc);
                    f32x4 ya = (f32x4){0.f, 0.f, 0.f, 0.f};
#pragma unroll
                    for (int ks = 0; ks < 4; ++ks) { const bf16x8 xf = *(const bf16x8*)(XBn + fr * 136 + ks * 32 + fq * 8); ya = MFMA16(cf[ks], xf, ya); }
#pragma unroll
                    for (int nb = 0; nb < 8; ++nb) { const f32x4 a = MFMA16(bbf[nb], uf, ((f32x4){0.f, 0.f, 0.f, 0.f})); *(f32x4*)(BUFn + fr * 132 + nb * 16 + fq * 4) = a; }
                    const u32x2 uo = uoq[(k + 3) & 3];
                    { const int s3 = (step + 3 < 512) ? step + 3 : 511; uoq[(k + 3) & 3] = *(const u32x2*)(ubase + (size_t)s3 * 16 * 3072 + fq * 4); }
                    if (step > 0) {
                        const float u0 = bflo(uo.x), u1 = bfhi(uo.x), u2 = bflo(uo.y), u3 = bfhi(uo.y);
                        float yv[4] = { ya[0] + dv[0] * u0, ya[1] + dv[1] * u1, ya[2] + dv[2] * u2, ya[3] + dv[3] * u3 };
#pragma unroll
                        for (int e = 0; e < 4; ++e) { const float v = yv[e]; const float z = 0.7978845608028654f * (v + 0.044715f * v * v * v); yv[e] = v * fsigmoid(2.f * z); }
                        u32x2 o; o.x = pk2(yv[0], yv[1]); o.y = pk2(yv[2], yv[3]);
                        st_global_b64(ybase + (size_t)(step - 1) * 16 * 2048, o);
                    }
                    S5_BAR();
                }
            }
            {
                const u32x2 uo = uoq[3];
                const bf16_t* XBn = XB + 6400;
                f32x4 ya = (f32x4){0.f, 0.f, 0.f, 0.f};
#pragma unroll
                for (int ks = 0; ks < 4; ++ks) { const bf16x8 xf = *(const bf16x8*)(XBn + fr * 136 + ks * 32 + fq * 8); ya = MFMA16(cf[ks], xf, ya); }
                const float u0 = bflo(uo.x), u1 = bfhi(uo.x), u2 = bflo(uo.y), u3 = bfhi(uo.y);
                float yv[4] = { ya[0] + dv[0] * u0, ya[1] + dv[1] * u1, ya[2] + dv[2] * u2, ya[3] + dv[3] * u3 };
#pragma unroll
                for (int e = 0; e < 4; ++e) { const float v = yv[e]; const float z = 0.7978845608028654f * (v + 0.044715f * v * v * v); yv[e] = v * fsigmoid(2.f * z); }
                u32x2 o; o.x = pk2(yv[0], yv[1]); o.y = pk2(yv[2], yv[3]);
                st_global_b64(ybase + (size_t)511 * 16 * 2048, o);
            }
        }
        __syncthreads();
    }
    __syncthreads();
}

enum { K_PREP = 0, K_KV, K_NORM, K_A1, K_MIX, K_GLU, K_A2, K_A3, K_FINAL, K_MIXB };
constexpr int N_PHASES = 25;
__device__ __forceinline__ void decode_phase(int ph, int& kind, int& layer) {
    if (ph == 0) { kind = K_PREP; layer = 0; return; }
    if (ph >= 24) { kind = K_FINAL; layer = 0; return; }
    int q;
    if (ph < 6) { layer = 0; q = ph; } else { const int q0 = ph - 6; layer = 1 + q0 / 6; q = q0 - (layer - 1) * 6; }
    if (layer & 1) kind = (q == 0) ? K_NORM : (q == 1) ? K_A1 : (q == 2) ? K_MIX : (q == 3) ? K_GLU : (q == 4) ? K_A2 : K_A3;
    else kind = (q == 0) ? K_NORM : (q == 1) ? K_A1 : (q == 2) ? K_MIX : (q == 3) ? K_MIXB : (q == 4) ? K_A2 : K_A3;
}

__device__ __forceinline__ void run_phase(const Params& p, int ph, unsigned char* smem) {
    int kind, layer; decode_phase(ph, kind, layer);
    const int j = layer >> 1; const bool is_gla = !(layer & 1);
    bf16_t* WT = (bf16_t*)(p.ws + WS_WT);
    bf16_t* H = (bf16_t*)(p.ws + WS_H);
    bf16_t* MIX = (bf16_t*)(p.ws + WS_MIX);
#ifndef NO_PREP
    if (kind == K_PREP) { prep_phase(p, smem); norm_phase(p, 0); return; }
#endif
    if (kind == K_NORM) { norm_phase(p, layer); return; }
    if (kind == K_FINAL) { rms_rows(p.out, p.in[21], nullptr, p.out, T_TOK, true); return; }
    if (kind == K_MIX) {
        if (is_gla) { if (PROBE_DUP & 2) { gla_pre_phase(p, smem, true); __syncthreads(); } gla_pre_phase(p, smem); } else s5_phase(p, j, smem);
        __syncthreads();
        attn_phase(p, layer, smem);
        return;
    }
    if (kind == K_MIXB) { if (PROBE_DUP & 1) { gla_phase(p, smem, true); __syncthreads(); } gla_phase(p, smem); return; }
    const bool withkv = (kind == K_A1 && layer == 0);
    const int ngemm = withkv ? 3 : 1;
    for (int q = 0; q < ngemm; ++q) {
        pg8::Gemm g; pg8::Epi E;
        E.mode = pg8::EM_BF16; E.o0 = nullptr; E.ld0 = 0; E.qk = nullptr; E.g = nullptr; E.gbias = nullptr; E.mix = MIX; E.part = nullptr; E.onw = nullptr; E.is_gla = 0;
        E.y5 = nullptr; E.bglu = nullptr; E.xin = nullptr; E.xout = nullptr;
        int ord_c = (int)blockIdx.x;
        if (withkv && q < 2) {
            if (q == 1) ord_c = (int)((blockIdx.x + gridDim.x / 2) % gridDim.x);
            if (q == 0) { g.A = (const bf16_t*)(p.ws + WS_MEMN); g.Bt = WT + WT_K_BASE; g.M = 2048; g.N = 4096; g.K = 1024; E.o0 = (bf16_t*)(p.ws + WS_KMEM); E.ld0 = 4096; }
            else { g.A = WT + WT_V_BASE; g.Bt = (const bf16_t*)(p.ws + WS_MEMN); g.M = 4096; g.N = 2048; g.K = 1024; E.o0 = (bf16_t*)(p.ws + WS_VT); E.ld0 = 2048; }
        } else if (kind == K_A1) {
            g.A = H; g.M = T_TOK; g.K = 1024;
            if (is_gla) { g.Bt = WT + j * WT_GLA_PER; g.N = 4608; E.mode = pg8::EM_A1GLA; E.qk = (bf16_t*)(p.ws + WS_QK); E.g = (float*)(p.ws + WS_G); E.gbias = p.in[6] + j * 512; }
            else { g.Bt = WT + WT_S5_BASE + j * WT_S5_PER; g.N = 3072; E.o0 = MIX; E.ld0 = 3072; }
        } else if (kind == K_A2) {
            g.A = H; g.M = T_TOK; g.K = 1024; g.N = 3072;
            g.Bt = is_gla ? (WT + j * WT_GLA_PER + WT_GLA_A2) : (WT + WT_S5_BASE + j * WT_S5_PER + WT_S5_A2);
            E.mode = pg8::EM_GATE; E.part = (const float*)(p.ws + WS_PART); E.onw = p.in[7] + j * 512; E.is_gla = is_gla ? 1 : 0;
        } else if (kind == K_GLU) {
            g.A = (const bf16_t*)(p.ws + WS_QK); g.M = T_TOK; g.K = 2048; g.N = 2048; g.Bt = WT + WT_S5_BASE + j * WT_S5_PER + WT_S5_GLU;
            E.mode = pg8::EM_GLU; E.y5 = (const bf16_t*)(p.ws + WS_QK); E.bglu = p.in[18] + j * 2048;
        } else {
            g.A = MIX; g.M = T_TOK; g.K = 3072; g.N = 1024; g.Bt = WT + WT_OUT_BASE + layer * WT_OUT_PER;
            E.mode = pg8::EM_RESID; E.xin = (layer == 0) ? p.in[0] : p.out; E.xout = p.out;
        }
        pg8::StaticOrder S; S.init(g.M, g.N, (int)gridDim.x, ord_c);
#ifndef NO_GEMM
        pg8::gemm_phase((LAS unsigned char*)smem, g, S, E);
#endif
        __syncthreads();
    }
}

__device__ __forceinline__ void grid_barrier(unsigned* ctr, unsigned target) {
    asm volatile("s_waitcnt vmcnt(0)" ::: "memory");
    __syncthreads();
    if (threadIdx.x == 0) {
        __threadfence();
        atomicAdd(ctr, 1u);
        while (__hip_atomic_load(ctr, __ATOMIC_RELAXED, __HIP_MEMORY_SCOPE_AGENT) < target) __builtin_amdgcn_s_sleep(2);
        __threadfence();
    }
    __syncthreads();
}

__global__ void __launch_bounds__(NTHREADS, 2) mega(Params p) {
    extern __shared__ __attribute__((aligned(16))) unsigned char smem[];
    cg::grid_group grid = cg::this_grid();
    unsigned* ctr = (unsigned*)(p.ws + WS_CTL);
    unsigned nbar = 0, ngrp = 0;
    for (int ph = p.ph_lo; ph < p.ph_hi; ++ph) {
        run_phase(p, ph, smem);
        if (ph + 1 < p.ph_hi) {
            if (ph == p.ph_lo) { asm volatile("s_waitcnt vmcnt(0)" ::: "memory"); __syncthreads(); grid.sync(); }
            else if (ph == 1 || (gridDim.x & 7) != 0) { ++nbar; grid_barrier(ctr, nbar * gridDim.x); }
            else { ++ngrp; grid_barrier(ctr + 16 * (1 + (blockIdx.x & 7)), ngrp * (gridDim.x >> 3)); }
        }
    }
}

extern "C" void kernel_launch(void* const* d_in, const int* in_sizes, int n_in, void* d_out, int out_size, void* d_ws, size_t ws_size, hipStream_t stream) {
    static int grid = 0;
    if (grid == 0) {
        if (n_in != 22 || out_size != T_TOK * DM || ws_size < WS_END) {
            fprintf(stderr, "kernel_launch: unexpected shapes: n_in %d out %d ws %zu (need %zu)\n", n_in, out_size, ws_size, (size_t)WS_END); grid = -1; return; }
        int dev = 0, cus = 0, per_cu = 0;
        if (hipGetDevice(&dev) != hipSuccess || hipDeviceGetAttribute(&cus, hipDeviceAttributeMultiprocessorCount, dev) != hipSuccess) { grid = -1; return; }
        if (hipFuncSetAttribute((const void*)mega, hipFuncAttributeMaxDynamicSharedMemorySize, LDS_BYTES) != hipSuccess) { fprintf(stderr, "kernel_launch: hipFuncSetAttribute failed\n"); grid = -1; return; }
        if (hipOccupancyMaxActiveBlocksPerMultiprocessor(&per_cu, (const void*)mega, NTHREADS, LDS_BYTES) != hipSuccess || per_cu < 1) { fprintf(stderr, "kernel_launch: occupancy query says %d\n", per_cu); per_cu = 1; }
        (void)hipGetLastError();
        grid = cus * 1;
    }
    if (grid < 0) return;
    if (hipMemsetAsync((char*)d_ws + WS_CTL, 0, 1024, stream) != hipSuccess) { fprintf(stderr, "kernel_launch: memset failed\n"); return; }
    Params p{};
    for (int i = 0; i < 22; ++i) p.in[i] = (const float*)d_in[i];
    p.out = (float*)d_out; p.ws = (unsigned char*)d_ws;
#if MK_COOP
    p.ph_lo = 0; p.ph_hi = N_PHASES;
    void* args[] = { &p };
    hipError_t e = hipLaunchCooperativeKernel((const void*)mega, dim3(grid), dim3(NTHREADS), args, LDS_BYTES, stream);
    if (e != hipSuccess) fprintf(stderr, "cooperative launch failed: %s (grid %d)\n", hipGetErrorString(e), grid);
#else
    for (int ph = 0; ph < N_PHASES; ++ph) {
        p.ph_lo = ph; p.ph_hi = ph + 1;
        hipLaunchKernelGGL(mega, dim3(grid), dim3(NTHREADS), LDS_BYTES, stream, p);
    }
#endif
}
```

```cpp
#include <hip/hip_runtime.h>
#include <hip/hip_cooperative_groups.h>
#include <cstdio>
#include <cstdint>
namespace cg = cooperative_groups;

#ifndef MK_COOP
#define MK_COOP 1
#endif
#ifndef PROBE_DUP
#define PROBE_DUP 0
#endif
#ifndef PROBE_ABL
#define PROBE_ABL 0
#endif

#define LAS __attribute__((address_space(3)))
typedef unsigned short bf16_t;
typedef short bf16x8 __attribute__((ext_vector_type(8)));
typedef float f32x4 __attribute__((ext_vector_type(4)));
typedef float f32x2 __attribute__((ext_vector_type(2)));
typedef unsigned u32x4 __attribute__((ext_vector_type(4)));
typedef unsigned u32x2 __attribute__((ext_vector_type(2)));

constexpr int T_TOK = 65536;
constexpr int SEQ_L = 8192;
constexpr int DM = 1024;
constexpr int GLA_IN_W = 7184, S5_IN_W = 6144;
constexpr float EPSN = 1e-6f;
constexpr float L2E = 1.4426950408889634f;

constexpr size_t MiB = 1024ull * 1024ull;
constexpr size_t WS_H = 0;
constexpr size_t WS_QK = 128 * MiB;
constexpr size_t WS_G = 256 * MiB;
constexpr size_t WS_MIX = 384 * MiB;
constexpr size_t WS_KMEM = 768 * MiB;
constexpr size_t WS_VT = 784 * MiB;
constexpr size_t WS_MEMN = 800 * MiB;
constexpr size_t WS_SUMSQ = 804 * MiB;
constexpr size_t WS_CTL = 806 * MiB;
constexpr size_t WS_WT = 807 * MiB;
constexpr size_t WT_GLA_PER = (size_t)(4608 + 3072) * 1024;
constexpr size_t WT_GLA_A2 = (size_t)4608 * 1024;
constexpr size_t WT_S5_BASE = 2 * WT_GLA_PER;
constexpr size_t WT_S5_PER = (size_t)6144 * 1024 + (size_t)2048 * 2048;
constexpr size_t WT_S5_A2 = (size_t)3072 * 1024;
constexpr size_t WT_S5_GLU = (size_t)6144 * 1024;
constexpr size_t WT_OUT_BASE = WT_S5_BASE + 2 * WT_S5_PER;
constexpr size_t WT_OUT_PER = (size_t)1024 * 3072;
constexpr size_t WT_K_BASE = WT_OUT_BASE + 4 * WT_OUT_PER;
constexpr size_t WT_V_BASE = WT_K_BASE + (size_t)4096 * 1024;
constexpr size_t WT_TOTAL = WT_V_BASE + (size_t)4096 * 1024;
constexpr size_t WS_END = WS_WT + WT_TOTAL * 2;
constexpr size_t WS_PART = 920 * MiB;
static_assert(WS_END <= WS_PART && WS_PART + (size_t)T_TOK * 64 * 4 <= 1024 * MiB, "workspace map");

constexpr int LDS_BYTES = 144 * 1024;
constexpr int NTHREADS = 512;

struct Params {
    const float* in[22];
    float* out;
    unsigned char* ws;
    int ph_lo, ph_hi;
};

typedef __bf16 bf16x2_t __attribute__((ext_vector_type(2)));
__device__ __forceinline__ unsigned pk2(float lo, float hi) { f32x2 v = {lo, hi}; bf16x2_t b = __builtin_convertvector(v, bf16x2_t); return __builtin_bit_cast(unsigned, b); }
__device__ __forceinline__ bf16_t bf1(float v) { return (bf16_t)(pk2(v, 0.f) & 0xffffu); }
__device__ __forceinline__ float bflo(unsigned u) { return __uint_as_float(u << 16); }
__device__ __forceinline__ float bfhi(unsigned u) { return __uint_as_float(u & 0xffff0000u); }
__device__ __forceinline__ float wave_sum(float v) {
#pragma unroll
    for (int o = 1; o < 64; o <<= 1) v += __shfl_xor(v, o);
    return v;
}
__device__ __forceinline__ float fexp(float x) { return __builtin_amdgcn_exp2f(x * L2E); }
__device__ __forceinline__ float frcp(float x) { return __builtin_amdgcn_rcpf(x); }
__device__ __forceinline__ float fsigmoid(float x) { return frcp(1.f + fexp(-x)); }
__device__ __forceinline__ void wave_sync() { asm volatile("s_waitcnt lgkmcnt(0)" ::: "memory"); __builtin_amdgcn_wave_barrier(); }
#define LDS_BAR() do { asm volatile("s_waitcnt lgkmcnt(0)" ::: "memory"); __builtin_amdgcn_s_barrier(); asm volatile("" ::: "memory"); } while (0)
__device__ __forceinline__ void st_global_b64(void* ptr, u32x2 v) { asm volatile("global_store_dwordx2 %0, %1, off" :: "v"(ptr), "v"(v) : "memory"); }
__device__ __forceinline__ void st_global_b128(void* ptr, u32x4 v) { asm volatile("global_store_dwordx4 %0, %1, off\n\ts_nop 1" :: "v"(ptr), "v"(v) : "memory"); }
__device__ __forceinline__ void st_global_f128(void* ptr, f32x4 v) { asm volatile("global_store_dwordx4 %0, %1, off\n\ts_nop 1" :: "v"(ptr), "v"(v) : "memory"); }
__device__ __forceinline__ float fma_s(float a, float b, float c) { float d; asm("v_fma_f32 %0, %1, %2, %3" : "=v"(d) : "v"(a), "v"(b), "v"(c)); return d; }
__device__ __forceinline__ void st_global_b32(void* ptr, float v) { asm volatile("global_store_dword %0, %1, off" :: "v"(ptr), "v"(v) : "memory"); }
__device__ __forceinline__ void atomic_add_u64_noret(unsigned long long* ptr, unsigned long long v) { asm volatile("global_atomic_add_x2 %0, %1, off" :: "v"(ptr), "v"(v) : "memory"); }
#define MFMA16(a, b, c) __builtin_amdgcn_mfma_f32_16x16x32_bf16((a), (b), (c), 0, 0, 0)

namespace pg8 {
constexpr int BM = 256, BK = 64, HALF = 128, HTB = HALF * BK * 2, STAGE_BYTES = 8 * HTB, NXCD = 8, WGM = 8;
__device__ __forceinline__ int lds_byte(int r, int c) { const int st = (r >> 4) * 2 + (c >> 5), rr = r & 15, cc = c & 31, ob = rr * 64 + cc * 2; return st * 1024 + (ob ^ (((ob >> 9) & 1) << 5)); }
__device__ __forceinline__ void stage_rc(int b, int& R, int& C) { const int st = b / 1024, sb = b % 1024, swz = sb ^ (((sb >> 9) & 1) << 5); R = (st >> 1) * 16 + swz / 64; C = (st & 1) * 32 + (swz % 64) / 2; }
__device__ __forceinline__ int perm32(int rho) { const int n = rho >> 4, i = rho & 15; return 8 * (i >> 2) + 4 * n + (i & 3); }
struct Unit { int pm, pn; };
struct Gemm { const bf16_t* A; const bf16_t* Bt; int M, N, K; };
struct StaticOrder {
    int nM, nN, nwg, G, c;
    __device__ void init(int M, int N, int G_, int c_) { nM = M / BM; nN = N / BM; nwg = nM * nN; G = G_; c = c_; }
    __device__ bool next(int i, Unit& u) const {
        const long L = (long)i * G + c; if (L >= nwg) return false;
        int wgid = (int)L; { const int q = nwg / NXCD, r = nwg % NXCD, xcd = wgid % NXCD, off = wgid / NXCD; wgid = (xcd < r ? xcd * (q + 1) : r * (q + 1) + (xcd - r) * q) + off; }
        const int nig = WGM * nN, gid = wgid / nig, fm = gid * WGM, gsz = (nM - fm) < WGM ? (nM - fm) : WGM;
        u.pm = fm + ((wgid % nig) % gsz); u.pn = (wgid % nig) / gsz; return true;
    }
};

enum { EM_BF16 = 0, EM_A1GLA = 1, EM_GATE = 2, EM_GLU = 3, EM_RESID = 4 };
struct Epi {
    int mode;
    bf16_t* o0; int ld0;
    bf16_t* qk; float* g; const float* gbias; bf16_t* mix;
    const float* part; const float* onw; int is_gla;
    const bf16_t* y5; const float* bglu;
    const float* xin; float* xout;
    __device__ __forceinline__ void operator()(const f32x4 (&acc)[2][2][4][2], const Unit& u, int wr, int wc, int fr, int fq) const {
        const int row0 = u.pm * BM + wr * 64 + fr;
        const int cb = u.pn * BM + wc * 32 + 8 * fq;
#define EPI_ROW(it) ((size_t)(row0 + ((it) >> 3) * HALF + (((it) >> 1) & 3) * 16))
#define EPI_COL(it) (cb + ((it) & 1) * HALF)
#define EPI_V0(it) acc[(it) >> 3][(it) & 1][((it) >> 1) & 3][0]
#define EPI_V1(it) acc[(it) >> 3][(it) & 1][((it) >> 1) & 3][1]
        if (mode == EM_BF16) {
#pragma unroll
            for (int it = 0; it < 16; ++it) { const f32x4 v0 = EPI_V0(it), v1 = EPI_V1(it);
                u32x4 o; o.x = pk2(v0[0], v0[1]); o.y = pk2(v0[2], v0[3]); o.z = pk2(v1[0], v1[1]); o.w = pk2(v1[2], v1[3]);
                *(u32x4*)(o0 + EPI_ROW(it) * ld0 + EPI_COL(it)) = o; }
        } else if (mode == EM_A1GLA) {
            if (u.pn < 4) {
                const float sc = (u.pn < 2) ? 0.08838834764831845f : 1.f;
#pragma unroll
                for (int it = 0; it < 16; ++it) { const f32x4 v0 = EPI_V0(it), v1 = EPI_V1(it);
                    u32x4 o; o.x = pk2(v0[0] * sc, v0[1] * sc); o.y = pk2(v0[2] * sc, v0[3] * sc); o.z = pk2(v1[0] * sc, v1[1] * sc); o.w = pk2(v1[2] * sc, v1[3] * sc);
                    *(u32x4*)(qk + EPI_ROW(it) * 1024 + EPI_COL(it)) = o; }
            } else if (u.pn < 6) {
                f32x4 bia[2][2];
#pragma unroll
                for (int bj = 0; bj < 2; ++bj) { bia[bj][0] = *(const f32x4*)(gbias + cb + bj * HALF - 1024); bia[bj][1] = *(const f32x4*)(gbias + cb + bj * HALF - 1024 + 4); }
#pragma unroll
                for (int it = 0; it < 16; ++it) { const f32x4 v0 = EPI_V0(it), v1 = EPI_V1(it); const int gc = EPI_COL(it) - 1024;
                    f32x4 r0, r1;
#pragma unroll
                    for (int e = 0; e < 4; ++e) {
                        const float x0 = v0[e] + bia[it & 1][0][e], x1 = v1[e] + bia[it & 1][1][e];
                        r0[e] = (fminf(x0, 0.f) - __logf(1.f + fexp(-fabsf(x0)))) * 0.0625f;
                        r1[e] = (fminf(x1, 0.f) - __logf(1.f + fexp(-fabsf(x1)))) * 0.0625f;
                    }
                    *(f32x4*)(g + EPI_ROW(it) * 512 + gc) = r0; *(f32x4*)(g + EPI_ROW(it) * 512 + gc + 4) = r1; }
            } else {
#pragma unroll
                for (int it = 0; it < 16; ++it) { const f32x4 v0 = EPI_V0(it), v1 = EPI_V1(it);
                    u32x4 o; o.x = pk2(v0[0], v0[1]); o.y = pk2(v0[2], v0[3]); o.z = pk2(v1[0], v1[1]); o.w = pk2(v1[2], v1[3]);
                    *(u32x4*)(mix + EPI_ROW(it) * 3072 + (EPI_COL(it) - 1536)) = o; }
            }
        } else if (mode == EM_GATE) {
            const bool nrm = is_gla && (cb < 2048);
            float rs[8]; f32x4 wv[2][2];
#pragma unroll
            for (int i = 0; i < 8; ++i) rs[i] = 1.f;
#pragma unroll
            for (int bj = 0; bj < 2; ++bj) { wv[bj][0] = (f32x4){1.f, 1.f, 1.f, 1.f}; wv[bj][1] = (f32x4){1.f, 1.f, 1.f, 1.f}; }
            if (nrm) {
#pragma unroll
                for (int i = 0; i < 8; ++i) {
                    const f32x4* pp = (const f32x4*)(part + (EPI_ROW(2 * i) * 4 + (cb >> 9)) * 16);
                    const f32x4 p0 = pp[0], p1 = pp[1], p2 = pp[2], p3 = pp[3];
                    const float ssum = ((p0[0] + p0[1]) + (p0[2] + p0[3])) + ((p1[0] + p1[1]) + (p1[2] + p1[3])) + ((p2[0] + p2[1]) + (p2[2] + p2[3])) + ((p3[0] + p3[1]) + (p3[2] + p3[3]));
                    rs[i] = rsqrtf(ssum * (1.f / 512.f) + EPSN);
                }
#pragma unroll
                for (int bj = 0; bj < 2; ++bj) { wv[bj][0] = *(const f32x4*)(onw + ((cb + bj * HALF) & 511)); wv[bj][1] = *(const f32x4*)(onw + ((cb + bj * HALF) & 511) + 4); }
            }
#pragma unroll
            for (int hb = 0; hb < 4; ++hb) {
            u32x4 mva[4];
#pragma unroll
            for (int i = 0; i < 4; ++i) mva[i] = *(const u32x4*)(mix + EPI_ROW(hb * 4 + i) * 3072 + EPI_COL(hb * 4 + i));
#pragma unroll
            for (int i = 0; i < 4; ++i) { const int it = hb * 4 + i;
                const u32x4 mv = mva[i];
                const f32x4 v0 = EPI_V0(it), v1 = EPI_V1(it);
                const float f[8] = { bflo(mv.x), bfhi(mv.x), bflo(mv.y), bfhi(mv.y), bflo(mv.z), bfhi(mv.z), bflo(mv.w), bfhi(mv.w) };
                const float r = rs[it >> 1];
                float y[8];
#pragma unroll
                for (int e = 0; e < 4; ++e) { y[e] = f[e] * (r * wv[it & 1][0][e]) * v0[e] * fsigmoid(v0[e]); y[4 + e] = f[4 + e] * (r * wv[it & 1][1][e]) * v1[e] * fsigmoid(v1[e]); }
                u32x4 o; o.x = pk2(y[0], y[1]); o.y = pk2(y[2], y[3]); o.z = pk2(y[4], y[5]); o.w = pk2(y[6], y[7]);
                st_global_b128(mix + EPI_ROW(it) * 3072 + EPI_COL(it), o);
            }
            }
        } else if (mode == EM_GLU) {
            f32x4 bia[2][2];
#pragma unroll
            for (int bj = 0; bj < 2; ++bj) { bia[bj][0] = *(const f32x4*)(bglu + cb + bj * HALF); bia[bj][1] = *(const f32x4*)(bglu + cb + bj * HALF + 4); }
#pragma unroll
            for (int hb = 0; hb < 2; ++hb) {
            u32x4 mva[8];
#pragma unroll
            for (int i = 0; i < 8; ++i) mva[i] = *(const u32x4*)(y5 + EPI_ROW(hb * 8 + i) * 2048 + EPI_COL(hb * 8 + i));
#pragma unroll
            for (int i = 0; i < 8; ++i) { const int it = hb * 8 + i;
                const u32x4 mv = mva[i];
                const f32x4 v0 = EPI_V0(it), v1 = EPI_V1(it);
                const float f[8] = { bflo(mv.x), bfhi(mv.x), bflo(mv.y), bfhi(mv.y), bflo(mv.z), bfhi(mv.z), bflo(mv.w), bfhi(mv.w) };
                float y[8];
#pragma unroll
                for (int e = 0; e < 4; ++e) { y[e] = f[e] * fsigmoid(v0[e] + bia[it & 1][0][e]); y[4 + e] = f[4 + e] * fsigmoid(v1[e] + bia[it & 1][1][e]); }
                u32x4 o; o.x = pk2(y[0], y[1]); o.y = pk2(y[2], y[3]); o.z = pk2(y[4], y[5]); o.w = pk2(y[6], y[7]);
                st_global_b128(mix + EPI_ROW(it) * 3072 + EPI_COL(it), o);
            }
            }
        } else {
#pragma unroll
            for (int hb = 0; hb < 4; ++hb) {
                f32x4 xa[4][2];
#pragma unroll
                for (int i = 0; i < 4; ++i) { const int it = hb * 4 + i; xa[i][0] = *(const f32x4*)(xin + EPI_ROW(it) * 1024 + EPI_COL(it)); xa[i][1] = *(const f32x4*)(xin + EPI_ROW(it) * 1024 + EPI_COL(it) + 4); }
#pragma unroll
                for (int i = 0; i < 4; ++i) { const int it = hb * 4 + i;
                    st_global_f128(xout + EPI_ROW(it) * 1024 + EPI_COL(it), xa[i][0] + EPI_V0(it)); st_global_f128(xout + EPI_ROW(it) * 1024 + EPI_COL(it) + 4, xa[i][1] + EPI_V1(it)); }
            }
        }
#undef EPI_ROW
#undef EPI_COL
#undef EPI_V0
#undef EPI_V1
    }
};

__device__ __forceinline__ void gemm_phase(LAS unsigned char* lds, const Gemm g, const StaticOrder& S, const Epi& E) {
    int tid_ = threadIdx.x; asm volatile("" : "+v"(tid_));
    const int tid = tid_, wid = __builtin_amdgcn_readfirstlane(tid >> 6), lane = tid & 63, wr = wid >> 2, wc = wid & 3, fr = lane & 15, fq = lane >> 4;
    const int K = g.K, nt = K / BK;
    unsigned voffA[2], voffB[2];
#pragma unroll
    for (int i = 0; i < 2; ++i) { int R, C; stage_rc(tid * 16 + i * 8192, R, C); const int Rb = (R & ~31) + perm32(R & 31);
        voffA[i] = (unsigned)(R * K + C) * 2u; voffB[i] = (unsigned)(Rb * K + C) * 2u; }
    const size_t kstep = (size_t)(BK * 2);
    const size_t hstep = (size_t)HALF * K * 2;
    const size_t tstep = 2 * hstep;
    const unsigned ldsw = (unsigned)wid * 1024u;
    const int aoff = lds_byte(wr * 64 + fr, fq * 8), boff = lds_byte(wc * 32 + fr, fq * 8);
#define PG8_SA(b, h) (((b) * 2 + (h)) * HTB)
#define PG8_SB(b, h) ((4 + (b) * 2 + (h)) * HTB)
#define PG8_STAGE(bufoff, gbase, voff) do { _Pragma("unroll") for (int _i = 0; _i < 2; ++_i) \
        __builtin_amdgcn_global_load_lds((const unsigned*)((const char*)(gbase) + (voff)[_i]), (LAS unsigned*)(lds + (bufoff) + ldsw + _i * 8192), 16, 0, 0); } while (0)
#define PG8_LDA(dst, b, h) do { _Pragma("unroll") for (int m = 0; m < 4; ++m) _Pragma("unroll") for (int k = 0; k < 2; ++k) dst[m][k] = *(const LAS bf16x8*)(lds + PG8_SA(b, h) + aoff + m * 2048 + k * 1024); } while (0)
#define PG8_LDB(dst, b, h) do { _Pragma("unroll") for (int n = 0; n < 2; ++n) _Pragma("unroll") for (int k = 0; k < 2; ++k) dst[n][k] = *(const LAS bf16x8*)(lds + PG8_SB(b, h) + boff + n * 2048 + k * 1024); } while (0)
#define PG8_MMA(ai, bj, At, Bt) do { __builtin_amdgcn_s_setprio(1); _Pragma("unroll") for (int m = 0; m < 4; ++m) _Pragma("unroll") for (int n = 0; n < 2; ++n) _Pragma("unroll") for (int k = 0; k < 2; ++k) \
        acc[ai][bj][m][n] = __builtin_amdgcn_mfma_f32_16x16x32_bf16(Bt[n][k], At[m][k], acc[ai][bj][m][n], 0, 0, 0); __builtin_amdgcn_s_setprio(0); } while (0)
#define PG8_WAIT_V(n) asm volatile("s_waitcnt vmcnt(" #n ")" ::: "memory")
#define PG8_WAIT_L(n) asm volatile("s_waitcnt lgkmcnt(" #n ")" ::: "memory")
#define PG8_BAR __builtin_amdgcn_s_barrier()
#define PG8_SCHED __builtin_amdgcn_sched_barrier(0)
    Unit cur, nxt; int ui = 0;
    if (!S.next(0, cur)) return;
    f32x4 acc[2][2][4][2];
#pragma unroll
    for (int a = 0; a < 2; ++a)
#pragma unroll
        for (int b = 0; b < 2; ++b)
#pragma unroll
            for (int m = 0; m < 4; ++m)
#pragma unroll
                for (int n = 0; n < 2; ++n) acc[a][b][m][n] = (f32x4){0.f, 0.f, 0.f, 0.f};
    bf16x8 At[4][2], B0[2][2], B1[2][2];
    const char* cA = (const char*)g.A + (size_t)cur.pm * tstep; const char* cB = (const char*)g.Bt + (size_t)cur.pn * tstep;
    PG8_STAGE(PG8_SB(0, 0), cB, voffB); PG8_STAGE(PG8_SB(0, 1), cB + hstep, voffB); PG8_STAGE(PG8_SA(0, 0), cA, voffA); PG8_STAGE(PG8_SA(0, 1), cA + hstep, voffA);
    if (wr == 1) PG8_BAR;
    PG8_WAIT_V(2); PG8_BAR;
    PG8_STAGE(PG8_SB(1, 0), cB + kstep, voffB); PG8_STAGE(PG8_SA(1, 0), cA + kstep, voffA); PG8_STAGE(PG8_SB(1, 1), cB + hstep + kstep, voffB);
    PG8_WAIT_V(6); PG8_BAR;
    for (;;) {
        const bool has_next = S.next(ui + 1, nxt);
        const char* nA = has_next ? (const char*)g.A + (size_t)nxt.pm * tstep : cA; const char* nB = has_next ? (const char*)g.Bt + (size_t)nxt.pn * tstep : cB;
        for (int t = 0; t < nt; t += 2) {
            const bool last = (t == nt - 2);
            const char* a1 = cA + (size_t)(t + 1) * kstep;
            const char* a2 = last ? nA : cA + (size_t)(t + 2) * kstep; const char* b2 = last ? nB : cB + (size_t)(t + 2) * kstep;
            const char* a3 = a2 + kstep; const char* b3 = b2 + kstep;
            PG8_LDB(B0, 0, 0); PG8_LDB(B1, 0, 1); PG8_SCHED; PG8_LDA(At, 0, 0); PG8_STAGE(PG8_SA(1, 1), a1 + hstep, voffA);
            PG8_WAIT_V(8); PG8_WAIT_L(0); PG8_BAR; PG8_MMA(0, 0, At, B0); PG8_MMA(0, 1, At, B1); PG8_BAR; PG8_SCHED;
            PG8_LDA(At, 0, 1); PG8_STAGE(PG8_SB(0, 0), b2, voffB); PG8_STAGE(PG8_SB(0, 1), b2 + hstep, voffB); PG8_STAGE(PG8_SA(0, 0), a2, voffA);
            PG8_WAIT_V(8); PG8_WAIT_L(0); PG8_BAR; PG8_MMA(1, 0, At, B0); PG8_MMA(1, 1, At, B1); PG8_BAR; PG8_SCHED;
            PG8_LDB(B0, 1, 0); PG8_LDB(B1, 1, 1); PG8_SCHED; PG8_LDA(At, 1, 0); PG8_STAGE(PG8_SA(0, 1), a2 + hstep, voffA);
            PG8_WAIT_V(8); PG8_WAIT_L(0); PG8_BAR; PG8_MMA(0, 0, At, B0); PG8_MMA(0, 1, At, B1); PG8_BAR; PG8_SCHED;
            PG8_LDA(At, 1, 1); PG8_STAGE(PG8_SB(1, 0), b3, voffB); PG8_STAGE(PG8_SB(1, 1), b3 + hstep, voffB); PG8_STAGE(PG8_SA(1, 0), a3, voffA);
            PG8_WAIT_V(8); PG8_WAIT_L(0); PG8_BAR; PG8_MMA(1, 0, At, B0); PG8_MMA(1, 1, At, B1); PG8_BAR; PG8_SCHED;
        }
        if (wr == 0) PG8_BAR;
        E(acc, cur, wr, wc, fr, fq);
        if (!has_next) break;
#pragma unroll
        for (int a = 0; a < 2; ++a)
#pragma unroll
            for (int b = 0; b < 2; ++b)
#pragma unroll
                for (int m = 0; m < 4; ++m)
#pragma unroll
                    for (int n = 0; n < 2; ++n) acc[a][b][m][n] = (f32x4){0.f, 0.f, 0.f, 0.f};
        cur = nxt; cA = nA; cB = nB; ++ui;
        if (wr == 1) PG8_BAR;
    }
    PG8_WAIT_V(0);
    PG8_BAR;
#undef PG8_SA
#undef PG8_SB
#undef PG8_STAGE
#undef PG8_LDA
#undef PG8_LDB
#undef PG8_MMA
#undef PG8_WAIT_V
#undef PG8_WAIT_L
#undef PG8_BAR
#undef PG8_SCHED
}
}

struct TJob { const float* src; int ld, K, c0, nc; bf16_t* dst; };
constexpr int N_TITEMS = 13824;

__device__ __forceinline__ void rms_rows(const float* x, const float* w, bf16_t* out_bf, float* out_f, int nrows, bool grouped = false) {
    int tid_ = threadIdx.x; asm volatile("" : "+v"(tid_));
    const int lane = tid_ & 63, wave = tid_ >> 6;
    int gw = blockIdx.x * 8 + wave, ngw = gridDim.x * 8;
    if (grouped) {
        const int per = nrows >> 3, lw = (int)(blockIdx.x >> 3) * 8 + wave, nlw = (int)(gridDim.x >> 3) * 8;
        x += (size_t)(blockIdx.x & 7) * per * 1024;
        if (out_bf) out_bf += (size_t)(blockIdx.x & 7) * per * 1024;
        if (out_f) out_f += (size_t)(blockIdx.x & 7) * per * 1024;
        nrows = per; gw = lw; ngw = nlw;
    }
    f32x4 wv[4];
#pragma unroll
    for (int j = 0; j < 4; ++j) wv[j] = ((const f32x4*)w)[lane + 64 * j];
    f32x4 vn[4];
    if (gw < nrows) {
        const f32x4* xr = (const f32x4*)(x + (size_t)gw * 1024) + lane;
#pragma unroll
        for (int j = 0; j < 4; ++j) vn[j] = xr[64 * j];
    }
    for (int r = gw; r < nrows; r += ngw) {
        f32x4 v[4];
#pragma unroll
        for (int j = 0; j < 4; ++j) v[j] = vn[j];
        const int rn = (r + ngw < nrows) ? r + ngw : r;
        {
            const f32x4* xr = (const f32x4*)(x + (size_t)rn * 1024) + lane;
#pragma unroll
            for (int j = 0; j < 4; ++j) vn[j] = xr[64 * j];
        }
        float s = 0.f;
#pragma unroll
        for (int j = 0; j < 4; ++j) s += (v[j][0] * v[j][0] + v[j][1] * v[j][1]) + (v[j][2] * v[j][2] + v[j][3] * v[j][3]);
        s = wave_sum(s);
        const float rs = rsqrtf(s * (1.f / 1024.f) + EPSN);
#pragma unroll
        for (int j = 0; j < 4; ++j) {
            f32x4 o; o[0] = v[j][0] * rs * wv[j][0]; o[1] = v[j][1] * rs * wv[j][1]; o[2] = v[j][2] * rs * wv[j][2]; o[3] = v[j][3] * rs * wv[j][3];
            if (out_bf) { u32x2 pk; pk.x = pk2(o[0], o[1]); pk.y = pk2(o[2], o[3]); st_global_b64(out_bf + (size_t)r * 1024 + (size_t)(lane + 64 * j) * 4, pk); }
            else st_global_f128(out_f + (size_t)r * 1024 + (size_t)(lane + 64 * j) * 4, o);
        }
    }
}

__device__ __forceinline__ void prep_phase(const Params& p, unsigned char* smem) {
    bf16_t* WT = (bf16_t*)(p.ws + WS_WT);
    float* tile = (float*)smem;
    int tid_ = threadIdx.x; asm volatile("" : "+v"(tid_)); const int tid = tid_;
    for (int it = blockIdx.x; it < N_TITEMS; it += gridDim.x) {
        int r = it; bool found = false; TJob jb; jb.src = nullptr; jb.ld = 0; jb.K = 0; jb.c0 = 0; jb.nc = 0; jb.dst = nullptr;
        auto tj = [&](const float* src, int ld, int K, int c0, int nc, bf16_t* dst) {
            if (!found) { const int ni = (K / 64) * (nc / 64); if (r < ni) { jb.src = src; jb.ld = ld; jb.K = K; jb.c0 = c0; jb.nc = nc; jb.dst = dst; found = true; } else r -= ni; } };
        for (int j = 0; j < 2; ++j) {
            const float* w = p.in[4] + (size_t)j * 1024 * GLA_IN_W; bf16_t* a1 = WT + j * WT_GLA_PER;
            tj(w, GLA_IN_W, 1024, 0, 1024, a1);
            tj(w, GLA_IN_W, 1024, 1024, 2048, a1 + (size_t)1536 * 1024);
            tj(w, GLA_IN_W, 1024, 6160, 1024, a1 + (size_t)3584 * 1024);
            tj(w, GLA_IN_W, 1024, 3088, 3072, a1 + WT_GLA_A2);
        }
        for (int j = 0; j < 2; ++j) {
            const float* w = p.in[8] + (size_t)j * 1024 * S5_IN_W; bf16_t* a1 = WT + WT_S5_BASE + j * WT_S5_PER;
            tj(w, S5_IN_W, 1024, 0, 2048, a1);
            tj(w, S5_IN_W, 1024, 5120, 1024, a1 + (size_t)2048 * 1024);
            tj(w, S5_IN_W, 1024, 2048, 3072, a1 + WT_S5_A2);
            tj(p.in[17] + (size_t)j * 2048 * 2048, 2048, 2048, 0, 2048, a1 + WT_S5_GLU);
        }
        for (int i = 0; i < 4; ++i) tj(p.in[20] + (size_t)i * 3072 * 1024, 1024, 3072, 0, 1024, WT + WT_OUT_BASE + i * WT_OUT_PER);
        for (int i = 0; i < 4; ++i) {
            const float* w = p.in[19] + (size_t)i * 1024 * 2048;
            tj(w, 2048, 1024, 0, 1024, WT + WT_K_BASE + (size_t)i * 1024 * 1024);
            tj(w, 2048, 1024, 1024, 1024, WT + WT_V_BASE + (size_t)i * 1024 * 1024);
        }
        if (found) {
            const int nblk = jb.nc / 64, kb = r / nblk, nb = r % nblk, k0 = kb * 64, n0 = nb * 64;
#pragma unroll
            for (int i = 0; i < 2; ++i) {
                const int kk = (tid >> 4) + 32 * i, c4 = (tid & 15) * 4;
                const f32x4 v = *(const f32x4*)(jb.src + (size_t)(k0 + kk) * jb.ld + jb.c0 + n0 + c4);
                tile[kk * 65 + c4 + 0] = v[0]; tile[kk * 65 + c4 + 1] = v[1]; tile[kk * 65 + c4 + 2] = v[2]; tile[kk * 65 + c4 + 3] = v[3];
            }
            __syncthreads();
            const int n = tid >> 3, kc = (tid & 7) * 8;
            u32x4 o;
            o.x = pk2(tile[(kc + 0) * 65 + n], tile[(kc + 1) * 65 + n]); o.y = pk2(tile[(kc + 2) * 65 + n], tile[(kc + 3) * 65 + n]);
            o.z = pk2(tile[(kc + 4) * 65 + n], tile[(kc + 5) * 65 + n]); o.w = pk2(tile[(kc + 6) * 65 + n], tile[(kc + 7) * 65 + n]);
            *(u32x4*)(jb.dst + (size_t)(n0 + n) * jb.K + k0 + kc) = o;
        }
        __syncthreads();
    }
    for (int idx = blockIdx.x * NTHREADS + tid; idx < 2 * 512 * 1024; idx += gridDim.x * NTHREADS) {
        const int j = idx >> 19, n = (idx >> 10) & 511, k = idx & 1023;
        const float* wr_ = p.in[4] + (size_t)j * 1024 * GLA_IN_W + (size_t)k * GLA_IN_W + 3072;
        const float* wg = p.in[5] + (size_t)j * 16 * 512 + n;
        float s = 0.f;
#pragma unroll
        for (int r = 0; r < 16; ++r) s += wr_[r] * wg[r * 512];
        WT[j * WT_GLA_PER + (size_t)(1024 + n) * 1024 + k] = bf1(s);
    }
    rms_rows(p.in[1], p.in[3], (bf16_t*)(p.ws + WS_MEMN), nullptr, 2048);
}

__device__ __forceinline__ void norm_phase(const Params& p, int layer) {
    const float* x = (layer == 0) ? p.in[0] : p.out;
    rms_rows(x, p.in[2] + layer * 1024, (bf16_t*)(p.ws + WS_H), nullptr, T_TOK, layer > 0);
    unsigned long long* ss = (unsigned long long*)(p.ws + WS_SUMSQ);
    for (int i = blockIdx.x * NTHREADS + threadIdx.x; i < T_TOK * 4; i += gridDim.x * NTHREADS) ss[i] = 0ull;
}

__device__ __forceinline__ void attn_phase(const Params& p, int layer, unsigned char* smem) {
    bf16_t* mix = (bf16_t*)(p.ws + WS_MIX);
    const bf16_t* kmem = (const bf16_t*)(p.ws + WS_KMEM);
    const bf16_t* vt = (const bf16_t*)(p.ws + WS_VT);
    bf16_t* KV = (bf16_t*)smem;
    bf16_t* PB = (bf16_t*)(smem + 67584);
    float* RS = (float*)(smem + 135168);
    int tid_ = threadIdx.x; asm volatile("" : "+v"(tid_));
    const int tid = tid_, wave = tid >> 6, lane = tid & 63, fr = lane & 15, fq = lane >> 4;
    const int sr = tid >> 5, sc8 = (tid & 31) * 8;
    u32x4 stg[8];
#define ATT_SRC(unit_, ti_) (((ti_) < 2) \
        ? (kmem + (size_t)((((unit_) >> 2) >> 6) * 256 + (ti_) * 128 + sr) * 4096 + layer * 1024 + ((unit_) & 3) * 256 + sc8) \
        : (vt + (size_t)(layer * 1024 + ((unit_) & 3) * 256 + ((ti_) - 2) * 128 + sr) * 2048 + (((unit_) >> 2) >> 6) * 256 + sc8))
#define ATT_LOAD(unit_, ti_) do { const bf16_t* sp_ = ATT_SRC(unit_, ti_); const size_t rp_ = ((ti_) < 2) ? (size_t)16 * 4096 : (size_t)16 * 2048; \
        _Pragma("unroll") for (int i = 0; i < 8; ++i) stg[i] = *(const u32x4*)(sp_ + i * rp_); } while (0)
#define ATT_STAGE() do { _Pragma("unroll") for (int i = 0; i < 8; ++i) *(u32x4*)(KV + (sr + 16 * i) * 264 + sc8) = stg[i]; } while (0)
    const int ab = blockIdx.x & 7, astep = (int)(gridDim.x >> 3);
#define ATT_UNIT(u_) ((((ab << 6) + ((u_) >> 2)) << 2) | ((u_) & 3))
    int au = blockIdx.x >> 3;
    int unit = (au < 256) ? ATT_UNIT(au) : 2048;
    if (unit < 2048) ATT_LOAD(unit, 0);
    __syncthreads();
    for (; au < 256; au += astep, unit = (au < 256) ? ATT_UNIT(au) : 2048) {
        const int h = unit & 3, tile = unit >> 2;
        const size_t t0 = (size_t)tile * 128;
        const int unext = (au + astep < 256) ? ATT_UNIT(au + astep) : unit;
        bf16x8 qf[8];
        {
            const bf16_t* qrow = mix + (t0 + wave * 16 + fr) * 3072 + 2048 + h * 256 + fq * 8;
#pragma unroll
            for (int ks = 0; ks < 8; ++ks) qf[ks] = *(const bf16x8*)(qrow + ks * 32);
        }
        f32x4 sacc[16];
#pragma unroll
        for (int half = 0; half < 2; ++half) {
            ATT_STAGE();
            LDS_BAR();
            ATT_LOAD(unit, half + 1);
#pragma unroll
            for (int mb = 0; mb < 8; ++mb) {
                f32x4 a = (f32x4){0.f, 0.f, 0.f, 0.f};
#pragma unroll
                for (int ks = 0; ks < 8; ++ks) { const bf16x8 bfr = *(const bf16x8*)(KV + (mb * 16 + fr) * 264 + ks * 32 + fq * 8); a = MFMA16(qf[ks], bfr, a); }
                sacc[half * 8 + mb] = a;
            }
            LDS_BAR();
        }
        const float sc = 0.0625f * L2E;
#pragma unroll
        for (int j = 0; j < 4; ++j) {
            float mx = sacc[0][j];
#pragma unroll
            for (int i = 1; i < 16; ++i) mx = fmaxf(mx, sacc[i][j]);
            mx = fmaxf(mx, __shfl_xor(mx, 1)); mx = fmaxf(mx, __shfl_xor(mx, 2)); mx = fmaxf(mx, __shfl_xor(mx, 4)); mx = fmaxf(mx, __shfl_xor(mx, 8));
            float sum = 0.f;
#pragma unroll
            for (int i = 0; i < 16; ++i) { const float e = __builtin_amdgcn_exp2f((sacc[i][j] - mx) * sc); sacc[i][j] = e; sum += e; }
            sum += __shfl_xor(sum, 1); sum += __shfl_xor(sum, 2); sum += __shfl_xor(sum, 4); sum += __shfl_xor(sum, 8);
            if (fr == 0) RS[wave * 16 + fq * 4 + j] = 1.f / sum;
#pragma unroll
            for (int i = 0; i < 16; ++i) PB[(wave * 16 + fq * 4 + j) * 264 + i * 16 + fr] = bf1(sacc[i][j]);
        }
        ATT_STAGE();
        LDS_BAR();
        bf16x8 pf[8];
#pragma unroll
        for (int ks = 0; ks < 8; ++ks) pf[ks] = *(const bf16x8*)(PB + (wave * 16 + fr) * 264 + ks * 32 + fq * 8);
        const float rinv = RS[wave * 16 + fr];
#pragma unroll
        for (int half = 0; half < 2; ++half) {
            if (half == 0) ATT_LOAD(unit, 3); else ATT_LOAD(unext, 0);
#pragma unroll
            for (int db = 0; db < 8; ++db) {
                f32x4 a = (f32x4){0.f, 0.f, 0.f, 0.f};
#pragma unroll
                for (int ks = 0; ks < 8; ++ks) { const bf16x8 bfr = *(const bf16x8*)(KV + (db * 16 + fr) * 264 + ks * 32 + fq * 8); a = MFMA16(bfr, pf[ks], a); }
                u32x2 o; o.x = pk2(a[0] * rinv, a[1] * rinv); o.y = pk2(a[2] * rinv, a[3] * rinv);
                st_global_b64(mix + (t0 + wave * 16 + fr) * 3072 + 2048 + h * 256 + half * 128 + db * 16 + fq * 4, o);
            }
            LDS_BAR();
            if (half == 0) { ATT_STAGE(); LDS_BAR(); }
        }
    }
#undef ATT_UNIT
#undef ATT_SRC
#undef ATT_LOAD
#undef ATT_STAGE
    asm volatile("s_waitcnt vmcnt(0)" ::: "memory");
    __syncthreads();
}

__device__ __forceinline__ void gla_pre_phase(const Params& p, unsigned char* smem, bool dry = false) {
    bf16_t* qk = (bf16_t*)(p.ws + WS_QK);
    unsigned char* Gb = p.ws + WS_G;
    float* BC = (float*)smem;
    float* SEG = (float*)(smem + 32768);
    float* BL = (float*)(smem + 32768 + 2048);
    bf16_t* QD = (bf16_t*)(smem + 35328);
    bf16_t* KI = QD + 64 * 136;
    bf16_t* KET = KI + 64 * 136;
    bf16_t* ATT = KET + 128 * 72;
    int tid_ = threadIdx.x; asm volatile("" : "+v"(tid_));
    const int tid = tid_, w = tid >> 6, lane = tid & 63, fr = lane & 15, fq = lane >> 4;
    const int cd = tid & 127, seg = tid >> 7;
    const int es = tid >> 3, dseg = tid & 7;
    const int cb = w >> 1;
    for (int pu = blockIdx.x >> 3; pu < 512; pu += (int)(gridDim.x >> 3)) {
        const int h = pu & 3, bc = (int)(blockIdx.x & 7) * 128 + (pu >> 2);
        const size_t t0 = (size_t)bc * 64;
        const float* G = (const float*)Gb;
        float gpre[16];
#pragma unroll
        for (int i = 0; i < 16; ++i) gpre[i] = G[(t0 + seg * 16 + i) * 512 + h * 128 + cd];
        bf16_t* qp = qk + (t0 + es) * 1024 + h * 128 + dseg * 16;
        const u32x4 q0 = *(const u32x4*)qp, q1 = *(const u32x4*)(qp + 8), k0 = *(const u32x4*)(qp + 512), k1 = *(const u32x4*)(qp + 520);
        float run = 0.f;
#pragma unroll
        for (int i = 0; i < 16; ++i) { run += gpre[i]; gpre[i] = run; }
        SEG[seg * 128 + cd] = run;
        __syncthreads();
        {
            const float s0 = SEG[cd], s1 = SEG[128 + cd], s2 = SEG[256 + cd];
            const float off = (seg > 0 ? s0 : 0.f) + (seg > 1 ? s1 : 0.f) + (seg > 2 ? s2 : 0.f);
#pragma unroll
            for (int i = 0; i < 16; ++i) BC[(seg * 16 + i) * 128 + cd] = gpre[i] + off;
            if (seg == 3) BL[cd] = run + off;
        }
        __syncthreads();
        {
            float bc_[16], bl[16];
#pragma unroll
            for (int e4 = 0; e4 < 4; ++e4) {
                const f32x4 t1 = *(const f32x4*)(BC + es * 128 + dseg * 16 + e4 * 4); const f32x4 t2 = *(const f32x4*)(BL + dseg * 16 + e4 * 4);
                bc_[e4 * 4 + 0] = t1[0]; bc_[e4 * 4 + 1] = t1[1]; bc_[e4 * 4 + 2] = t1[2]; bc_[e4 * 4 + 3] = t1[3];
                bl[e4 * 4 + 0] = t2[0]; bl[e4 * 4 + 1] = t2[1]; bl[e4 * 4 + 2] = t2[2]; bl[e4 * 4 + 3] = t2[3];
            }
            const unsigned qw[8] = { q0.x, q0.y, q0.z, q0.w, q1.x, q1.y, q1.z, q1.w };
            const unsigned kw[8] = { k0.x, k0.y, k0.z, k0.w, k1.x, k1.y, k1.z, k1.w };
            unsigned qo[8], ko[8];
#pragma unroll
            for (int e2 = 0; e2 < 8; ++e2) {
                const float e1a = fexp(bc_[2 * e2]), e1b = fexp(bc_[2 * e2 + 1]);
                const float ia = frcp(e1a), ib = frcp(e1b);
                const float e3a = fexp(bl[2 * e2] - bc_[2 * e2]), e3b = fexp(bl[2 * e2 + 1] - bc_[2 * e2 + 1]);
                const float qa = bflo(qw[e2]), qb = bfhi(qw[e2]), ka = bflo(kw[e2]), kb = bfhi(kw[e2]);
                qo[e2] = pk2(qa * e1a, qb * e1b);
                ko[e2] = pk2(ka * ia, kb * ib);
                const unsigned ke = pk2(ka * e3a, kb * e3b);
                KET[(dseg * 16 + 2 * e2) * 72 + es] = (bf16_t)(ke & 0xffffu);
                KET[(dseg * 16 + 2 * e2 + 1) * 72 + es] = (bf16_t)(ke >> 16);
            }
            u32x4 t; t.x = qo[0]; t.y = qo[1]; t.z = qo[2]; t.w = qo[3]; *(u32x4*)(QD + es * 136 + dseg * 16) = t; if (!dry) *(u32x4*)qp = t;
            t.x = qo[4]; t.y = qo[5]; t.z = qo[6]; t.w = qo[7]; *(u32x4*)(QD + es * 136 + dseg * 16 + 8) = t; if (!dry) *(u32x4*)(qp + 8) = t;
            t.x = ko[0]; t.y = ko[1]; t.z = ko[2]; t.w = ko[3]; *(u32x4*)(KI + es * 136 + dseg * 16) = t;
            t.x = ko[4]; t.y = ko[5]; t.z = ko[6]; t.w = ko[7]; *(u32x4*)(KI + es * 136 + dseg * 16 + 8) = t;
        }
        __syncthreads();
#pragma unroll
        for (int n = 0; n < 2; ++n) {
            const int sb = (w & 1) * 2 + n;
            f32x4 a = (f32x4){0.f, 0.f, 0.f, 0.f};
            if (sb <= cb) {
#pragma unroll
                for (int ks = 0; ks < 4; ++ks) {
                    const bf16x8 af = *(const bf16x8*)(QD + (cb * 16 + fr) * 136 + ks * 32 + fq * 8);
                    const bf16x8 bfr = *(const bf16x8*)(KI + (sb * 16 + fr) * 136 + ks * 32 + fq * 8);
                    a = MFMA16(af, bfr, a);
                }
            }
#pragma unroll
            for (int jj = 0; jj < 4; ++jj) {
                const int cc = cb * 16 + fq * 4 + jj, ss = sb * 16 + fr;
                ATT[cc * 72 + ss] = bf1(ss <= cc ? a[jj] : 0.f);
            }
        }
        __syncthreads();
        unsigned char* gbase = Gb + ((t0 * 512) + (size_t)h * 128) * 4;
#pragma unroll
        for (int i = 0; i < 2; ++i) {
            const int idx = tid + i * 512, d = idx >> 3, pc = idx & 7;
            const u32x4 v = *(const u32x4*)(KET + d * 72 + pc * 8);
            if (!dry) *(u32x4*)(gbase + (size_t)(d >> 2) * 2048 + (d & 3) * 128 + pc * 16) = v;
        }
        {
            const int c = tid >> 3, pc = tid & 7;
            const u32x4 v = *(const u32x4*)(ATT + c * 72 + pc * 8);
            if (!dry) *(u32x4*)(gbase + (size_t)(32 + (c >> 2)) * 2048 + (c & 3) * 128 + pc * 16) = v;
        }
        if (tid < 128 && !dry) *(float*)(gbase + (size_t)48 * 2048 + tid * 4) = fexp(BL[tid]);
        __syncthreads();
    }
}

__device__ __forceinline__ void gla_phase(const Params& p, unsigned char* smem, bool dry = false) {
    const unsigned char* qkb = p.ws + WS_QK;
    const unsigned char* Gb = p.ws + WS_G;
    bf16_t* mix = (bf16_t*)(p.ws + WS_MIX);
    float* part = (float*)(p.ws + WS_PART);
    bf16_t* ST = (bf16_t*)smem;
    bf16_t* VT = ST + 64 * 136;
    constexpr int OPB = 26624, OPSZ = 41984, O_KET = 0, O_QD = 16384, O_ATT = 32768, O_DEC = 40960;
    LAS unsigned char* lds = (LAS unsigned char*)smem;
    int tid_ = threadIdx.x; asm volatile("" : "+v"(tid_));
    const int tid = tid_, w = __builtin_amdgcn_readfirstlane(tid >> 6), lane = tid & 63, fr = lane & 15, fq = lane >> 4;
    const int es = tid >> 3, dseg = tid & 7;
    const int cb = w >> 1, wh = w & 1;
    const int crow = cb * 16 + fr;
    unsigned koff[2], qoff[2], aoff, doff;
#pragma unroll
    for (int i = 0; i < 2; ++i) {
        const int P = (2 * w + i) * 64 + lane;
        { const int r = P >> 3, s_ = P & 7, q = s_ ^ (r & 7); koff[i] = (unsigned)((r >> 2) * 2048 + (r & 3) * 128 + q * 16); }
        { const int r = P >> 4, s_ = P & 15, q = s_ ^ (r & 15); qoff[i] = (unsigned)(r * 2048 + q * 16); }
    }
    { const int P = w * 64 + lane, r = P >> 3, s_ = P & 7, q = s_ ^ (r & 7); aoff = (unsigned)((32 + (r >> 2)) * 2048 + (r & 3) * 128 + q * 16); }
    doff = (unsigned)(48 * 2048 + (lane & 31) * 16);
    int r_att[2], r_qd[4], r_ket[4][2], r_dec[4];
#pragma unroll
    for (int ks = 0; ks < 2; ++ks) r_att[ks] = O_ATT + (crow * 8 + ((ks * 4 + fq) ^ (crow & 7))) * 16;
#pragma unroll
    for (int ks = 0; ks < 4; ++ks) r_qd[ks] = O_QD + (crow * 16 + ((ks * 4 + fq) ^ (crow & 15))) * 16;
#pragma unroll
    for (int n = 0; n < 4; ++n) { const int d = (wh * 4 + n) * 16 + fr; r_dec[n] = O_DEC + d * 4;
#pragma unroll
        for (int ks = 0; ks < 2; ++ks) r_ket[n][ks] = O_KET + (d * 8 + ((ks * 4 + fq) ^ (d & 7))) * 16; }
    for (int unit = blockIdx.x; unit < 256; unit += gridDim.x) {
        const int ux = unit & 7, uy = unit >> 3;
        const int bh = ux * 4 + (uy >> 3), sl = uy & 7, h = bh & 3, b = bh >> 2;
        const size_t tb = (size_t)b * SEQ_L;
        f32x4 st[4];
#pragma unroll
        for (int n = 0; n < 4; ++n) st[n] = (f32x4){0.f, 0.f, 0.f, 0.f};
        u32x4 vpre;
#define GLA_DMA(t1, bufoff) do { const unsigned char* gb_ = Gb + (((t1) * 512) + (size_t)h * 128) * 4; const unsigned char* qb_ = qkb + (((t1) * 1024) + (size_t)h * 128) * 2; \
            _Pragma("unroll") for (int i = 0; i < 2; ++i) { \
                __builtin_amdgcn_global_load_lds((const unsigned*)(gb_ + koff[i]), (LAS unsigned*)(lds + (bufoff) + O_KET + (2 * w + i) * 1024), 16, 0, 0); \
                __builtin_amdgcn_global_load_lds((const unsigned*)(qb_ + qoff[i]), (LAS unsigned*)(lds + (bufoff) + O_QD + (2 * w + i) * 1024), 16, 0, 0); } \
            __builtin_amdgcn_global_load_lds((const unsigned*)(gb_ + aoff), (LAS unsigned*)(lds + (bufoff) + O_ATT + w * 1024), 16, 0, 0); \
            if (w == 7) __builtin_amdgcn_global_load_lds((const unsigned*)(gb_ + doff), (LAS unsigned*)(lds + (bufoff) + O_DEC), 16, 0, 0); } while (0)
#define GLA_LOAD_V(t1) vpre = *(const u32x4*)(mix + ((t1) + es) * 3072 + h * 512 + sl * 64 + dseg * 8)
        __syncthreads();
        GLA_DMA(tb, OPB); GLA_LOAD_V(tb);
        u32x2 po[2]; po[0] = (u32x2){0u, 0u}; po[1] = (u32x2){0u, 0u}; float pssq = 0.f;
        for (int c = 0; c < 128; ++c) {
            const size_t t0 = tb + (size_t)c * 64;
            const size_t tn = tb + (size_t)(c < 127 ? c + 1 : 127) * 64;
            const size_t tp = tb + (size_t)(c > 0 ? c - 1 : 0) * 64;
            const int bcur = OPB + (c & 1) * OPSZ, bnxt = OPB + ((c & 1) ^ 1) * OPSZ;
            const unsigned char* OB = smem + bcur;
            {
                const unsigned vw[4] = { vpre.x, vpre.y, vpre.z, vpre.w };
#pragma unroll
                for (int e2 = 0; e2 < 4; ++e2) {
                    VT[(dseg * 8 + 2 * e2) * 72 + es] = (bf16_t)(vw[e2] & 0xffffu);
                    VT[(dseg * 8 + 2 * e2 + 1) * 72 + es] = (bf16_t)(vw[e2] >> 16);
                }
#pragma unroll
                for (int n = 0; n < 4; ++n) {
                    const int db = wh * 4 + n;
#pragma unroll
                    for (int jj = 0; jj < 4; ++jj) ST[(cb * 16 + fq * 4 + jj) * 136 + db * 16 + fr] = bf1(st[n][jj]);
                }
            }
            asm volatile("s_waitcnt vmcnt(0) lgkmcnt(0)" ::: "memory"); __builtin_amdgcn_s_barrier(); asm volatile("" ::: "memory");
            if (!(dry && (PROBE_ABL & 1))) { GLA_DMA(tn, bnxt); GLA_LOAD_V(tn); }
            {
                bf16_t* op = mix + (tp + crow) * 3072 + h * 512 + sl * 64 + wh * 32 + fq * 4;
                if (!dry) { st_global_b64(op, po[0]); st_global_b64(op + 16, po[1]);
                st_global_b32(part + ((tp + crow) * 4 + h) * 16 + sl * 2 + wh, pssq); }
            }
            {
                bf16x8 A_vt[2];
#pragma unroll
                for (int ks = 0; ks < 2; ++ks) A_vt[ks] = *(const bf16x8*)(VT + (cb * 16 + fr) * 72 + ks * 32 + fq * 8);
#pragma unroll
                for (int n = 0; n < 4; ++n) {
                    const float dcn = *(const float*)(OB + r_dec[n]);
                    st[n][0] *= dcn; st[n][1] *= dcn; st[n][2] *= dcn; st[n][3] *= dcn;
#pragma unroll
                    for (int ks = 0; ks < 2; ++ks) st[n] = MFMA16(A_vt[ks], *(const bf16x8*)(OB + r_ket[n][ks]), st[n]);
                }
            }
            {
                bf16x8 A_att[2], A_qd[4];
#pragma unroll
                for (int ks = 0; ks < 2; ++ks) A_att[ks] = *(const bf16x8*)(OB + r_att[ks]);
#pragma unroll
                for (int ks = 0; ks < 4; ++ks) A_qd[ks] = *(const bf16x8*)(OB + r_qd[ks]);
                float ssq = 0.f;
#pragma unroll
                for (int n = 0; n < 2; ++n) {
                    const int eb = wh * 2 + n;
                    f32x4 a = (f32x4){0.f, 0.f, 0.f, 0.f};
#pragma unroll
                    for (int ks = 0; ks < 2; ++ks) { const bf16x8 bfr = *(const bf16x8*)(VT + (eb * 16 + fr) * 72 + ks * 32 + fq * 8); a = MFMA16(bfr, A_att[ks], a); }
#pragma unroll
                    for (int ks = 0; ks < 4; ++ks) { const bf16x8 bfr = *(const bf16x8*)(ST + (eb * 16 + fr) * 136 + ks * 32 + fq * 8); a = MFMA16(bfr, A_qd[ks], a); }
                    po[n].x = pk2(a[0], a[1]); po[n].y = pk2(a[2], a[3]);
                    ssq += (a[0] * a[0] + a[1] * a[1]) + (a[2] * a[2] + a[3] * a[3]);
                }
                ssq += __shfl_xor(ssq, 16); ssq += __shfl_xor(ssq, 32); pssq = ssq;
            }
            LDS_BAR();
        }
        {
            const size_t t0 = tb + (size_t)127 * 64;
            bf16_t* op = mix + (t0 + crow) * 3072 + h * 512 + sl * 64 + wh * 32 + fq * 4;
            if (!dry) { st_global_b64(op, po[0]); st_global_b64(op + 16, po[1]);
            st_global_b32(part + ((t0 + crow) * 4 + h) * 16 + sl * 2 + wh, pssq); }
        }
        asm volatile("s_waitcnt vmcnt(0)" ::: "memory");
#undef GLA_DMA
#undef GLA_LOAD_V
        __syncthreads();
    }
}

#define S5_BAR() LDS_BAR()
__device__ __forceinline__ void s5_phase(const Params& p, int j, unsigned char* smem) {
    const bf16_t* mix = (const bf16_t*)(p.ws + WS_MIX);
    bf16_t* y5 = (bf16_t*)(p.ws + WS_QK);
    int tid_ = threadIdx.x; asm volatile("" : "+v"(tid_));
    const int tid = tid_, w = __builtin_amdgcn_readfirstlane(tid >> 6), lane = tid & 63, fr = lane & 15, fq = lane >> 4;
    const int wp = w & 3;
    float* BUF = (float*)(smem + wp * 25600);
    bf16_t* XB = (bf16_t*)(smem + wp * 25600 + 8448);
    for (int ub = blockIdx.x; ub < 256; ub += gridDim.x) {
        const int b = ub & 7, g = (ub >> 3) * 4 + wp;
        const int jg = j * 128 + g;
        const float lr = p.in[9][jg * 64 + lane], li = p.in[10][jg * 64 + lane];
        const float dt = __expf(p.in[11][jg]);
        const float mag = __expf(lr * dt);
        float rev = li * dt * 0.15915494309189535f; rev -= floorf(rev);
        const float ar = mag * __builtin_amdgcn_cosf(rev), ai = mag * __builtin_amdgcn_sinf(rev);
        const size_t tb0 = (size_t)b * SEQ_L;
        if (w < 4) {
            float xr = 0.f, xi = 0.f; const float nai = -ai;
            S5_BAR();
            for (int step2 = 0; step2 < 512; step2 += 2) {
#pragma unroll
                for (int k = 0; k < 2; ++k) {
                    const float* BUFc = BUF + k * 3200; bf16_t* XBc = XB + k * 6400;
                    f32x2 bu[16];
#pragma unroll
                    for (int t = 0; t < 16; ++t) bu[t] = *(const f32x2*)(BUFc + t * 132 + 2 * lane);
#pragma unroll
                    for (int t = 0; t < 16; ++t) {
                        const float t1 = fma_s(nai, xi, bu[t][0]);
                        const float t2 = fma_s(ai, xr, bu[t][1]);
                        const float nxr = fma_s(ar, xr, t1);
                        const float nxi = fma_s(ar, xi, t2);
                        xr = nxr; xi = nxi;
                        *(unsigned*)(XBc + t * 136 + 2 * lane) = pk2(xr, xi);
                    }
                    S5_BAR();
                }
            }
        } else {
            const float nr = ar - 1.f, ni = ai, den = lr * lr + li * li;
            const float cre = (nr * lr + ni * li) / den, cim = (ni * lr - nr * li) / den;
            bf16x8 bbf[8];
#pragma unroll
            for (int nb = 0; nb < 8; ++nb) {
                const int pp = nb * 8 + (fr >> 1);
                const float c_re = __shfl(cre, pp), c_im = __shfl(cim, pp);
                const int fqc = fq & 1;
                const float* br = p.in[12] + ((size_t)jg * 64 + pp) * 16 + fqc * 8;
                const float* bi = p.in[13] + ((size_t)jg * 64 + pp) * 16 + fqc * 8;
                const f32x4 br0 = *(const f32x4*)br, br1 = *(const f32x4*)(br + 4), bi0 = *(const f32x4*)bi, bi1 = *(const f32x4*)(bi + 4);
                float v[8];
#pragma unroll
                for (int e = 0; e < 4; ++e) {
                    v[e] = (fr & 1) ? (c_re * bi0[e] + c_im * br0[e]) : (c_re * br0[e] - c_im * bi0[e]);
                    v[4 + e] = (fr & 1) ? (c_re * bi1[e] + c_im * br1[e]) : (c_re * br1[e] - c_im * bi1[e]);
                }
                u32x4 t; t.x = pk2(v[0], v[1]); t.y = pk2(v[2], v[3]); t.z = pk2(v[4], v[5]); t.w = pk2(v[6], v[7]);
                if (fq >= 2) { t.x = 0u; t.y = 0u; t.z = 0u; t.w = 0u; }
                bbf[nb] = __builtin_bit_cast(bf16x8, t);
            }
            bf16x8 cf[4];
#pragma unroll
            for (int ks = 0; ks < 4; ++ks) {
                const int pb = ks * 16 + fq * 4;
                const f32x4 cr = *(const f32x4*)(p.in[14] + ((size_t)jg * 16 + fr) * 64 + pb);
                const f32x4 ci = *(const f32x4*)(p.in[15] + ((size_t)jg * 16 + fr) * 64 + pb);
                u32x4 t; t.x = pk2(cr[0], -ci[0]); t.y = pk2(cr[1], -ci[1]); t.z = pk2(cr[2], -ci[2]); t.w = pk2(cr[3], -ci[3]);
                cf[ks] = __builtin_bit_cast(bf16x8, t);
            }
            const f32x4 dv = *(const f32x4*)(p.in[16] + j * 2048 + g * 16 + fq * 4);
            const bf16_t* ubase = mix + (tb0 + fr) * 3072 + g * 16;
            bf16_t* ybase = y5 + (tb0 + fr) * 2048 + g * 16 + fq * 4;
            const bool pad = (fq >= 2);
            u32x4 ufq[4]; u32x2 uoq[4];
            {
                u32x4 uf0 = *(const u32x4*)(ubase + (fq & 1) * 8);
                if (pad) { uf0.x = 0u; uf0.y = 0u; uf0.z = 0u; uf0.w = 0u; }
                const bf16x8 uf = __builtin_bit_cast(bf16x8, uf0);
#pragma unroll
                for (int nb = 0; nb < 8; ++nb) { const f32x4 a = MFMA16(bbf[nb], uf, ((f32x4){0.f, 0.f, 0.f, 0.f})); *(f32x4*)(BUF + fr * 132 + nb * 16 + fq * 4) = a; }
#pragma unroll
                for (int q = 1; q <= 4; ++q) ufq[q & 3] = *(const u32x4*)(ubase + (size_t)q * 16 * 3072 + (fq & 1) * 8);
#pragma unroll
                for (int q = 0; q < 3; ++q) uoq[q] = *(const u32x2*)(ubase + (size_t)q * 16 * 3072 + fq * 4);
                uoq[3] = uoq[0];
                S5_BAR();
            }
            for (int step4 = 0; step4 < 512; step4 += 4) {
#pragma unroll
                for (int k = 0; k < 4; ++k) {
                    const int step = step4 + k;
                    const int cur = k & 1, nxt = cur ^ 1;
                    float* BUFn = BUF + nxt * 3200; const bf16_t* XBn = XB + nxt * 6400;
                    u32x4 ufc = ufq[(k + 1) & 3]; if (pad) { ufc.x = 0u; ufc.y = 0u; ufc.z = 0u; ufc.w = 0u; }
                    { const int s5 = (step + 5 < 512) ? step + 5 : 511; ufq[(k + 1) & 3] = *(const u32x4*)(ubase + (size_t)s5 * 16 * 3072 + (fq & 1) * 8); }
                    const bf16x8 uf = __builtin_bit_cast(bf16x8, ufc);
                    f32x4 ya = (f32x4){0.f, 0.f, 0.f, 0.f};
#pragma unroll
                    for (int ks = 0; ks < 4; ++ks) { const bf16x8 xf = *(const bf16x8*)(XBn + fr * 136 + ks * 32 + fq * 8); ya = MFMA16(cf[ks], xf, ya); }
#pragma unroll
                    for (int nb = 0; nb < 8; ++nb) { const f32x4 a = MFMA16(bbf[nb], uf, ((f32x4){0.f, 0.f, 0.f, 0.f})); *(f32x4*)(BUFn + fr * 132 + nb * 16 + fq * 4) = a; }
                    const u32x2 uo = uoq[(k + 3) & 3];
                    { const int s3 = (step + 3 < 512) ? step + 3 : 511; uoq[(k + 3) & 3] = *(const u32x2*)(ubase + (size_t)s3 * 16 * 3072 + fq * 4); }
                    if (step > 0) {
                        const float u0 = bflo(uo.x), u1 = bfhi(uo.x), u2 = bflo(uo.y), u3 = bfhi(uo.y);
                        float yv[4] = { ya[0] + dv[0] * u0, ya[1] + dv[1] * u1, ya[2] + dv[2] * u2, ya[3] + dv[3] * u3 };
#pragma unroll
                        for (int e = 0; e < 4; ++e) { const float v = yv[e]; const float z = 0.7978845608028654f * (v + 0.044715f * v * v * v); yv[e] = v * fsigmoid(2.f * z); }
                        u32x2 o; o.x = pk2(yv[0], yv[1]); o.y = pk2(yv[2], yv[3]);
                        st_global_b64(ybase + (size_t)(step - 1) * 16 * 2048, o);
                    }
                    S5_BAR();
                }
            }
            {
                const u32x2 uo = uoq[3];
                const bf16_t* XBn = XB + 6400;
                f32x4 ya = (f32x4){0.f, 0.f, 0.f, 0.f};
#pragma unroll
                for (int ks = 0; ks < 4; ++ks) { const bf16x8 xf = *(const bf16x8*)(XBn + fr * 136 + ks * 32 + fq * 8); ya = MFMA16(cf[ks], xf, ya); }
                const float u0 = bflo(uo.x), u1 = bfhi(uo.x), u2 = bflo(uo.y), u3 = bfhi(uo.y);
                float yv[4] = { ya[0] + dv[0] * u0, ya[1] + dv[1] * u1, ya[2] + dv[2] * u2, ya[3] + dv[3] * u3 };
#pragma unroll
                for (int e = 0; e < 4; ++e) { const float v = yv[e]; const float z = 0.7978845608028654f * (v + 0.044715f * v * v * v); yv[e] = v * fsigmoid(2.f * z); }
                u32x2 o; o.x = pk2(yv[0], yv[1]); o.y = pk2(yv[2], yv[3]);
                st_global_b64(ybase + (size_t)511 * 16 * 2048, o);
            }
        }
        __syncthreads();
    }
    __syncthreads();
}

enum { K_PREP = 0, K_KV, K_NORM, K_A1, K_MIX, K_GLU, K_A2, K_A3, K_FINAL, K_MIXB };
constexpr int N_PHASES = 25;
__device__ __forceinline__ void decode_phase(int ph, int& kind, int& layer) {
    if (ph == 0) { kind = K_PREP; layer = 0; return; }
    if (ph >= 24) { kind = K_FINAL; layer = 0; return; }
    int q;
    if (ph < 6) { layer = 0; q = ph; } else { const int q0 = ph - 6; layer = 1 + q0 / 6; q = q0 - (layer - 1) * 6; }
    if (layer & 1) kind = (q == 0) ? K_NORM : (q == 1) ? K_A1 : (q == 2) ? K_MIX : (q == 3) ? K_GLU : (q == 4) ? K_A2 : K_A3;
    else kind = (q == 0) ? K_NORM : (q == 1) ? K_A1 : (q == 2) ? K_MIX : (q == 3) ? K_MIXB : (q == 4) ? K_A2 : K_A3;
}

__device__ __forceinline__ void run_phase(const Params& p, int ph, unsigned char* smem) {
    int kind, layer; decode_phase(ph, kind, layer);
    const int j = layer >> 1; const bool is_gla = !(layer & 1);
    bf16_t* WT = (bf16_t*)(p.ws + WS_WT);
    bf16_t* H = (bf16_t*)(p.ws + WS_H);
    bf16_t* MIX = (bf16_t*)(p.ws + WS_MIX);
#ifndef NO_PREP
    if (kind == K_PREP) { prep_phase(p, smem); norm_phase(p, 0); return; }
#endif
    if (kind == K_NORM) { norm_phase(p, layer); return; }
    if (kind == K_FINAL) { rms_rows(p.out, p.in[21], nullptr, p.out, T_TOK, true); return; }
    if (kind == K_MIX) {
        if (is_gla) { if (PROBE_DUP & 2) { gla_pre_phase(p, smem, true); __syncthreads(); } gla_pre_phase(p, smem); } else s5_phase(p, j, smem);
        __syncthreads();
        attn_phase(p, layer, smem);
        return;
    }
    if (kind == K_MIXB) { if (PROBE_DUP & 1) { gla_phase(p, smem, true); __syncthreads(); } gla_phase(p, smem); return; }
    const bool withkv = (kind == K_A1 && layer == 0);
    const int ngemm = withkv ? 3 : 1;
    for (int q = 0; q < ngemm; ++q) {
        pg8::Gemm g; pg8::Epi E;
        E.mode = pg8::EM_BF16; E.o0 = nullptr; E.ld0 = 0; E.qk = nullptr; E.g = nullptr; E.gbias = nullptr; E.mix = MIX; E.part = nullptr; E.onw = nullptr; E.is_gla = 0;
        E.y5 = nullptr; E.bglu = nullptr; E.xin = nullptr; E.xout = nullptr;
        int ord_c = (int)blockIdx.x;
        if (withkv && q < 2) {
            if (q == 1) ord_c = (int)((blockIdx.x + gridDim.x / 2) % gridDim.x);
            if (q == 0) { g.A = (const bf16_t*)(p.ws + WS_MEMN); g.Bt = WT + WT_K_BASE; g.M = 2048; g.N = 4096; g.K = 1024; E.o0 = (bf16_t*)(p.ws + WS_KMEM); E.ld0 = 4096; }
            else { g.A = WT + WT_V_BASE; g.Bt = (const bf16_t*)(p.ws + WS_MEMN); g.M = 4096; g.N = 2048; g.K = 1024; E.o0 = (bf16_t*)(p.ws + WS_VT); E.ld0 = 2048; }
        } else if (kind == K_A1) {
            g.A = H; g.M = T_TOK; g.K = 1024;
            if (is_gla) { g.Bt = WT + j * WT_GLA_PER; g.N = 4608; E.mode = pg8::EM_A1GLA; E.qk = (bf16_t*)(p.ws + WS_QK); E.g = (float*)(p.ws + WS_G); E.gbias = p.in[6] + j * 512; }
            else { g.Bt = WT + WT_S5_BASE + j * WT_S5_PER; g.N = 3072; E.o0 = MIX; E.ld0 = 3072; }
        } else if (kind == K_A2) {
            g.A = H; g.M = T_TOK; g.K = 1024; g.N = 3072;
            g.Bt = is_gla ? (WT + j * WT_GLA_PER + WT_GLA_A2) : (WT + WT_S5_BASE + j * WT_S5_PER + WT_S5_A2);
            E.mode = pg8::EM_GATE; E.part = (const float*)(p.ws + WS_PART); E.onw = p.in[7] + j * 512; E.is_gla = is_gla ? 1 : 0;
        } else if (kind == K_GLU) {
            g.A = (const bf16_t*)(p.ws + WS_QK); g.M = T_TOK; g.K = 2048; g.N = 2048; g.Bt = WT + WT_S5_BASE + j * WT_S5_PER + WT_S5_GLU;
            E.mode = pg8::EM_GLU; E.y5 = (const bf16_t*)(p.ws + WS_QK); E.bglu = p.in[18] + j * 2048;
        } else {
            g.A = MIX; g.M = T_TOK; g.K = 3072; g.N = 1024; g.Bt = WT + WT_OUT_BASE + layer * WT_OUT_PER;
            E.mode = pg8::EM_RESID; E.xin = (layer == 0) ? p.in[0] : p.out; E.xout = p.out;
        }
        pg8::StaticOrder S; S.init(g.M, g.N, (int)gridDim.x, ord_c);
#ifndef NO_GEMM
        pg8::gemm_phase((LAS unsigned char*)smem, g, S, E);
#endif
        __syncthreads();
    }
}

__device__ __forceinline__ void grid_barrier(unsigned* ctr, unsigned target) {
    asm volatile("s_waitcnt vmcnt(0)" ::: "memory");
    __syncthreads();
    if (threadIdx.x == 0) {
        __threadfence();
        atomicAdd(ctr, 1u);
        while (__hip_atomic_load(ctr, __ATOMIC_RELAXED, __HIP_MEMORY_SCOPE_AGENT) < target) __builtin_amdgcn_s_sleep(2);
        __threadfence();
    }
    __syncthreads();
}

__global__ void __launch_bounds__(NTHREADS, 2) mega(Params p) {
    extern __shared__ __attribute__((aligned(16))) unsigned char smem[];
    cg::grid_group grid = cg::this_grid();
    unsigned* ctr = (unsigned*)(p.ws + WS_CTL);
    unsigned nbar = 0, ngrp = 0;
    for (int ph = p.ph_lo; ph < p.ph_hi; ++ph) {
        run_phase(p, ph, smem);
        if (ph + 1 < p.ph_hi) {
            if (ph == p.ph_lo) { asm volatile("s_waitcnt vmcnt(0)" ::: "memory"); __syncthreads(); grid.sync(); }
            else if (ph == 1 || (gridDim.x & 7) != 0) { ++nbar; grid_barrier(ctr, nbar * gridDim.x); }
            else { ++ngrp; grid_barrier(ctr + 16 * (1 + (blockIdx.x & 7)), ngrp * (gridDim.x >> 3)); }
        }
    }
}

extern "C" void kernel_launch(void* const* d_in, const int* in_sizes, int n_in, void* d_out, int out_size, void* d_ws, size_t ws_size, hipStream_t stream) {
    static int grid = 0;
    if (grid == 0) {
        if (n_in != 22 || out_size != T_TOK * DM || ws_size < WS_END) {
            fprintf(stderr, "kernel_launch: unexpected shapes: n_in %d out %d ws %zu (need %zu)\n", n_in, out_size, ws_size, (size_t)WS_END); grid = -1; return; }
        int dev = 0, cus = 0, per_cu = 0;
        if (hipGetDevice(&dev) != hipSuccess || hipDeviceGetAttribute(&cus, hipDeviceAttributeMultiprocessorCount, dev) != hipSuccess) { grid = -1; return; }
        if (hipFuncSetAttribute((const void*)mega, hipFuncAttributeMaxDynamicSharedMemorySize, LDS_BYTES) != hipSuccess) { fprintf(stderr, "kernel_launch: hipFuncSetAttribute failed\n"); grid = -1; return; }
        if (hipOccupancyMaxActiveBlocksPerMultiprocessor(&per_cu, (const void*)mega, NTHREADS, LDS_BYTES) != hipSuccess || per_cu < 1) { fprintf(stderr, "kernel_launch: occupancy query says %d\n", per_cu); per_cu = 1; }
        (void)hipGetLastError();
        grid = cus * 1;
    }
    if (grid < 0) return;
    if (hipMemsetAsync((char*)d_ws + WS_CTL, 0, 1024, stream) != hipSuccess) { fprintf(stderr, "kernel_launch: memset failed\n"); return; }
    Params p{};
    for (int i = 0; i < 22; ++i) p.in[i] = (const float*)d_in[i];
    p.out = (float*)d_out; p.ws = (unsigned char*)d_ws;
#if MK_COOP
    p.ph_lo = 0; p.ph_hi = N_PHASES;
    void* args[] = { &p };
    hipError_t e = hipLaunchCooperativeKernel((const void*)mega, dim3(grid), dim3(NTHREADS), args, LDS_BYTES, stream);
    if (e != hipSuccess) fprintf(stderr, "cooperative launch failed: %s (grid %d)\n", hipGetErrorString(e), grid);
#else
    for (int ph = 0; ph < N_PHASES; ++ph) {
        p.ph_lo = ph; p.ph_hi = ph + 1;
        hipLaunchKernelGGL(mega, dim3(grid), dim3(NTHREADS), LDS_BYTES, stream, p);
    }
#endif
}
```

```cpp
#include <hip/hip_runtime.h>
#include <hip/hip_cooperative_groups.h>
#include <cstdio>
#include <cstdint>
namespace cg = cooperative_groups;

#ifndef MK_COOP
#define MK_COOP 1
#endif
#ifndef PROBE_DUP
#define PROBE_DUP 0
#endif
#ifndef PROBE_ABL
#define PROBE_ABL 0
#endif

#define LAS __attribute__((address_space(3)))
typedef unsigned short bf16_t;
typedef short bf16x8 __attribute__((ext_vector_type(8)));
typedef float f32x4 __attribute__((ext_vector_type(4)));
typedef float f32x2 __attribute__((ext_vector_type(2)));
typedef unsigned u32x4 __attribute__((ext_vector_type(4)));
typedef unsigned u32x2 __attribute__((ext_vector_type(2)));

constexpr int T_TOK = 65536;
constexpr int SEQ_L = 8192;
constexpr int DM = 1024;
constexpr int GLA_IN_W = 7184, S5_IN_W = 6144;
constexpr float EPSN = 1e-6f;
constexpr float L2E = 1.4426950408889634f;

constexpr size_t MiB = 1024ull * 1024ull;
constexpr size_t WS_H = 0;
constexpr size_t WS_QK = 128 * MiB;
constexpr size_t WS_G = 256 * MiB;
constexpr size_t WS_MIX = 384 * MiB;
constexpr size_t WS_KMEM = 768 * MiB;
constexpr size_t WS_VT = 784 * MiB;
constexpr size_t WS_MEMN = 800 * MiB;
constexpr size_t WS_SUMSQ = 804 * MiB;
constexpr size_t WS_CTL = 806 * MiB;
constexpr size_t WS_WT = 807 * MiB;
constexpr size_t WT_GLA_PER = (size_t)(4608 + 3072) * 1024;
constexpr size_t WT_GLA_A2 = (size_t)4608 * 1024;
constexpr size_t WT_S5_BASE = 2 * WT_GLA_PER;
constexpr size_t WT_S5_PER = (size_t)6144 * 1024 + (size_t)2048 * 2048;
constexpr size_t WT_S5_A2 = (size_t)3072 * 1024;
constexpr size_t WT_S5_GLU = (size_t)6144 * 1024;
constexpr size_t WT_OUT_BASE = WT_S5_BASE + 2 * WT_S5_PER;
constexpr size_t WT_OUT_PER = (size_t)1024 * 3072;
constexpr size_t WT_K_BASE = WT_OUT_BASE + 4 * WT_OUT_PER;
constexpr size_t WT_V_BASE = WT_K_BASE + (size_t)4096 * 1024;
constexpr size_t WT_TOTAL = WT_V_BASE + (size_t)4096 * 1024;
constexpr size_t WS_END = WS_WT + WT_TOTAL * 2;
constexpr size_t WS_PART = 920 * MiB;
static_assert(WS_END <= WS_PART && WS_PART + (size_t)T_TOK * 64 * 4 <= 1024 * MiB, "workspace map");

constexpr int LDS_BYTES = 144 * 1024;
constexpr int NTHREADS = 512;

struct Params {
    const float* in[22];
    float* out;
    unsigned char* ws;
    int ph_lo, ph_hi;
};

typedef __bf16 bf16x2_t __attribute__((ext_vector_type(2)));
__device__ __forceinline__ unsigned pk2(float lo, float hi) { f32x2 v = {lo, hi}; bf16x2_t b = __builtin_convertvector(v, bf16x2_t); return __builtin_bit_cast(unsigned, b); }
__device__ __forceinline__ bf16_t bf1(float v) { return (bf16_t)(pk2(v, 0.f) & 0xffffu); }
__device__ __forceinline__ float bflo(unsigned u) { return __uint_as_float(u << 16); }
__device__ __forceinline__ float bfhi(unsigned u) { return __uint_as_float(u & 0xffff0000u); }
__device__ __forceinline__ float wave_sum(float v) {
#pragma unroll
    for (int o = 1; o < 64; o <<= 1) v += __shfl_xor(v, o);
    return v;
}
__device__ __forceinline__ float fexp(float x) { return __builtin_amdgcn_exp2f(x * L2E); }
__device__ __forceinline__ float frcp(float x) { return __builtin_amdgcn_rcpf(x); }
__device__ __forceinline__ float fsigmoid(float x) { return frcp(1.f + fexp(-x)); }
__device__ __forceinline__ void wave_sync() { asm volatile("s_waitcnt lgkmcnt(0)" ::: "memory"); __builtin_amdgcn_wave_barrier(); }
#define LDS_BAR() do { asm volatile("s_waitcnt lgkmcnt(0)" ::: "memory"); __builtin_amdgcn_s_barrier(); asm volatile("" ::: "memory"); } while (0)
__device__ __forceinline__ void st_global_b64(void* ptr, u32x2 v) { asm volatile("global_store_dwordx2 %0, %1, off" :: "v"(ptr), "v"(v) : "memory"); }
__device__ __forceinline__ void st_global_b128(void* ptr, u32x4 v) { asm volatile("global_store_dwordx4 %0, %1, off\n\ts_nop 1" :: "v"(ptr), "v"(v) : "memory"); }
__device__ __forceinline__ void st_global_f128(void* ptr, f32x4 v) { asm volatile("global_store_dwordx4 %0, %1, off\n\ts_nop 1" :: "v"(ptr), "v"(v) : "memory"); }
__device__ __forceinline__ float fma_s(float a, float b, float c) { float d; asm("v_fma_f32 %0, %1, %2, %3" : "=v"(d) : "v"(a), "v"(b), "v"(c)); return d; }
__device__ __forceinline__ void st_global_b32(void* ptr, float v) { asm volatile("global_store_dword %0, %1, off" :: "v"(ptr), "v"(v) : "memory"); }
__device__ __forceinline__ void atomic_add_u64_noret(unsigned long long* ptr, unsigned long long v) { asm volatile("global_atomic_add_x2 %0, %1, off" :: "v"(ptr), "v"(v) : "memory"); }
#define MFMA16(a, b, c) __builtin_amdgcn_mfma_f32_16x16x32_bf16((a), (b), (c), 0, 0, 0)

namespace pg8 {
constexpr int BM = 256, BK = 64, HALF = 128, HTB = HALF * BK * 2, STAGE_BYTES = 8 * HTB, NXCD = 8, WGM = 8;
__device__ __forceinline__ int lds_byte(int r, int c) { const int st = (r >> 4) * 2 + (c >> 5), rr = r & 15, cc = c & 31, ob = rr * 64 + cc * 2; return st * 1024 + (ob ^ (((ob >> 9) & 1) << 5)); }
__device__ __forceinline__ void stage_rc(int b, int& R, int& C) { const int st = b / 1024, sb = b % 1024, swz = sb ^ (((sb >> 9) & 1) << 5); R = (st >> 1) * 16 + swz / 64; C = (st & 1) * 32 + (swz % 64) / 2; }
__device__ __forceinline__ int perm32(int rho) { const int n = rho >> 4, i = rho & 15; return 8 * (i >> 2) + 4 * n + (i & 3); }
struct Unit { int pm, pn; };
struct Gemm { const bf16_t* A; const bf16_t* Bt; int M, N, K; };
struct StaticOrder {
    int nM, nN, nwg, G, c;
    __device__ void init(int M, int N, int G_, int c_) { nM = M / BM; nN = N / BM; nwg = nM * nN; G = G_; c = c_; }
    __device__ bool next(int i, Unit& u) const {
        const long L = (long)i * G + c; if (L >= nwg) return false;
        int wgid = (int)L; { const int q = nwg / NXCD, r = nwg % NXCD, xcd = wgid % NXCD, off = wgid / NXCD; wgid = (xcd < r ? xcd * (q + 1) : r * (q + 1) + (xcd - r) * q) + off; }
        const int nig = WGM * nN, gid = wgid / nig, fm = gid * WGM, gsz = (nM - fm) < WGM ? (nM - fm) : WGM;
        u.pm = fm + ((wgid % nig) % gsz); u.pn = (wgid % nig) / gsz; return true;
    }
};

enum { EM_BF16 = 0, EM_A1GLA = 1, EM_GATE = 2, EM_GLU = 3, EM_RESID = 4 };
struct Epi {
    int mode;
    bf16_t* o0; int ld0;
    bf16_t* qk; float* g; const float* gbias; bf16_t* mix;
    const float* part; const float* onw; int is_gla;
    const bf16_t* y5; const float* bglu;
    const float* xin; float* xout;
    __device__ __forceinline__ void operator()(const f32x4 (&acc)[2][2][4][2], const Unit& u, int wr, int wc, int fr, int fq) const {
        const int row0 = u.pm * BM + wr * 64 + fr;
        const int cb = u.pn * BM + wc * 32 + 8 * fq;
#define EPI_ROW(it) ((size_t)(row0 + ((it) >> 3) * HALF + (((it) >> 1) & 3) * 16))
#define EPI_COL(it) (cb + ((it) & 1) * HALF)
#define EPI_V0(it) acc[(it) >> 3][(it) & 1][((it) >> 1) & 3][0]
#define EPI_V1(it) acc[(it) >> 3][(it) & 1][((it) >> 1) & 3][1]
        if (mode == EM_BF16) {
#pragma unroll
            for (int it = 0; it < 16; ++it) { const f32x4 v0 = EPI_V0(it), v1 = EPI_V1(it);
                u32x4 o; o.x = pk2(v0[0], v0[1]); o.y = pk2(v0[2], v0[3]); o.z = pk2(v1[0], v1[1]); o.w = pk2(v1[2], v1[3]);
                *(u32x4*)(o0 + EPI_ROW(it) * ld0 + EPI_COL(it)) = o; }
        } else if (mode == EM_A1GLA) {
            if (u.pn < 4) {
                const float sc = (u.pn < 2) ? 0.08838834764831845f : 1.f;
#pragma unroll
                for (int it = 0; it < 16; ++it) { const f32x4 v0 = EPI_V0(it), v1 = EPI_V1(it);
                    u32x4 o; o.x = pk2(v0[0] * sc, v0[1] * sc); o.y = pk2(v0[2] * sc, v0[3] * sc); o.z = pk2(v1[0] * sc, v1[1] * sc); o.w = pk2(v1[2] * sc, v1[3] * sc);
                    *(u32x4*)(qk + EPI_ROW(it) * 1024 + EPI_COL(it)) = o; }
            } else if (u.pn < 6) {
                f32x4 bia[2][2];
#pragma unroll
                for (int bj = 0; bj < 2; ++bj) { bia[bj][0] = *(const f32x4*)(gbias + cb + bj * HALF - 1024); bia[bj][1] = *(const f32x4*)(gbias + cb + bj * HALF - 1024 + 4); }
#pragma unroll
                for (int it = 0; it < 16; ++it) { const f32x4 v0 = EPI_V0(it), v1 = EPI_V1(it); const int gc = EPI_COL(it) - 1024;
                    f32x4 r0, r1;
#pragma unroll
                    for (int e = 0; e < 4; ++e) {
                        const float x0 = v0[e] + bia[it & 1][0][e], x1 = v1[e] + bia[it & 1][1][e];
                        r0[e] = (fminf(x0, 0.f) - __logf(1.f + fexp(-fabsf(x0)))) * 0.0625f;
                        r1[e] = (fminf(x1, 0.f) - __logf(1.f + fexp(-fabsf(x1)))) * 0.0625f;
                    }
                    *(f32x4*)(g + EPI_ROW(it) * 512 + gc) = r0; *(f32x4*)(g + EPI_ROW(it) * 512 + gc + 4) = r1; }
            } else {
#pragma unroll
                for (int it = 0; it < 16; ++it) { const f32x4 v0 = EPI_V0(it), v1 = EPI_V1(it);
                    u32x4 o; o.x = pk2(v0[0], v0[1]); o.y = pk2(v0[2], v0[3]); o.z = pk2(v1[0], v1[1]); o.w = pk2(v1[2], v1[3]);
                    *(u32x4*)(mix + EPI_ROW(it) * 3072 + (EPI_COL(it) - 1536)) = o; }
            }
        } else if (mode == EM_GATE) {
            const bool nrm = is_gla && (cb < 2048);
            float rs[8]; f32x4 wv[2][2];
#pragma unroll
            for (int i = 0; i < 8; ++i) rs[i] = 1.f;
#pragma unroll
            for (int bj = 0; bj < 2; ++bj) { wv[bj][0] = (f32x4){1.f, 1.f, 1.f, 1.f}; wv[bj][1] = (f32x4){1.f, 1.f, 1.f, 1.f}; }
            if (nrm) {
#pragma unroll
                for (int i = 0; i < 8; ++i) {
                    const f32x4* pp = (const f32x4*)(part + (EPI_ROW(2 * i) * 4 + (cb >> 9)) * 16);
                    const f32x4 p0 = pp[0], p1 = pp[1], p2 = pp[2], p3 = pp[3];
                    const float ssum = ((p0[0] + p0[1]) + (p0[2] + p0[3])) + ((p1[0] + p1[1]) + (p1[2] + p1[3])) + ((p2[0] + p2[1]) + (p2[2] + p2[3])) + ((p3[0] + p3[1]) + (p3[2] + p3[3]));
                    rs[i] = rsqrtf(ssum * (1.f / 512.f) + EPSN);
                }
#pragma unroll
                for (int bj = 0; bj < 2; ++bj) { wv[bj][0] = *(const f32x4*)(onw + ((cb + bj * HALF) & 511)); wv[bj][1] = *(const f32x4*)(onw + ((cb + bj * HALF) & 511) + 4); }
            }
#pragma unroll
            for (int hb = 0; hb < 4; ++hb) {
            u32x4 mva[4];
#pragma unroll
            for (int i = 0; i < 4; ++i) mva[i] = *(const u32x4*)(mix + EPI_ROW(hb * 4 + i) * 3072 + EPI_COL(hb * 4 + i));
#pragma unroll
            for (int i = 0; i < 4; ++i) { const int it = hb * 4 + i;
                const u32x4 mv = mva[i];
                const f32x4 v0 = EPI_V0(it), v1 = EPI_V1(it);
                const float f[8] = { bflo(mv.x), bfhi(mv.x), bflo(mv.y), bfhi(mv.y), bflo(mv.z), bfhi(mv.z), bflo(mv.w), bfhi(mv.w) };
                const float r = rs[it >> 1];
                float y[8];
#pragma unroll
                for (int e = 0; e < 4; ++e) { y[e] = f[e] * (r * wv[it & 1][0][e]) * v0[e] * fsigmoid(v0[e]); y[4 + e] = f[4 + e] * (r * wv[it & 1][1][e]) * v1[e] * fsigmoid(v1[e]); }
                u32x4 o; o.x = pk2(y[0], y[1]); o.y = pk2(y[2], y[3]); o.z = pk2(y[4], y[5]); o.w = pk2(y[6], y[7]);
                st_global_b128(mix + EPI_ROW(it) * 3072 + EPI_COL(it), o);
            }
            }
        } else if (mode == EM_GLU) {
            f32x4 bia[2][2];
#pragma unroll
            for (int bj = 0; bj < 2; ++bj) { bia[bj][0] = *(const f32x4*)(bglu + cb + bj * HALF); bia[bj][1] = *(const f32x4*)(bglu + cb + bj * HALF + 4); }
#pragma unroll
            for (int hb = 0; hb < 2; ++hb) {
            u32x4 mva[8];
#pragma unroll
            for (int i = 0; i < 8; ++i) mva[i] = *(const u32x4*)(y5 + EPI_ROW(hb * 8 + i) * 2048 + EPI_COL(hb * 8 + i));
#pragma unroll
            for (int i = 0; i < 8; ++i) { const int it = hb * 8 + i;
                const u32x4 mv = mva[i];
                const f32x4 v0 = EPI_V0(it), v1 = EPI_V1(it);
                const float f[8] = { bflo(mv.x), bfhi(mv.x), bflo(mv.y), bfhi(mv.y), bflo(mv.z), bfhi(mv.z), bflo(mv.w), bfhi(mv.w) };
                float y[8];
#pragma unroll
                for (int e = 0; e < 4; ++e) { y[e] = f[e] * fsigmoid(v0[e] + bia[it & 1][0][e]); y[4 + e] = f[4 + e] * fsigmoid(v1[e] + bia[it & 1][1][e]); }
                u32x4 o; o.x = pk2(y[0], y[1]); o.y = pk2(y[2], y[3]); o.z = pk2(y[4], y[5]); o.w = pk2(y[6], y[7]);
                st_global_b128(mix + EPI_ROW(it) * 3072 + EPI_COL(it), o);
            }
            }
        } else {
#pragma unroll
            for (int hb = 0; hb < 4; ++hb) {
                f32x4 xa[4][2];
#pragma unroll
                for (int i = 0; i < 4; ++i) { const int it = hb * 4 + i; xa[i][0] = *(const f32x4*)(xin + EPI_ROW(it) * 1024 + EPI_COL(it)); xa[i][1] = *(const f32x4*)(xin + EPI_ROW(it) * 1024 + EPI_COL(it) + 4); }
#pragma unroll
                for (int i = 0; i < 4; ++i) { const int it = hb * 4 + i;
                    st_global_f128(xout + EPI_ROW(it) * 1024 + EPI_COL(it), xa[i][0] + EPI_V0(it)); st_global_f128(xout + EPI_ROW(it) * 1024 + EPI_COL(it) + 4, xa[i][1] + EPI_V1(it)); }
            }
        }
#undef EPI_ROW
#undef EPI_COL
#undef EPI_V0
#undef EPI_V1
    }
};

__device__ __forceinline__ void gemm_phase(LAS unsigned char* lds, const Gemm g, const StaticOrder& S, const Epi& E) {
    int tid_ = threadIdx.x; asm volatile("" : "+v"(tid_));
    const int tid = tid_, wid = __builtin_amdgcn_readfirstlane(tid >> 6), lane = tid & 63, wr = wid >> 2, wc = wid & 3, fr = lane & 15, fq = lane >> 4;
    const int K = g.K, nt = K / BK;
    unsigned voffA[2], voffB[2];
#pragma unroll
    for (int i = 0; i < 2; ++i) { int R, C; stage_rc(tid * 16 + i * 8192, R, C); const int Rb = (R & ~31) + perm32(R & 31);
        voffA[i] = (unsigned)(R * K + C) * 2u; voffB[i] = (unsigned)(Rb * K + C) * 2u; }
    const size_t kstep = (size_t)(BK * 2);
    const size_t hstep = (size_t)HALF * K * 2;
    const size_t tstep = 2 * hstep;
    const unsigned ldsw = (unsigned)wid * 1024u;
    const int aoff = lds_byte(wr * 64 + fr, fq * 8), boff = lds_byte(wc * 32 + fr, fq * 8);
#define PG8_SA(b, h) (((b) * 2 + (h)) * HTB)
#define PG8_SB(b, h) ((4 + (b) * 2 + (h)) * HTB)
#define PG8_STAGE(bufoff, gbase, voff) do { _Pragma("unroll") for (int _i = 0; _i < 2; ++_i) \
        __builtin_amdgcn_global_load_lds((const unsigned*)((const char*)(gbase) + (voff)[_i]), (LAS unsigned*)(lds + (bufoff) + ldsw + _i * 8192), 16, 0, 0); } while (0)
#define PG8_LDA(dst, b, h) do { _Pragma("unroll") for (int m = 0; m < 4; ++m) _Pragma("unroll") for (int k = 0; k < 2; ++k) dst[m][k] = *(const LAS bf16x8*)(lds + PG8_SA(b, h) + aoff + m * 2048 + k * 1024); } while (0)
#define PG8_LDB(dst, b, h) do { _Pragma("unroll") for (int n = 0; n < 2; ++n) _Pragma("unroll") for (int k = 0; k < 2; ++k) dst[n][k] = *(const LAS bf16x8*)(lds + PG8_SB(b, h) + boff + n * 2048 + k * 1024); } while (0)
#define PG8_MMA(ai, bj, At, Bt) do { __builtin_amdgcn_s_setprio(1); _Pragma("unroll") for (int m = 0; m < 4; ++m) _Pragma("unroll") for (int n = 0; n < 2; ++n) _Pragma("unroll") for (int k = 0; k < 2; ++k) \
        acc[ai][bj][m][n] = __builtin_amdgcn_mfma_f32_16x16x32_bf16(Bt[n][k], At[m][k], acc[ai][bj][m][n], 0, 0, 0); __builtin_amdgcn_s_setprio(0); } while (0)
#define PG8_WAIT_V(n) asm volatile("s_waitcnt vmcnt(" #n ")" ::: "memory")
#define PG8_WAIT_L(n) asm volatile("s_waitcnt lgkmcnt(" #n ")" ::: "memory")
#define PG8_BAR __builtin_amdgcn_s_barrier()
#define PG8_SCHED __builtin_amdgcn_sched_barrier(0)
    Unit cur, nxt; int ui = 0;
    if (!S.next(0, cur)) return;
    f32x4 acc[2][2][4][2];
#pragma unroll
    for (int a = 0; a < 2; ++a)
#pragma unroll
        for (int b = 0; b < 2; ++b)
#pragma unroll
            for (int m = 0; m < 4; ++m)
#pragma unroll
                for (int n = 0; n < 2; ++n) acc[a][b][m][n] = (f32x4){0.f, 0.f, 0.f, 0.f};
    bf16x8 At[4][2], B0[2][2], B1[2][2];
    const char* cA = (const char*)g.A + (size_t)cur.pm * tstep; const char* cB = (const char*)g.Bt + (size_t)cur.pn * tstep;
    PG8_STAGE(PG8_SB(0, 0), cB, voffB); PG8_STAGE(PG8_SB(0, 1), cB + hstep, voffB); PG8_STAGE(PG8_SA(0, 0), cA, voffA); PG8_STAGE(PG8_SA(0, 1), cA + hstep, voffA);
    if (wr == 1) PG8_BAR;
    PG8_WAIT_V(2); PG8_BAR;
    PG8_STAGE(PG8_SB(1, 0), cB + kstep, voffB); PG8_STAGE(PG8_SA(1, 0), cA + kstep, voffA); PG8_STAGE(PG8_SB(1, 1), cB + hstep + kstep, voffB);
    PG8_WAIT_V(6); PG8_BAR;
    for (;;) {
        const bool has_next = S.next(ui + 1, nxt);
        const char* nA = has_next ? (const char*)g.A + (size_t)nxt.pm * tstep : cA; const char* nB = has_next ? (const char*)g.Bt + (size_t)nxt.pn * tstep : cB;
        for (int t = 0; t < nt; t += 2) {
            const bool last = (t == nt - 2);
            const char* a1 = cA + (size_t)(t + 1) * kstep;
            const char* a2 = last ? nA : cA + (size_t)(t + 2) * kstep; const char* b2 = last ? nB : cB + (size_t)(t + 2) * kstep;
            const char* a3 = a2 + kstep; const char* b3 = b2 + kstep;
            PG8_LDB(B0, 0, 0); PG8_LDB(B1, 0, 1); PG8_SCHED; PG8_LDA(At, 0, 0); PG8_STAGE(PG8_SA(1, 1), a1 + hstep, voffA);
            PG8_WAIT_V(8); PG8_WAIT_L(0); PG8_BAR; PG8_MMA(0, 0, At, B0); PG8_MMA(0, 1, At, B1); PG8_BAR; PG8_SCHED;
            PG8_LDA(At, 0, 1); PG8_STAGE(PG8_SB(0, 0), b2, voffB); PG8_STAGE(PG8_SB(0, 1), b2 + hstep, voffB); PG8_STAGE(PG8_SA(0, 0), a2, voffA);
            PG8_WAIT_V(8); PG8_WAIT_L(0); PG8_BAR; PG8_MMA(1, 0, At, B0); PG8_MMA(1, 1, At, B1); PG8_BAR; PG8_SCHED;
            PG8_LDB(B0, 1, 0); PG8_LDB(B1, 1, 1); PG8_SCHED; PG8_LDA(At, 1, 0); PG8_STAGE(PG8_SA(0, 1), a2 + hstep, voffA);
            PG8_WAIT_V(8); PG8_WAIT_L(0); PG8_BAR; PG8_MMA(0, 0, At, B0); PG8_MMA(0, 1, At, B1); PG8_BAR; PG8_SCHED;
            PG8_LDA(At, 1, 1); PG8_STAGE(PG8_SB(1, 0), b3, voffB); PG8_STAGE(PG8_SB(1, 1), b3 + hstep, voffB); PG8_STAGE(PG8_SA(1, 0), a3, voffA);
            PG8_WAIT_V(8); PG8_WAIT_L(0); PG8_BAR; PG8_MMA(1, 0, At, B0); PG8_MMA(1, 1, At, B1); PG8_BAR; PG8_SCHED;
        }
        if (wr == 0) PG8_BAR;
        E(acc, cur, wr, wc, fr, fq);
        if (!has_next) break;
#pragma unroll
        for (int a = 0; a < 2; ++a)
#pragma unroll
            for (int b = 0; b < 2; ++b)
#pragma unroll
                for (int m = 0; m < 4; ++m)
#pragma unroll
                    for (int n = 0; n < 2; ++n) acc[a][b][m][n] = (f32x4){0.f, 0.f, 0.f, 0.f};
        cur = nxt; cA = nA; cB = nB; ++ui;
        if (wr == 1) PG8_BAR;
    }
    PG8_WAIT_V(0);
    PG8_BAR;
#undef PG8_SA
#undef PG8_SB
#undef PG8_STAGE
#undef PG8_LDA
#undef PG8_LDB
#undef PG8_MMA
#undef PG8_WAIT_V
#undef PG8_WAIT_L
#undef PG8_BAR
#undef PG8_SCHED
}
}

struct TJob { const float* src; int ld, K, c0, nc; bf16_t* dst; };
constexpr int N_TITEMS = 13824;

__device__ __forceinline__ void rms_rows(const float* x, const float* w, bf16_t* out_bf, float* out_f, int nrows, bool grouped = false) {
    int tid_ = threadIdx.x; asm volatile("" : "+v"(tid_));
    const int lane = tid_ & 63, wave = tid_ >> 6;
    int gw = blockIdx.x * 8 + wave, ngw = gridDim.x * 8;
    if (grouped) {
        const int per = nrows >> 3, lw = (int)(blockIdx.x >> 3) * 8 + wave, nlw = (int)(gridDim.x >> 3) * 8;
        x += (size_t)(blockIdx.x & 7) * per * 1024;
        if (out_bf) out_bf += (size_t)(blockIdx.x & 7) * per * 1024;
        if (out_f) out_f += (size_t)(blockIdx.x & 7) * per * 1024;
        nrows = per; gw = lw; ngw = nlw;
    }
    f32x4 wv[4];
#pragma unroll
    for (int j = 0; j < 4; ++j) wv[j] = ((const f32x4*)w)[lane + 64 * j];
    f32x4 vn[4];
    if (gw < nrows) {
        const f32x4* xr = (const f32x4*)(x + (size_t)gw * 1024) + lane;
#pragma unroll
        for (int j = 0; j < 4; ++j) vn[j] = xr[64 * j];
    }
    for (int r = gw; r < nrows; r += ngw) {
        f32x4 v[4];
#pragma unroll
        for (int j = 0; j < 4; ++j) v[j] = vn[j];
        const int rn = (r + ngw < nrows) ? r + ngw : r;
        {
            const f32x4* xr = (const f32x4*)(x + (size_t)rn * 1024) + lane;
#pragma unroll
            for (int j = 0; j < 4; ++j) vn[j] = xr[64 * j];
        }
        float s = 0.f;
#pragma unroll
        for (int j = 0; j < 4; ++j) s += (v[j][0] * v[j][0] + v[j][1] * v[j][1]) + (v[j][2] * v[j][2] + v[j][3] * v[j][3]);
        s = wave_sum(s);
        const float rs = rsqrtf(s * (1.f / 1024.f) + EPSN);
#pragma unroll
        for (int j = 0; j < 4; ++j) {
            f32x4 o; o[0] = v[j][0] * rs * wv[j][0]; o[1] = v[j][1] * rs * wv[j][1]; o[2] = v[j][2] * rs * wv[j][2]; o[3] = v[j][3] * rs * wv[j][3];
            if (out_bf) { u32x2 pk; pk.x = pk2(o[0], o[1]); pk.y = pk2(o[2], o[3]); st_global_b64(out_bf + (size_t)r * 1024 + (size_t)(lane + 64 * j) * 4, pk); }
            else st_global_f128(out_f + (size_t)r * 1024 + (size_t)(lane + 64 * j) * 4, o);
        }
    }
}

__device__ __forceinline__ void prep_phase(const Params& p, unsigned char* smem) {
    bf16_t* WT = (bf16_t*)(p.ws + WS_WT);
    float* tile = (float*)smem;
    int tid_ = threadIdx.x; asm volatile("" : "+v"(tid_)); const int tid = tid_;
    auto decode = [&](int it, TJob& jb, int& r) {
        r = it; bool found = false; jb.src = nullptr; jb.ld = 0; jb.K = 0; jb.c0 = 0; jb.nc = 64; jb.dst = nullptr;
        auto tj = [&](const float* src, int ld, int K, int c0, int nc, bf16_t* dst) {
            if (!found) { const int ni = (K / 64) * (nc / 64); if (r < ni) { jb.src = src; jb.ld = ld; jb.K = K; jb.c0 = c0; jb.nc = nc; jb.dst = dst; found = true; } else r -= ni; } };
        for (int j = 0; j < 2; ++j) {
            const float* w = p.in[4] + (size_t)j * 1024 * GLA_IN_W; bf16_t* a1 = WT + j * WT_GLA_PER;
            tj(w, GLA_IN_W, 1024, 0, 1024, a1);
            tj(w, GLA_IN_W, 1024, 1024, 2048, a1 + (size_t)1536 * 1024);
            tj(w, GLA_IN_W, 1024, 6160, 1024, a1 + (size_t)3584 * 1024);
            tj(w, GLA_IN_W, 1024, 3088, 3072, a1 + WT_GLA_A2);
        }
        for (int j = 0; j < 2; ++j) {
            const float* w = p.in[8] + (size_t)j * 1024 * S5_IN_W; bf16_t* a1 = WT + WT_S5_BASE + j * WT_S5_PER;
            tj(w, S5_IN_W, 1024, 0, 2048, a1);
            tj(w, S5_IN_W, 1024, 5120, 1024, a1 + (size_t)2048 * 1024);
            tj(w, S5_IN_W, 1024, 2048, 3072, a1 + WT_S5_A2);
            tj(p.in[17] + (size_t)j * 2048 * 2048, 2048, 2048, 0, 2048, a1 + WT_S5_GLU);
        }
        for (int i = 0; i < 4; ++i) tj(p.in[20] + (size_t)i * 3072 * 1024, 1024, 3072, 0, 1024, WT + WT_OUT_BASE + i * WT_OUT_PER);
        for (int i = 0; i < 4; ++i) {
            const float* w = p.in[19] + (size_t)i * 1024 * 2048;
            tj(w, 2048, 1024, 0, 1024, WT + WT_K_BASE + (size_t)i * 1024 * 1024);
            tj(w, 2048, 1024, 1024, 1024, WT + WT_V_BASE + (size_t)i * 1024 * 1024);
        }
    };
    const int lk = tid >> 4, lc4 = (tid & 15) * 4;
    for (int it0 = blockIdx.x * 4; it0 < N_TITEMS; it0 += gridDim.x * 4) {
        TJob jb[4]; int rr[4]; f32x4 v0[4], v1[4];
#pragma unroll
        for (int u = 0; u < 4; ++u) {
            const int it = (it0 + u < N_TITEMS) ? it0 + u : it0;
            decode(it, jb[u], rr[u]);
            const int nblk = jb[u].nc / 64, kb = rr[u] / nblk, nb = rr[u] % nblk;
            const float* sp = jb[u].src + (size_t)(kb * 64 + lk) * jb[u].ld + jb[u].c0 + nb * 64 + lc4;
            v0[u] = *(const f32x4*)sp; v1[u] = *(const f32x4*)(sp + (size_t)32 * jb[u].ld);
        }
#pragma unroll
        for (int u = 0; u < 4; ++u) {
            tile[lk * 65 + lc4 + 0] = v0[u][0]; tile[lk * 65 + lc4 + 1] = v0[u][1]; tile[lk * 65 + lc4 + 2] = v0[u][2]; tile[lk * 65 + lc4 + 3] = v0[u][3];
            tile[(lk + 32) * 65 + lc4 + 0] = v1[u][0]; tile[(lk + 32) * 65 + lc4 + 1] = v1[u][1]; tile[(lk + 32) * 65 + lc4 + 2] = v1[u][2]; tile[(lk + 32) * 65 + lc4 + 3] = v1[u][3];
            LDS_BAR();
            const int nblk = jb[u].nc / 64, kb = rr[u] / nblk, nb = rr[u] % nblk, k0 = kb * 64, n0 = nb * 64;
            const int n = tid >> 3, kc = (tid & 7) * 8;
            u32x4 o;
            o.x = pk2(tile[(kc + 0) * 65 + n], tile[(kc + 1) * 65 + n]); o.y = pk2(tile[(kc + 2) * 65 + n], tile[(kc + 3) * 65 + n]);
            o.z = pk2(tile[(kc + 4) * 65 + n], tile[(kc + 5) * 65 + n]); o.w = pk2(tile[(kc + 6) * 65 + n], tile[(kc + 7) * 65 + n]);
            st_global_b128(jb[u].dst + (size_t)(n0 + n) * jb[u].K + k0 + kc, o);
            LDS_BAR();
        }
    }
    asm volatile("s_waitcnt vmcnt(0)" ::: "memory");
    __syncthreads();
    for (int idx = blockIdx.x * NTHREADS + tid; idx < 2 * 512 * 1024; idx += gridDim.x * NTHREADS) {
        const int j = idx >> 19, n = (idx >> 10) & 511, k = idx & 1023;
        const float* wr_ = p.in[4] + (size_t)j * 1024 * GLA_IN_W + (size_t)k * GLA_IN_W + 3072;
        const float* wg = p.in[5] + (size_t)j * 16 * 512 + n;
        float s = 0.f;
#pragma unroll
        for (int r = 0; r < 16; ++r) s += wr_[r] * wg[r * 512];
        WT[j * WT_GLA_PER + (size_t)(1024 + n) * 1024 + k] = bf1(s);
    }
    rms_rows(p.in[1], p.in[3], (bf16_t*)(p.ws + WS_MEMN), nullptr, 2048);
}

__device__ __forceinline__ void norm_phase(const Params& p, int layer) {
    const float* x = (layer == 0) ? p.in[0] : p.out;
    rms_rows(x, p.in[2] + layer * 1024, (bf16_t*)(p.ws + WS_H), nullptr, T_TOK, layer > 0);
    unsigned long long* ss = (unsigned long long*)(p.ws + WS_SUMSQ);
    for (int i = blockIdx.x * NTHREADS + threadIdx.x; i < T_TOK * 4; i += gridDim.x * NTHREADS) ss[i] = 0ull;
}

__device__ __forceinline__ void attn_phase(const Params& p, int layer, unsigned char* smem) {
    bf16_t* mix = (bf16_t*)(p.ws + WS_MIX);
    const bf16_t* kmem = (const bf16_t*)(p.ws + WS_KMEM);
    const bf16_t* vt = (const bf16_t*)(p.ws + WS_VT);
    bf16_t* KV = (bf16_t*)smem;
    bf16_t* PB = (bf16_t*)(smem + 67584);
    float* RS = (float*)(smem + 135168);
    int tid_ = threadIdx.x; asm volatile("" : "+v"(tid_));
    const int tid = tid_, wave = tid >> 6, lane = tid & 63, fr = lane & 15, fq = lane >> 4;
    const int sr = tid >> 5, sc8 = (tid & 31) * 8;
    u32x4 stg[8];
#define ATT_SRC(unit_, ti_) (((ti_) < 2) \
        ? (kmem + (size_t)((((unit_) >> 2) >> 6) * 256 + (ti_) * 128 + sr) * 4096 + layer * 1024 + ((unit_) & 3) * 256 + sc8) \
        : (vt + (size_t)(layer * 1024 + ((unit_) & 3) * 256 + ((ti_) - 2) * 128 + sr) * 2048 + (((unit_) >> 2) >> 6) * 256 + sc8))
#define ATT_LOAD(unit_, ti_) do { const bf16_t* sp_ = ATT_SRC(unit_, ti_); const size_t rp_ = ((ti_) < 2) ? (size_t)16 * 4096 : (size_t)16 * 2048; \
        _Pragma("unroll") for (int i = 0; i < 8; ++i) stg[i] = *(const u32x4*)(sp_ + i * rp_); } while (0)
#define ATT_STAGE() do { _Pragma("unroll") for (int i = 0; i < 8; ++i) *(u32x4*)(KV + (sr + 16 * i) * 264 + sc8) = stg[i]; } while (0)
    const int ab = blockIdx.x & 7, astep = (int)(gridDim.x >> 3);
#define ATT_UNIT(u_) ((((ab << 6) + ((u_) >> 2)) << 2) | ((u_) & 3))
    int au = blockIdx.x >> 3;
    int unit = (au < 256) ? ATT_UNIT(au) : 2048;
    if (unit < 2048) ATT_LOAD(unit, 0);
    __syncthreads();
    for (; au < 256; au += astep, unit = (au < 256) ? ATT_UNIT(au) : 2048) {
        const int h = unit & 3, tile = unit >> 2;
        const size_t t0 = (size_t)tile * 128;
        const int unext = (au + astep < 256) ? ATT_UNIT(au + astep) : unit;
        bf16x8 qf[8];
        {
            const bf16_t* qrow = mix + (t0 + wave * 16 + fr) * 3072 + 2048 + h * 256 + fq * 8;
#pragma unroll
            for (int ks = 0; ks < 8; ++ks) qf[ks] = *(const bf16x8*)(qrow + ks * 32);
        }
        f32x4 sacc[16];
#pragma unroll
        for (int half = 0; half < 2; ++half) {
            ATT_STAGE();
            LDS_BAR();
            ATT_LOAD(unit, half + 1);
#pragma unroll
            for (int mb = 0; mb < 8; ++mb) {
                f32x4 a = (f32x4){0.f, 0.f, 0.f, 0.f};
#pragma unroll
                for (int ks = 0; ks < 8; ++ks) { const bf16x8 bfr = *(const bf16x8*)(KV + (mb * 16 + fr) * 264 + ks * 32 + fq * 8); a = MFMA16(qf[ks], bfr, a); }
                sacc[half * 8 + mb] = a;
            }
            LDS_BAR();
        }
        const float sc = 0.0625f * L2E;
#pragma unroll
        for (int j = 0; j < 4; ++j) {
            float mx = sacc[0][j];
#pragma unroll
            for (int i = 1; i < 16; ++i) mx = fmaxf(mx, sacc[i][j]);
            mx = fmaxf(mx, __shfl_xor(mx, 1)); mx = fmaxf(mx, __shfl_xor(mx, 2)); mx = fmaxf(mx, __shfl_xor(mx, 4)); mx = fmaxf(mx, __shfl_xor(mx, 8));
            float sum = 0.f;
#pragma unroll
            for (int i = 0; i < 16; ++i) { const float e = __builtin_amdgcn_exp2f((sacc[i][j] - mx) * sc); sacc[i][j] = e; sum += e; }
            sum += __shfl_xor(sum, 1); sum += __shfl_xor(sum, 2); sum += __shfl_xor(sum, 4); sum += __shfl_xor(sum, 8);
            if (fr == 0) RS[wave * 16 + fq * 4 + j] = 1.f / sum;
#pragma unroll
            for (int i = 0; i < 16; ++i) PB[(wave * 16 + fq * 4 + j) * 264 + i * 16 + fr] = bf1(sacc[i][j]);
        }
        ATT_STAGE();
        LDS_BAR();
        bf16x8 pf[8];
#pragma unroll
        for (int ks = 0; ks < 8; ++ks) pf[ks] = *(const bf16x8*)(PB + (wave * 16 + fr) * 264 + ks * 32 + fq * 8);
        const float rinv = RS[wave * 16 + fr];
#pragma unroll
        for (int half = 0; half < 2; ++half) {
            if (half == 0) ATT_LOAD(unit, 3); else ATT_LOAD(unext, 0);
#pragma unroll
            for (int db = 0; db < 8; ++db) {
                f32x4 a = (f32x4){0.f, 0.f, 0.f, 0.f};
#pragma unroll
                for (int ks = 0; ks < 8; ++ks) { const bf16x8 bfr = *(const bf16x8*)(KV + (db * 16 + fr) * 264 + ks * 32 + fq * 8); a = MFMA16(bfr, pf[ks], a); }
                u32x2 o; o.x = pk2(a[0] * rinv, a[1] * rinv); o.y = pk2(a[2] * rinv, a[3] * rinv);
                st_global_b64(mix + (t0 + wave * 16 + fr) * 3072 + 2048 + h * 256 + half * 128 + db * 16 + fq * 4, o);
            }
            LDS_BAR();
            if (half == 0) { ATT_STAGE(); LDS_BAR(); }
        }
    }
#undef ATT_UNIT
#undef ATT_SRC
#undef ATT_LOAD
#undef ATT_STAGE
    asm volatile("s_waitcnt vmcnt(0)" ::: "memory");
    __syncthreads();
}

__device__ __forceinline__ void gla_pre_phase(const Params& p, unsigned char* smem, bool dry = false) {
    bf16_t* qk = (bf16_t*)(p.ws + WS_QK);
    unsigned char* Gb = p.ws + WS_G;
    float* BC = (float*)smem;
    float* SEG = (float*)(smem + 32768);
    float* BL = (float*)(smem + 32768 + 2048);
    bf16_t* QD = (bf16_t*)(smem + 35328);
    bf16_t* KI = QD + 64 * 136;
    bf16_t* KET = KI + 64 * 136;
    bf16_t* ATT = KET + 128 * 72;
    int tid_ = threadIdx.x; asm volatile("" : "+v"(tid_));
    const int tid = tid_, w = tid >> 6, lane = tid & 63, fr = lane & 15, fq = lane >> 4;
    const int cd = tid & 127, seg = tid >> 7;
    const int es = tid >> 3, dseg = tid & 7;
    const int cb = w >> 1;
    for (int pu = blockIdx.x >> 3; pu < 512; pu += (int)(gridDim.x >> 3)) {
        const int h = pu & 3, bc = (int)(blockIdx.x & 7) * 128 + (pu >> 2);
        const size_t t0 = (size_t)bc * 64;
        const float* G = (const float*)Gb;
        float gpre[16];
#pragma unroll
        for (int i = 0; i < 16; ++i) gpre[i] = G[(t0 + seg * 16 + i) * 512 + h * 128 + cd];
        bf16_t* qp = qk + (t0 + es) * 1024 + h * 128 + dseg * 16;
        const u32x4 q0 = *(const u32x4*)qp, q1 = *(const u32x4*)(qp + 8), k0 = *(const u32x4*)(qp + 512), k1 = *(const u32x4*)(qp + 520);
        float run = 0.f;
#pragma unroll
        for (int i = 0; i < 16; ++i) { run += gpre[i]; gpre[i] = run; }
        SEG[seg * 128 + cd] = run;
        __syncthreads();
        {
            const float s0 = SEG[cd], s1 = SEG[128 + cd], s2 = SEG[256 + cd];
            const float off = (seg > 0 ? s0 : 0.f) + (seg > 1 ? s1 : 0.f) + (seg > 2 ? s2 : 0.f);
#pragma unroll
            for (int i = 0; i < 16; ++i) BC[(seg * 16 + i) * 128 + cd] = gpre[i] + off;
            if (seg == 3) BL[cd] = run + off;
        }
        __syncthreads();
        {
            float bc_[16], bl[16];
#pragma unroll
            for (int e4 = 0; e4 < 4; ++e4) {
                const f32x4 t1 = *(const f32x4*)(BC + es * 128 + dseg * 16 + e4 * 4); const f32x4 t2 = *(const f32x4*)(BL + dseg * 16 + e4 * 4);
                bc_[e4 * 4 + 0] = t1[0]; bc_[e4 * 4 + 1] = t1[1]; bc_[e4 * 4 + 2] = t1[2]; bc_[e4 * 4 + 3] = t1[3];
                bl[e4 * 4 + 0] = t2[0]; bl[e4 * 4 + 1] = t2[1]; bl[e4 * 4 + 2] = t2[2]; bl[e4 * 4 + 3] = t2[3];
            }
            const unsigned qw[8] = { q0.x, q0.y, q0.z, q0.w, q1.x, q1.y, q1.z, q1.w };
            const unsigned kw[8] = { k0.x, k0.y, k0.z, k0.w, k1.x, k1.y, k1.z, k1.w };
            unsigned qo[8], ko[8];
#pragma unroll
            for (int e2 = 0; e2 < 8; ++e2) {
                const float e1a = fexp(bc_[2 * e2]), e1b = fexp(bc_[2 * e2 + 1]);
                const float ia = frcp(e1a), ib = frcp(e1b);
                const float e3a = fexp(bl[2 * e2] - bc_[2 * e2]), e3b = fexp(bl[2 * e2 + 1] - bc_[2 * e2 + 1]);
                const float qa = bflo(qw[e2]), qb = bfhi(qw[e2]), ka = bflo(kw[e2]), kb = bfhi(kw[e2]);
                qo[e2] = pk2(qa * e1a, qb * e1b);
                ko[e2] = pk2(ka * ia, kb * ib);
                const unsigned ke = pk2(ka * e3a, kb * e3b);
                KET[(dseg * 16 + 2 * e2) * 72 + es] = (bf16_t)(ke & 0xffffu);
                KET[(dseg * 16 + 2 * e2 + 1) * 72 + es] = (bf16_t)(ke >> 16);
            }
            u32x4 t; t.x = qo[0]; t.y = qo[1]; t.z = qo[2]; t.w = qo[3]; *(u32x4*)(QD + es * 136 + dseg * 16) = t; if (!dry) *(u32x4*)qp = t;
            t.x = qo[4]; t.y = qo[5]; t.z = qo[6]; t.w = qo[7]; *(u32x4*)(QD + es * 136 + dseg * 16 + 8) = t; if (!dry) *(u32x4*)(qp + 8) = t;
            t.x = ko[0]; t.y = ko[1]; t.z = ko[2]; t.w = ko[3]; *(u32x4*)(KI + es * 136 + dseg * 16) = t;
            t.x = ko[4]; t.y = ko[5]; t.z = ko[6]; t.w = ko[7]; *(u32x4*)(KI + es * 136 + dseg * 16 + 8) = t;
        }
        __syncthreads();
#pragma unroll
        for (int n = 0; n < 2; ++n) {
            const int sb = (w & 1) * 2 + n;
            f32x4 a = (f32x4){0.f, 0.f, 0.f, 0.f};
            if (sb <= cb) {
#pragma unroll
                for (int ks = 0; ks < 4; ++ks) {
                    const bf16x8 af = *(const bf16x8*)(QD + (cb * 16 + fr) * 136 + ks * 32 + fq * 8);
                    const bf16x8 bfr = *(const bf16x8*)(KI + (sb * 16 + fr) * 136 + ks * 32 + fq * 8);
                    a = MFMA16(af, bfr, a);
                }
            }
#pragma unroll
            for (int jj = 0; jj < 4; ++jj) {
                const int cc = cb * 16 + fq * 4 + jj, ss = sb * 16 + fr;
                ATT[cc * 72 + ss] = bf1(ss <= cc ? a[jj] : 0.f);
            }
        }
        __syncthreads();
        unsigned char* gbase = Gb + ((t0 * 512) + (size_t)h * 128) * 4;
#pragma unroll
        for (int i = 0; i < 2; ++i) {
            const int idx = tid + i * 512, d = idx >> 3, pc = idx & 7;
            const u32x4 v = *(const u32x4*)(KET + d * 72 + pc * 8);
            if (!dry) *(u32x4*)(gbase + (size_t)(d >> 2) * 2048 + (d & 3) * 128 + pc * 16) = v;
        }
        {
            const int c = tid >> 3, pc = tid & 7;
            const u32x4 v = *(const u32x4*)(ATT + c * 72 + pc * 8);
            if (!dry) *(u32x4*)(gbase + (size_t)(32 + (c >> 2)) * 2048 + (c & 3) * 128 + pc * 16) = v;
        }
        if (tid < 128 && !dry) *(float*)(gbase + (size_t)48 * 2048 + tid * 4) = fexp(BL[tid]);
        __syncthreads();
    }
}

__device__ __forceinline__ void gla_phase(const Params& p, unsigned char* smem, bool dry = false) {
    const unsigned char* qkb = p.ws + WS_QK;
    const unsigned char* Gb = p.ws + WS_G;
    bf16_t* mix = (bf16_t*)(p.ws + WS_MIX);
    float* part = (float*)(p.ws + WS_PART);
    bf16_t* ST = (bf16_t*)smem;
    bf16_t* VT = ST + 64 * 136;
    constexpr int OPB = 26624, OPSZ = 41984, O_KET = 0, O_QD = 16384, O_ATT = 32768, O_DEC = 40960;
    LAS unsigned char* lds = (LAS unsigned char*)smem;
    int tid_ = threadIdx.x; asm volatile("" : "+v"(tid_));
    const int tid = tid_, w = __builtin_amdgcn_readfirstlane(tid >> 6), lane = tid & 63, fr = lane & 15, fq = lane >> 4;
    const int es = tid >> 3, dseg = tid & 7;
    const int cb = w >> 1, wh = w & 1;
    const int crow = cb * 16 + fr;
    unsigned koff[2], qoff[2], aoff, doff;
#pragma unroll
    for (int i = 0; i < 2; ++i) {
        const int P = (2 * w + i) * 64 + lane;
        { const int r = P >> 3, s_ = P & 7, q = s_ ^ (r & 7); koff[i] = (unsigned)((r >> 2) * 2048 + (r & 3) * 128 + q * 16); }
        { const int r = P >> 4, s_ = P & 15, q = s_ ^ (r & 15); qoff[i] = (unsigned)(r * 2048 + q * 16); }
    }
    { const int P = w * 64 + lane, r = P >> 3, s_ = P & 7, q = s_ ^ (r & 7); aoff = (unsigned)((32 + (r >> 2)) * 2048 + (r & 3) * 128 + q * 16); }
    doff = (unsigned)(48 * 2048 + (lane & 31) * 16);
    int r_att[2], r_qd[4], r_ket[4][2], r_dec[4];
#pragma unroll
    for (int ks = 0; ks < 2; ++ks) r_att[ks] = O_ATT + (crow * 8 + ((ks * 4 + fq) ^ (crow & 7))) * 16;
#pragma unroll
    for (int ks = 0; ks < 4; ++ks) r_qd[ks] = O_QD + (crow * 16 + ((ks * 4 + fq) ^ (crow & 15))) * 16;
#pragma unroll
    for (int n = 0; n < 4; ++n) { const int d = (wh * 4 + n) * 16 + fr; r_dec[n] = O_DEC + d * 4;
#pragma unroll
        for (int ks = 0; ks < 2; ++ks) r_ket[n][ks] = O_KET + (d * 8 + ((ks * 4 + fq) ^ (d & 7))) * 16; }
    for (int unit = blockIdx.x; unit < 256; unit += gridDim.x) {
        const int ux = unit & 7, uy = unit >> 3;
        const int bh = ux * 4 + (uy >> 3), sl = uy & 7, h = bh & 3, b = bh >> 2;
        const size_t tb = (size_t)b * SEQ_L;
        f32x4 st[4];
#pragma unroll
        for (int n = 0; n < 4; ++n) st[n] = (f32x4){0.f, 0.f, 0.f, 0.f};
        u32x4 vpre;
#define GLA_DMA(t1, bufoff) do { const unsigned char* gb_ = Gb + (((t1) * 512) + (size_t)h * 128) * 4; const unsigned char* qb_ = qkb + (((t1) * 1024) + (size_t)h * 128) * 2; \
            _Pragma("unroll") for (int i = 0; i < 2; ++i) { \
                __builtin_amdgcn_global_load_lds((const unsigned*)(gb_ + koff[i]), (LAS unsigned*)(lds + (bufoff) + O_KET + (2 * w + i) * 1024), 16, 0, 0); \
                __builtin_amdgcn_global_load_lds((const unsigned*)(qb_ + qoff[i]), (LAS unsigned*)(lds + (bufoff) + O_QD + (2 * w + i) * 1024), 16, 0, 0); } \
            __builtin_amdgcn_global_load_lds((const unsigned*)(gb_ + aoff), (LAS unsigned*)(lds + (bufoff) + O_ATT + w * 1024), 16, 0, 0); \
            if (w == 7) __builtin_amdgcn_global_load_lds((const unsigned*)(gb_ + doff), (LAS unsigned*)(lds + (bufoff) + O_DEC), 16, 0, 0); } while (0)
#define GLA_LOAD_V(t1) vpre = *(const u32x4*)(mix + ((t1) + es) * 3072 + h * 512 + sl * 64 + dseg * 8)
        __syncthreads();
        GLA_DMA(tb, OPB); GLA_LOAD_V(tb);
        u32x2 po[2]; po[0] = (u32x2){0u, 0u}; po[1] = (u32x2){0u, 0u}; float pssq = 0.f;
        for (int c = 0; c < 128; ++c) {
            const size_t t0 = tb + (size_t)c * 64;
            const size_t tn = tb + (size_t)(c < 127 ? c + 1 : 127) * 64;
            const size_t tp = tb + (size_t)(c > 0 ? c - 1 : 0) * 64;
            const int bcur = OPB + (c & 1) * OPSZ, bnxt = OPB + ((c & 1) ^ 1) * OPSZ;
            const unsigned char* OB = smem + bcur;
            {
                const unsigned vw[4] = { vpre.x, vpre.y, vpre.z, vpre.w };
#pragma unroll
                for (int e2 = 0; e2 < 4; ++e2) {
                    VT[(dseg * 8 + 2 * e2) * 72 + es] = (bf16_t)(vw[e2] & 0xffffu);
                    VT[(dseg * 8 + 2 * e2 + 1) * 72 + es] = (bf16_t)(vw[e2] >> 16);
                }
#pragma unroll
                for (int n = 0; n < 4; ++n) {
                    const int db = wh * 4 + n;
#pragma unroll
                    for (int jj = 0; jj < 4; ++jj) ST[(cb * 16 + fq * 4 + jj) * 136 + db * 16 + fr] = bf1(st[n][jj]);
                }
            }
            asm volatile("s_waitcnt vmcnt(0) lgkmcnt(0)" ::: "memory"); __builtin_amdgcn_s_barrier(); asm volatile("" ::: "memory");
            if (!(dry && (PROBE_ABL & 1))) { GLA_DMA(tn, bnxt); GLA_LOAD_V(tn); }
            {
                bf16_t* op = mix + (tp + crow) * 3072 + h * 512 + sl * 64 + wh * 32 + fq * 4;
                if (!dry) { st_global_b64(op, po[0]); st_global_b64(op + 16, po[1]);
                st_global_b32(part + ((tp + crow) * 4 + h) * 16 + sl * 2 + wh, pssq); }
            }
            {
                bf16x8 A_vt[2];
#pragma unroll
                for (int ks = 0; ks < 2; ++ks) A_vt[ks] = *(const bf16x8*)(VT + (cb * 16 + fr) * 72 + ks * 32 + fq * 8);
#pragma unroll
                for (int n = 0; n < 4; ++n) {
                    const float dcn = *(const float*)(OB + r_dec[n]);
                    st[n][0] *= dcn; st[n][1] *= dcn; st[n][2] *= dcn; st[n][3] *= dcn;
#pragma unroll
                    for (int ks = 0; ks < 2; ++ks) st[n] = MFMA16(A_vt[ks], *(const bf16x8*)(OB + r_ket[n][ks]), st[n]);
                }
            }
            {
                bf16x8 A_att[2], A_qd[4];
#pragma unroll
                for (int ks = 0; ks < 2; ++ks) A_att[ks] = *(const bf16x8*)(OB + r_att[ks]);
#pragma unroll
                for (int ks = 0; ks < 4; ++ks) A_qd[ks] = *(const bf16x8*)(OB + r_qd[ks]);
                float ssq = 0.f;
#pragma unroll
                for (int n = 0; n < 2; ++n) {
                    const int eb = wh * 2 + n;
                    f32x4 a = (f32x4){0.f, 0.f, 0.f, 0.f};
#pragma unroll
                    for (int ks = 0; ks < 2; ++ks) { const bf16x8 bfr = *(const bf16x8*)(VT + (eb * 16 + fr) * 72 + ks * 32 + fq * 8); a = MFMA16(bfr, A_att[ks], a); }
#pragma unroll
                    for (int ks = 0; ks < 4; ++ks) { const bf16x8 bfr = *(const bf16x8*)(ST + (eb * 16 + fr) * 136 + ks * 32 + fq * 8); a = MFMA16(bfr, A_qd[ks], a); }
                    po[n].x = pk2(a[0], a[1]); po[n].y = pk2(a[2], a[3]);
                    ssq += (a[0] * a[0] + a[1] * a[1]) + (a[2] * a[2] + a[3] * a[3]);
                }
                ssq += __shfl_xor(ssq, 16); ssq += __shfl_xor(ssq, 32); pssq = ssq;
            }
            LDS_BAR();
        }
        {
            const size_t t0 = tb + (size_t)127 * 64;
            bf16_t* op = mix + (t0 + crow) * 3072 + h * 512 + sl * 64 + wh * 32 + fq * 4;
            if (!dry) { st_global_b64(op, po[0]); st_global_b64(op + 16, po[1]);
            st_global_b32(part + ((t0 + crow) * 4 + h) * 16 + sl * 2 + wh, pssq); }
        }
        asm volatile("s_waitcnt vmcnt(0)" ::: "memory");
#undef GLA_DMA
#undef GLA_LOAD_V
        __syncthreads();
    }
}

#define S5_BAR() LDS_BAR()
__device__ __forceinline__ void s5_phase(const Params& p, int j, unsigned char* smem) {
    const bf16_t* mix = (const bf16_t*)(p.ws + WS_MIX);
    bf16_t* y5 = (bf16_t*)(p.ws + WS_QK);
    int tid_ = threadIdx.x; asm volatile("" : "+v"(tid_));
    const int tid = tid_, w = __builtin_amdgcn_readfirstlane(tid >> 6), lane = tid & 63, fr = lane & 15, fq = lane >> 4;
    const int wp = w & 3;
    float* BUF = (float*)(smem + wp * 25600);
    bf16_t* XB = (bf16_t*)(smem + wp * 25600 + 8448);
    for (int ub = blockIdx.x; ub < 256; ub += gridDim.x) {
        const int b = ub & 7, g = (ub >> 3) * 4 + wp;
        const int jg = j * 128 + g;
        const float lr = p.in[9][jg * 64 + lane], li = p.in[10][jg * 64 + lane];
        const float dt = __expf(p.in[11][jg]);
        const float mag = __expf(lr * dt);
        float rev = li * dt * 0.15915494309189535f; rev -= floorf(rev);
        const float ar = mag * __builtin_amdgcn_cosf(rev), ai = mag * __builtin_amdgcn_sinf(rev);
        const size_t tb0 = (size_t)b * SEQ_L;
        if (w < 4) {
            float xr = 0.f, xi = 0.f; const float nai = -ai;
            S5_BAR();
            for (int step2 = 0; step2 < 512; step2 += 2) {
#pragma unroll
                for (int k = 0; k < 2; ++k) {
                    const float* BUFc = BUF + k * 3200; bf16_t* XBc = XB + k * 6400;
                    f32x2 bu[16];
#pragma unroll
                    for (int t = 0; t < 16; ++t) bu[t] = *(const f32x2*)(BUFc + t * 132 + 2 * lane);
#pragma unroll
                    for (int t = 0; t < 16; ++t) {
                        const float t1 = fma_s(nai, xi, bu[t][0]);
                        const float t2 = fma_s(ai, xr, bu[t][1]);
                        const float nxr = fma_s(ar, xr, t1);
                        const float nxi = fma_s(ar, xi, t2);
                        xr = nxr; xi = nxi;
                        *(unsigned*)(XBc + t * 136 + 2 * lane) = pk2(xr, xi);
                    }
                    S5_BAR();
                }
            }
        } else {
            const float nr = ar - 1.f, ni = ai, den = lr * lr + li * li;
            const float cre = (nr * lr + ni * li) / den, cim = (ni * lr - nr * li) / den;
            bf16x8 bbf[8];
#pragma unroll
            for (int nb = 0; nb < 8; ++nb) {
                const int pp = nb * 8 + (fr >> 1);
                const float c_re = __shfl(cre, pp), c_im = __shfl(cim, pp);
                const int fqc = fq & 1;
                const float* br = p.in[12] + ((size_t)jg * 64 + pp) * 16 + fqc * 8;
                const float* bi = p.in[13] + ((size_t)jg * 64 + pp) * 16 + fqc * 8;
                const f32x4 br0 = *(const f32x4*)br, br1 = *(const f32x4*)(br + 4), bi0 = *(const f32x4*)bi, bi1 = *(const f32x4*)(bi + 4);
                float v[8];
#pragma unroll
                for (int e = 0; e < 4; ++e) {
                    v[e] = (fr & 1) ? (c_re * bi0[e] + c_im * br0[e]) : (c_re * br0[e] - c_im * bi0[e]);
                    v[4 + e] = (fr & 1) ? (c_re * bi1[e] + c_im * br1[e]) : (c_re * br1[e] - c_im * bi1[e]);
                }
                u32x4 t; t.x = pk2(v[0], v[1]); t.y = pk2(v[2], v[3]); t.z = pk2(v[4], v[5]); t.w = pk2(v[6], v[7]);
                if (fq >= 2) { t.x = 0u; t.y = 0u; t.z = 0u; t.w = 0u; }
                bbf[nb] = __builtin_bit_cast(bf16x8, t);
            }
            bf16x8 cf[4];
#pragma unroll
            for (int ks = 0; ks < 4; ++ks) {
                const int pb = ks * 16 + fq * 4;
                const f32x4 cr = *(const f32x4*)(p.in[14] + ((size_t)jg * 16 + fr) * 64 + pb);
                const f32x4 ci = *(const f32x4*)(p.in[15] + ((size_t)jg * 16 + fr) * 64 + pb);
                u32x4 t; t.x = pk2(cr[0], -ci[0]); t.y = pk2(cr[1], -ci[1]); t.z = pk2(cr[2], -ci[2]); t.w = pk2(cr[3], -ci[3]);
                cf[ks] = __builtin_bit_cast(bf16x8, t);
            }
            const f32x4 dv = *(const f32x4*)(p.in[16] + j * 2048 + g * 16 + fq * 4);
            const bf16_t* ubase = mix + (tb0 + fr) * 3072 + g * 16;
            bf16_t* ybase = y5 + (tb0 + fr) * 2048 + g * 16 + fq * 4;
            const bool pad = (fq >= 2);
            u32x4 ufq[4]; u32x2 uoq[4];
            {
                u32x4 uf0 = *(const u32x4*)(ubase + (fq & 1) * 8);
                if (pad) { uf0.x = 0u; uf0.y = 0u; uf0.z = 0u; uf0.w = 0u; }
                const bf16x8 uf = __builtin_bit_cast(bf16x8, uf0);
#pragma unroll
                for (int nb = 0; nb < 8; ++nb) { const f32x4 a = MFMA16(bbf[nb], uf, ((f32x4){0.f, 0.f, 0.f, 0.f})); *(f32x4*)(BUF + fr * 132 + nb * 16 + fq * 4) = a; }
#pragma unroll
                for (int q = 1; q <= 4; ++q) ufq[q & 3] = *(const u32x4*)(ubase + (size_t)q * 16 * 3072 + (fq & 1) * 8);
#pragma unroll
                for (int q = 0; q < 3; ++q) uoq[q] = *(const u32x2*)(ubase + (size_t)q * 16 * 3072 + fq * 4);
                uoq[3] = uoq[0];
                S5_BAR();
            }
            for (int step4 = 0; step4 < 512; step4 += 4) {
#pragma unroll
                for (int k = 0; k < 4; ++k) {
                    const int step = step4 + k;
                    const int cur = k & 1, nxt = cur ^ 1;
                    float* BUFn = BUF + nxt * 3200; const bf16_t* XBn = XB + nxt * 6400;
                    u32x4 ufc = ufq[(k + 1) & 3]; if (pad) { ufc.x = 0u; ufc.y = 0u; ufc.z = 0u; ufc.w = 0u; }
                    { const int s5 = (step + 5 < 512) ? step + 5 : 511; ufq[(k + 1) & 3] = *(const u32x4*)(ubase + (size_t)s5 * 16 * 3072 + (fq & 1) * 8); }
                    const bf16x8 uf = __builtin_bit_cast(bf16x8, ufc);
                    f32x4 ya = (f32x4){0.f, 0.f, 0.f, 0.f};
#pragma unroll
                    for (int ks = 0; ks < 4; ++ks) { const bf16x8 xf = *(const bf16x8*)(XBn + fr * 136 + ks * 32 + fq * 8); ya = MFMA16(cf[ks], xf, ya); }
#pragma unroll
                    for (int nb = 0; nb < 8; ++nb) { const f32x4 a = MFMA16(bbf[nb], uf, ((f32x4){0.f, 0.f, 0.f, 0.f})); *(f32x4*)(BUFn + fr * 132 + nb * 16 + fq * 4) = a; }
                    const u32x2 uo = uoq[(k + 3) & 3];
                    { const int s3 = (step + 3 < 512) ? step + 3 : 511; uoq[(k + 3) & 3] = *(const u32x2*)(ubase + (size_t)s3 * 16 * 3072 + fq * 4); }
                    if (step > 0) {
                        const float u0 = bflo(uo.x), u1 = bfhi(uo.x), u2 = bflo(uo.y), u3 = bfhi(uo.y);
                        float yv[4] = { ya[0] + dv[0] * u0, ya[1] + dv[1] * u1, ya[2] + dv[2] * u2, ya[3] + dv[3] * u3 };
#pragma unroll
                        for (int e = 0; e < 4; ++e) { const float v = yv[e]; const float z = 0.7978845608028654f * (v + 0.044715f * v * v * v); yv[e] = v * fsigmoid(2.f * z); }
                        u32x2 o; o.x = pk2(yv[0], yv[1]); o.y = pk2(yv[2], yv[3]);
                        st_global_b64(ybase + (size_t)(step - 1) * 16 * 2048, o);
                    }
                    S5_BAR();
                }
            }
            {
                const u32x2 uo = uoq[3];
                const bf16_t* XBn = XB + 6400;
                f32x4 ya = (f32x4){0.f, 0.f, 0.f, 0.f};
#pragma unroll
                for (int ks = 0; ks < 4; ++ks) { const bf16x8 xf = *(const bf16x8*)(XBn + fr * 136 + ks * 32 + fq * 8); ya = MFMA16(cf[ks], xf, ya); }
                const float u0 = bflo(uo.x), u1 = bfhi(uo.x), u2 = bflo(uo.y), u3 = bfhi(uo.y);
                float yv[4] = { ya[0] + dv[0] * u0, ya[1] + dv[1] * u1, ya[2] + dv[2] * u2, ya[3] + dv[3] * u3 };
#pragma unroll
                for (int e = 0; e < 4; ++e) { const float v = yv[e]; const float z = 0.7978845608028654f * (v + 0.044715f * v * v * v); yv[e] = v * fsigmoid(2.f * z); }
                u32x2 o; o.x = pk2(yv[0], yv[1]); o.y = pk2(yv[2], yv[3]);
                st_global_b64(ybase + (size_t)511 * 16 * 2048, o);
            }
        }
        __syncthreads();
    }
    __syncthreads();
}

enum { K_PREP = 0, K_KV, K_NORM, K_A1, K_MIX, K_GLU, K_A2, K_A3, K_FINAL, K_MIXB };
constexpr int N_PHASES = 25;
__device__ __forceinline__ void decode_phase(int ph, int& kind, int& layer) {
    if (ph == 0) { kind = K_PREP; layer = 0; return; }
    if (ph >= 24) { kind = K_FINAL; layer = 0; return; }
    int q;
    if (ph < 6) { layer = 0; q = ph; } else { const int q0 = ph - 6; layer = 1 + q0 / 6; q = q0 - (layer - 1) * 6; }
    if (layer & 1) kind = (q == 0) ? K_NORM : (q == 1) ? K_A1 : (q == 2) ? K_MIX : (q == 3) ? K_GLU : (q == 4) ? K_A2 : K_A3;
    else kind = (q == 0) ? K_NORM : (q == 1) ? K_A1 : (q == 2) ? K_MIX : (q == 3) ? K_MIXB : (q == 4) ? K_A2 : K_A3;
}

__device__ __forceinline__ void run_phase(const Params& p, int ph, unsigned char* smem) {
    int kind, layer; decode_phase(ph, kind, layer);
    const int j = layer >> 1; const bool is_gla = !(layer & 1);
    bf16_t* WT = (bf16_t*)(p.ws + WS_WT);
    bf16_t* H = (bf16_t*)(p.ws + WS_H);
    bf16_t* MIX = (bf16_t*)(p.ws + WS_MIX);
#ifndef NO_PREP
    if (kind == K_PREP) { prep_phase(p, smem); norm_phase(p, 0); return; }
#endif
    if (kind == K_NORM) { norm_phase(p, layer); return; }
    if (kind == K_FINAL) { rms_rows(p.out, p.in[21], nullptr, p.out, T_TOK, true); return; }
    if (kind == K_MIX) {
        if (is_gla) { if (PROBE_DUP & 2) { gla_pre_phase(p, smem, true); __syncthreads(); } gla_pre_phase(p, smem); } else s5_phase(p, j, smem);
        __syncthreads();
        attn_phase(p, layer, smem);
        return;
    }
    if (kind == K_MIXB) { if (PROBE_DUP & 1) { gla_phase(p, smem, true); __syncthreads(); } gla_phase(p, smem); return; }
    const bool withkv = (kind == K_A1 && layer == 0);
    const int ngemm = withkv ? 3 : 1;
    for (int q = 0; q < ngemm; ++q) {
        pg8::Gemm g; pg8::Epi E;
        E.mode = pg8::EM_BF16; E.o0 = nullptr; E.ld0 = 0; E.qk = nullptr; E.g = nullptr; E.gbias = nullptr; E.mix = MIX; E.part = nullptr; E.onw = nullptr; E.is_gla = 0;
        E.y5 = nullptr; E.bglu = nullptr; E.xin = nullptr; E.xout = nullptr;
        int ord_c = (int)blockIdx.x;
        if (withkv && q < 2) {
            if (q == 1) ord_c = (int)((blockIdx.x + gridDim.x / 2) % gridDim.x);
            if (q == 0) { g.A = (const bf16_t*)(p.ws + WS_MEMN); g.Bt = WT + WT_K_BASE; g.M = 2048; g.N = 4096; g.K = 1024; E.o0 = (bf16_t*)(p.ws + WS_KMEM); E.ld0 = 4096; }
            else { g.A = WT + WT_V_BASE; g.Bt = (const bf16_t*)(p.ws + WS_MEMN); g.M = 4096; g.N = 2048; g.K = 1024; E.o0 = (bf16_t*)(p.ws + WS_VT); E.ld0 = 2048; }
        } else if (kind == K_A1) {
            g.A = H; g.M = T_TOK; g.K = 1024;
            if (is_gla) { g.Bt = WT + j * WT_GLA_PER; g.N = 4608; E.mode = pg8::EM_A1GLA; E.qk = (bf16_t*)(p.ws + WS_QK); E.g = (float*)(p.ws + WS_G); E.gbias = p.in[6] + j * 512; }
            else { g.Bt = WT + WT_S5_BASE + j * WT_S5_PER; g.N = 3072; E.o0 = MIX; E.ld0 = 3072; }
        } else if (kind == K_A2) {
            g.A = H; g.M = T_TOK; g.K = 1024; g.N = 3072;
            g.Bt = is_gla ? (WT + j * WT_GLA_PER + WT_GLA_A2) : (WT + WT_S5_BASE + j * WT_S5_PER + WT_S5_A2);
            E.mode = pg8::EM_GATE; E.part = (const float*)(p.ws + WS_PART); E.onw = p.in[7] + j * 512; E.is_gla = is_gla ? 1 : 0;
        } else if (kind == K_GLU) {
            g.A = (const bf16_t*)(p.ws + WS_QK); g.M = T_TOK; g.K = 2048; g.N = 2048; g.Bt = WT + WT_S5_BASE + j * WT_S5_PER + WT_S5_GLU;
            E.mode = pg8::EM_GLU; E.y5 = (const bf16_t*)(p.ws + WS_QK); E.bglu = p.in[18] + j * 2048;
        } else {
            g.A = MIX; g.M = T_TOK; g.K = 3072; g.N = 1024; g.Bt = WT + WT_OUT_BASE + layer * WT_OUT_PER;
            E.mode = pg8::EM_RESID; E.xin = (layer == 0) ? p.in[0] : p.out; E.xout = p.out;
        }
        pg8::StaticOrder S; S.init(g.M, g.N, (int)gridDim.x, ord_c);
#ifndef NO_GEMM
        pg8::gemm_phase((LAS unsigned char*)smem, g, S, E);
#endif
        __syncthreads();
    }
}

__device__ __forceinline__ void grid_barrier(unsigned* ctr, unsigned target) {
    asm volatile("s_waitcnt vmcnt(0)" ::: "memory");
    __syncthreads();
    if (threadIdx.x == 0) {
        __threadfence();
        atomicAdd(ctr, 1u);
        while (__hip_atomic_load(ctr, __ATOMIC_RELAXED, __HIP_MEMORY_SCOPE_AGENT) < target) __builtin_amdgcn_s_sleep(2);
        __threadfence();
    }
    __syncthreads();
}

__global__ void __launch_bounds__(NTHREADS, 2) mega(Params p) {
    extern __shared__ __attribute__((aligned(16))) unsigned char smem[];
    cg::grid_group grid = cg::this_grid();
    unsigned* ctr = (unsigned*)(p.ws + WS_CTL);
    unsigned nbar = 0, ngrp = 0;
    for (int ph = p.ph_lo; ph < p.ph_hi; ++ph) {
        run_phase(p, ph, smem);
        if (ph + 1 < p.ph_hi) {
            if (ph == p.ph_lo) { asm volatile("s_waitcnt vmcnt(0)" ::: "memory"); __syncthreads(); grid.sync(); }
            else if (ph == 1 || (gridDim.x & 7) != 0) { ++nbar; grid_barrier(ctr, nbar * gridDim.x); }
            else { ++ngrp; grid_barrier(ctr + 16 * (1 + (blockIdx.x & 7)), ngrp * (gridDim.x >> 3)); }
        }
    }
}

extern "C" void kernel_launch(void* const* d_in, const int* in_sizes, int n_in, void* d_out, int out_size, void* d_ws, size_t ws_size, hipStream_t stream) {
    static int grid = 0;
    if (grid == 0) {
        if (n_in != 22 || out_size != T_TOK * DM || ws_size < WS_END) {
            fprintf(stderr, "kernel_launch: unexpected shapes: n_in %d out %d ws %zu (need %zu)\n", n_in, out_size, ws_size, (size_t)WS_END); grid = -1; return; }
        int dev = 0, cus = 0, per_cu = 0;
        if (hipGetDevice(&dev) != hipSuccess || hipDeviceGetAttribute(&cus, hipDeviceAttributeMultiprocessorCount, dev) != hipSuccess) { grid = -1; return; }
        if (hipFuncSetAttribute((const void*)mega, hipFuncAttributeMaxDynamicSharedMemorySize, LDS_BYTES) != hipSuccess) { fprintf(stderr, "kernel_launch: hipFuncSetAttribute failed\n"); grid = -1; return; }
        if (hipOccupancyMaxActiveBlocksPerMultiprocessor(&per_cu, (const void*)mega, NTHREADS, LDS_BYTES) != hipSuccess || per_cu < 1) { fprintf(stderr, "kernel_launch: occupancy query says %d\n", per_cu); per_cu = 1; }
        (void)hipGetLastError();
        grid = cus * 1;
    }
    if (grid < 0) return;
    if (hipMemsetAsync((char*)d_ws + WS_CTL, 0, 1024, stream) != hipSuccess) { fprintf(stderr, "kernel_launch: memset failed\n"); return; }
    Params p{};
    for (int i = 0; i < 22; ++i) p.in[i] = (const float*)d_in[i];
    p.out = (float*)d_out; p.ws = (unsigned char*)d_ws;
#if MK_COOP
    p.ph_lo = 0; p.ph_hi = N_PHASES;
    void* args[] = { &p };
    hipError_t e = hipLaunchCooperativeKernel((const void*)mega, dim3(grid), dim3(NTHREADS), args, LDS_BYTES, stream);
    if (e != hipSuccess) fprintf(stderr, "cooperative launch failed: %s (grid %d)\n", hipGetErrorString(e), grid);
#else
    for (int ph = 0; ph < N_PHASES; ++ph) {
        p.ph_lo = ph; p.ph_hi = ph + 1;
        hipLaunchKernelGGL(mega, dim3(grid), dim3(NTHREADS), LDS_BYTES, stream, p);
    }
#endif
}
```

```cpp
#include <hip/hip_runtime.h>
#include <hip/hip_cooperative_groups.h>
#include <cstdio>
#include <cstdint>
namespace cg = cooperative_groups;

#ifndef MK_COOP
#define MK_COOP 1
#endif
#ifndef PROBE_DUP
#define PROBE_DUP 0
#endif
#ifndef PROBE_ABL
#define PROBE_ABL 0
#endif

#define LAS __attribute__((address_space(3)))
typedef unsigned short bf16_t;
typedef short bf16x8 __attribute__((ext_vector_type(8)));
typedef float f32x4 __attribute__((ext_vector_type(4)));
typedef float f32x2 __attribute__((ext_vector_type(2)));
typedef unsigned u32x4 __attribute__((ext_vector_type(4)));
typedef unsigned u32x2 __attribute__((ext_vector_type(2)));

constexpr int T_TOK = 65536;
constexpr int SEQ_L = 8192;
constexpr int DM = 1024;
constexpr int GLA_IN_W = 7184, S5_IN_W = 6144;
constexpr float EPSN = 1e-6f;
constexpr float L2E = 1.4426950408889634f;

constexpr size_t MiB = 1024ull * 1024ull;
constexpr size_t WS_H = 0;
constexpr size_t WS_QK = 128 * MiB;
constexpr size_t WS_G = 256 * MiB;
constexpr size_t WS_MIX = 384 * MiB;
constexpr size_t WS_KMEM = 768 * MiB;
constexpr size_t WS_VT = 784 * MiB;
constexpr size_t WS_MEMN = 800 * MiB;
constexpr size_t WS_SUMSQ = 804 * MiB;
constexpr size_t WS_CTL = 806 * MiB;
constexpr size_t WS_WT = 807 * MiB;
constexpr size_t WT_GLA_PER = (size_t)(4608 + 3072) * 1024;
constexpr size_t WT_GLA_A2 = (size_t)4608 * 1024;
constexpr size_t WT_S5_BASE = 2 * WT_GLA_PER;
constexpr size_t WT_S5_PER = (size_t)6144 * 1024 + (size_t)2048 * 2048;
constexpr size_t WT_S5_A2 = (size_t)3072 * 1024;
constexpr size_t WT_S5_GLU = (size_t)6144 * 1024;
constexpr size_t WT_OUT_BASE = WT_S5_BASE + 2 * WT_S5_PER;
constexpr size_t WT_OUT_PER = (size_t)1024 * 3072;
constexpr size_t WT_K_BASE = WT_OUT_BASE + 4 * WT_OUT_PER;
constexpr size_t WT_V_BASE = WT_K_BASE + (size_t)4096 * 1024;
constexpr size_t WT_TOTAL = WT_V_BASE + (size_t)4096 * 1024;
constexpr size_t WS_END = WS_WT + WT_TOTAL * 2;
constexpr size_t WS_PART = 920 * MiB;
static_assert(WS_END <= WS_PART && WS_PART + (size_t)T_TOK * 64 * 4 <= 1024 * MiB, "workspace map");

constexpr int LDS_BYTES = 144 * 1024;
constexpr int NTHREADS = 512;

struct Params {
    const float* in[22];
    float* out;
    unsigned char* ws;
    int ph_lo, ph_hi;
};

typedef __bf16 bf16x2_t __attribute__((ext_vector_type(2)));
__device__ __forceinline__ unsigned pk2(float lo, float hi) { f32x2 v = {lo, hi}; bf16x2_t b = __builtin_convertvector(v, bf16x2_t); return __builtin_bit_cast(unsigned, b); }
__device__ __forceinline__ bf16_t bf1(float v) { return (bf16_t)(pk2(v, 0.f) & 0xffffu); }
__device__ __forceinline__ float bflo(unsigned u) { return __uint_as_float(u << 16); }
__device__ __forceinline__ float bfhi(unsigned u) { return __uint_as_float(u & 0xffff0000u); }
__device__ __forceinline__ float wave_sum(float v) {
#pragma unroll
    for (int o = 1; o < 64; o <<= 1) v += __shfl_xor(v, o);
    return v;
}
__device__ __forceinline__ float fexp(float x) { return __builtin_amdgcn_exp2f(x * L2E); }
__device__ __forceinline__ float frcp(float x) { return __builtin_amdgcn_rcpf(x); }
__device__ __forceinline__ float fsigmoid(float x) { return frcp(1.f + fexp(-x)); }
__device__ __forceinline__ void wave_sync() { asm volatile("s_waitcnt lgkmcnt(0)" ::: "memory"); __builtin_amdgcn_wave_barrier(); }
#define LDS_BAR() do { asm volatile("s_waitcnt lgkmcnt(0)" ::: "memory"); __builtin_amdgcn_s_barrier(); asm volatile("" ::: "memory"); } while (0)
__device__ __forceinline__ void st_global_b64(void* ptr, u32x2 v) { asm volatile("global_store_dwordx2 %0, %1, off" :: "v"(ptr), "v"(v) : "memory"); }
__device__ __forceinline__ void st_global_b128(void* ptr, u32x4 v) { asm volatile("global_store_dwordx4 %0, %1, off\n\ts_nop 1" :: "v"(ptr), "v"(v) : "memory"); }
__device__ __forceinline__ void st_global_f128(void* ptr, f32x4 v) { asm volatile("global_store_dwordx4 %0, %1, off\n\ts_nop 1" :: "v"(ptr), "v"(v) : "memory"); }
__device__ __forceinline__ float fma_s(float a, float b, float c) { float d; asm("v_fma_f32 %0, %1, %2, %3" : "=v"(d) : "v"(a), "v"(b), "v"(c)); return d; }
__device__ __forceinline__ void st_global_b32(void* ptr, float v) { asm volatile("global_store_dword %0, %1, off" :: "v"(ptr), "v"(v) : "memory"); }
__device__ __forceinline__ void atomic_add_u64_noret(unsigned long long* ptr, unsigned long long v) { asm volatile("global_atomic_add_x2 %0, %1, off" :: "v"(ptr), "v"(v) : "memory"); }
#define MFMA16(a, b, c) __builtin_amdgcn_mfma_f32_16x16x32_bf16((a), (b), (c), 0, 0, 0)

namespace pg8 {
constexpr int BM = 256, BK = 64, HALF = 128, HTB = HALF * BK * 2, STAGE_BYTES = 8 * HTB, NXCD = 8, WGM = 8;
__device__ __forceinline__ int lds_byte(int r, int c) { const int st = (r >> 4) * 2 + (c >> 5), rr = r & 15, cc = c & 31, ob = rr * 64 + cc * 2; return st * 1024 + (ob ^ (((ob >> 9) & 1) << 5)); }
__device__ __forceinline__ void stage_rc(int b, int& R, int& C) { const int st = b / 1024, sb = b % 1024, swz = sb ^ (((sb >> 9) & 1) << 5); R = (st >> 1) * 16 + swz / 64; C = (st & 1) * 32 + (swz % 64) / 2; }
__device__ __forceinline__ int perm32(int rho) { const int n = rho >> 4, i = rho & 15; return 8 * (i >> 2) + 4 * n + (i & 3); }
struct Unit { int pm, pn; };
struct Gemm { const bf16_t* A; const bf16_t* Bt; int M, N, K; };
struct StaticOrder {
    int nM, nN, nwg, G, c;
    __device__ void init(int M, int N, int G_, int c_) { nM = M / BM; nN = N / BM; nwg = nM * nN; G = G_; c = c_; }
    __device__ bool next(int i, Unit& u) const {
        const long L = (long)i * G + c; if (L >= nwg) return false;
        int wgid = (int)L; { const int q = nwg / NXCD, r = nwg % NXCD, xcd = wgid % NXCD, off = wgid / NXCD; wgid = (xcd < r ? xcd * (q + 1) : r * (q + 1) + (xcd - r) * q) + off; }
        const int nig = WGM * nN, gid = wgid / nig, fm = gid * WGM, gsz = (nM - fm) < WGM ? (nM - fm) : WGM;
        u.pm = fm + ((wgid % nig) % gsz); u.pn = (wgid % nig) / gsz; return true;
    }
};

enum { EM_BF16 = 0, EM_A1GLA = 1, EM_GATE = 2, EM_GLU = 3, EM_RESID = 4 };
struct Epi {
    int mode;
    bf16_t* o0; int ld0;
    bf16_t* qk; float* g; const float* gbias; bf16_t* mix;
    const float* part; const float* onw; int is_gla;
    const bf16_t* y5; const float* bglu;
    const float* xin; float* xout;
    __device__ __forceinline__ void operator()(const f32x4 (&acc)[2][2][4][2], const Unit& u, int wr, int wc, int fr, int fq) const {
        const int row0 = u.pm * BM + wr * 64 + fr;
        const int cb = u.pn * BM + wc * 32 + 8 * fq;
#define EPI_ROW(it) ((size_t)(row0 + ((it) >> 3) * HALF + (((it) >> 1) & 3) * 16))
#define EPI_COL(it) (cb + ((it) & 1) * HALF)
#define EPI_V0(it) acc[(it) >> 3][(it) & 1][((it) >> 1) & 3][0]
#define EPI_V1(it) acc[(it) >> 3][(it) & 1][((it) >> 1) & 3][1]
        if (mode == EM_BF16) {
#pragma unroll
            for (int it = 0; it < 16; ++it) { const f32x4 v0 = EPI_V0(it), v1 = EPI_V1(it);
                u32x4 o; o.x = pk2(v0[0], v0[1]); o.y = pk2(v0[2], v0[3]); o.z = pk2(v1[0], v1[1]); o.w = pk2(v1[2], v1[3]);
                *(u32x4*)(o0 + EPI_ROW(it) * ld0 + EPI_COL(it)) = o; }
        } else if (mode == EM_A1GLA) {
            if (u.pn < 4) {
                const float sc = (u.pn < 2) ? 0.08838834764831845f : 1.f;
#pragma unroll
                for (int it = 0; it < 16; ++it) { const f32x4 v0 = EPI_V0(it), v1 = EPI_V1(it);
                    u32x4 o; o.x = pk2(v0[0] * sc, v0[1] * sc); o.y = pk2(v0[2] * sc, v0[3] * sc); o.z = pk2(v1[0] * sc, v1[1] * sc); o.w = pk2(v1[2] * sc, v1[3] * sc);
                    *(u32x4*)(qk + EPI_ROW(it) * 1024 + EPI_COL(it)) = o; }
            } else if (u.pn < 6) {
                f32x4 bia[2][2];
#pragma unroll
                for (int bj = 0; bj < 2; ++bj) { bia[bj][0] = *(const f32x4*)(gbias + cb + bj * HALF - 1024); bia[bj][1] = *(const f32x4*)(gbias + cb + bj * HALF - 1024 + 4); }
#pragma unroll
                for (int it = 0; it < 16; ++it) { const f32x4 v0 = EPI_V0(it), v1 = EPI_V1(it); const int gc = EPI_COL(it) - 1024;
                    f32x4 r0, r1;
#pragma unroll
                    for (int e = 0; e < 4; ++e) {
                        const float x0 = v0[e] + bia[it & 1][0][e], x1 = v1[e] + bia[it & 1][1][e];
                        r0[e] = (fminf(x0, 0.f) - __logf(1.f + fexp(-fabsf(x0)))) * 0.0625f;
                        r1[e] = (fminf(x1, 0.f) - __logf(1.f + fexp(-fabsf(x1)))) * 0.0625f;
                    }
                    *(f32x4*)(g + EPI_ROW(it) * 512 + gc) = r0; *(f32x4*)(g + EPI_ROW(it) * 512 + gc + 4) = r1; }
            } else {
#pragma unroll
                for (int it = 0; it < 16; ++it) { const f32x4 v0 = EPI_V0(it), v1 = EPI_V1(it);
                    u32x4 o; o.x = pk2(v0[0], v0[1]); o.y = pk2(v0[2], v0[3]); o.z = pk2(v1[0], v1[1]); o.w = pk2(v1[2], v1[3]);
                    *(u32x4*)(mix + EPI_ROW(it) * 3072 + (EPI_COL(it) - 1536)) = o; }
            }
        } else if (mode == EM_GATE) {
            const bool nrm = is_gla && (cb < 2048);
            float rs[8]; f32x4 wv[2][2];
#pragma unroll
            for (int i = 0; i < 8; ++i) rs[i] = 1.f;
#pragma unroll
            for (int bj = 0; bj < 2; ++bj) { wv[bj][0] = (f32x4){1.f, 1.f, 1.f, 1.f}; wv[bj][1] = (f32x4){1.f, 1.f, 1.f, 1.f}; }
            if (nrm) {
#pragma unroll
                for (int i = 0; i < 8; ++i) {
                    const f32x4* pp = (const f32x4*)(part + (EPI_ROW(2 * i) * 4 + (cb >> 9)) * 16);
                    const f32x4 p0 = pp[0], p1 = pp[1], p2 = pp[2], p3 = pp[3];
                    const float ssum = ((p0[0] + p0[1]) + (p0[2] + p0[3])) + ((p1[0] + p1[1]) + (p1[2] + p1[3])) + ((p2[0] + p2[1]) + (p2[2] + p2[3])) + ((p3[0] + p3[1]) + (p3[2] + p3[3]));
                    rs[i] = rsqrtf(ssum * (1.f / 512.f) + EPSN);
                }
#pragma unroll
                for (int bj = 0; bj < 2; ++bj) { wv[bj][0] = *(const f32x4*)(onw + ((cb + bj * HALF) & 511)); wv[bj][1] = *(const f32x4*)(onw + ((cb + bj * HALF) & 511) + 4); }
            }
#pragma unroll
            for (int hb = 0; hb < 4; ++hb) {
            u32x4 mva[4];
#pragma unroll
            for (int i = 0; i < 4; ++i) mva[i] = *(const u32x4*)(mix + EPI_ROW(hb * 4 + i) * 3072 + EPI_COL(hb * 4 + i));
#pragma unroll
            for (int i = 0; i < 4; ++i) { const int it = hb * 4 + i;
                const u32x4 mv = mva[i];
                const f32x4 v0 = EPI_V0(it), v1 = EPI_V1(it);
                const float f[8] = { bflo(mv.x), bfhi(mv.x), bflo(mv.y), bfhi(mv.y), bflo(mv.z), bfhi(mv.z), bflo(mv.w), bfhi(mv.w) };
                const float r = rs[it >> 1];
                float y[8];
#pragma unroll
                for (int e = 0; e < 4; ++e) { y[e] = f[e] * (r * wv[it & 1][0][e]) * v0[e] * fsigmoid(v0[e]); y[4 + e] = f[4 + e] * (r * wv[it & 1][1][e]) * v1[e] * fsigmoid(v1[e]); }
                u32x4 o; o.x = pk2(y[0], y[1]); o.y = pk2(y[2], y[3]); o.z = pk2(y[4], y[5]); o.w = pk2(y[6], y[7]);
                st_global_b128(mix + EPI_ROW(it) * 3072 + EPI_COL(it), o);
            }
            }
        } else if (mode == EM_GLU) {
            f32x4 bia[2][2];
#pragma unroll
            for (int bj = 0; bj < 2; ++bj) { bia[bj][0] = *(const f32x4*)(bglu + cb + bj * HALF); bia[bj][1] = *(const f32x4*)(bglu + cb + bj * HALF + 4); }
#pragma unroll
            for (int hb = 0; hb < 2; ++hb) {
            u32x4 mva[8];
#pragma unroll
            for (int i = 0; i < 8; ++i) mva[i] = *(const u32x4*)(y5 + EPI_ROW(hb * 8 + i) * 2048 + EPI_COL(hb * 8 + i));
#pragma unroll
            for (int i = 0; i < 8; ++i) { const int it = hb * 8 + i;
                const u32x4 mv = mva[i];
                const f32x4 v0 = EPI_V0(it), v1 = EPI_V1(it);
                const float f[8] = { bflo(mv.x), bfhi(mv.x), bflo(mv.y), bfhi(mv.y), bflo(mv.z), bfhi(mv.z), bflo(mv.w), bfhi(mv.w) };
                float y[8];
#pragma unroll
                for (int e = 0; e < 4; ++e) { y[e] = f[e] * fsigmoid(v0[e] + bia[it & 1][0][e]); y[4 + e] = f[4 + e] * fsigmoid(v1[e] + bia[it & 1][1][e]); }
                u32x4 o; o.x = pk2(y[0], y[1]); o.y = pk2(y[2], y[3]); o.z = pk2(y[4], y[5]); o.w = pk2(y[6], y[7]);
                st_global_b128(mix + EPI_ROW(it) * 3072 + EPI_COL(it), o);
            }
            }
        } else {
#pragma unroll
            for (int hb = 0; hb < 4; ++hb) {
                f32x4 xa[4][2];
#pragma unroll
                for (int i = 0; i < 4; ++i) { const int it = hb * 4 + i; xa[i][0] = *(const f32x4*)(xin + EPI_ROW(it) * 1024 + EPI_COL(it)); xa[i][1] = *(const f32x4*)(xin + EPI_ROW(it) * 1024 + EPI_COL(it) + 4); }
#pragma unroll
                for (int i = 0; i < 4; ++i) { const int it = hb * 4 + i;
                    st_global_f128(xout + EPI_ROW(it) * 1024 + EPI_COL(it), xa[i][0] + EPI_V0(it)); st_global_f128(xout + EPI_ROW(it) * 1024 + EPI_COL(it) + 4, xa[i][1] + EPI_V1(it)); }
            }
        }
#undef EPI_ROW
#undef EPI_COL
#undef EPI_V0
#undef EPI_V1
    }
};

__device__ __forceinline__ void gemm_phase(LAS unsigned char* lds, const Gemm g, const StaticOrder& S, const Epi& E) {
    int tid_ = threadIdx.x; asm volatile("" : "+v"(tid_));
    const int tid = tid_, wid = __builtin_amdgcn_readfirstlane(tid >> 6), lane = tid & 63, wr = wid >> 2, wc = wid & 3, fr = lane & 15, fq = lane >> 4;
    const int K = g.K, nt = K / BK;
    unsigned voffA[2], voffB[2];
#pragma unroll
    for (int i = 0; i < 2; ++i) { int R, C; stage_rc(tid * 16 + i * 8192, R, C); const int Rb = (R & ~31) + perm32(R & 31);
        voffA[i] = (unsigned)(R * K + C) * 2u; voffB[i] = (unsigned)(Rb * K + C) * 2u; }
    const size_t kstep = (size_t)(BK * 2);
    const size_t hstep = (size_t)HALF * K * 2;
    const size_t tstep = 2 * hstep;
    const unsigned ldsw = (unsigned)wid * 1024u;
    const int aoff = lds_byte(wr * 64 + fr, fq * 8), boff = lds_byte(wc * 32 + fr, fq * 8);
#define PG8_SA(b, h) (((b) * 2 + (h)) * HTB)
#define PG8_SB(b, h) ((4 + (b) * 2 + (h)) * HTB)
#define PG8_STAGE(bufoff, gbase, voff) do { _Pragma("unroll") for (int _i = 0; _i < 2; ++_i) \
        __builtin_amdgcn_global_load_lds((const unsigned*)((const char*)(gbase) + (voff)[_i]), (LAS unsigned*)(lds + (bufoff) + ldsw + _i * 8192), 16, 0, 0); } while (0)
#define PG8_LDA(dst, b, h) do { _Pragma("unroll") for (int m = 0; m < 4; ++m) _Pragma("unroll") for (int k = 0; k < 2; ++k) dst[m][k] = *(const LAS bf16x8*)(lds + PG8_SA(b, h) + aoff + m * 2048 + k * 1024); } while (0)
#define PG8_LDB(dst, b, h) do { _Pragma("unroll") for (int n = 0; n < 2; ++n) _Pragma("unroll") for (int k = 0; k < 2; ++k) dst[n][k] = *(const LAS bf16x8*)(lds + PG8_SB(b, h) + boff + n * 2048 + k * 1024); } while (0)
#define PG8_MMA(ai, bj, At, Bt) do { __builtin_amdgcn_s_setprio(1); _Pragma("unroll") for (int m = 0; m < 4; ++m) _Pragma("unroll") for (int n = 0; n < 2; ++n) _Pragma("unroll") for (int k = 0; k < 2; ++k) \
        acc[ai][bj][m][n] = __builtin_amdgcn_mfma_f32_16x16x32_bf16(Bt[n][k], At[m][k], acc[ai][bj][m][n], 0, 0, 0); __builtin_amdgcn_s_setprio(0); } while (0)
#define PG8_WAIT_V(n) asm volatile("s_waitcnt vmcnt(" #n ")" ::: "memory")
#define PG8_WAIT_L(n) asm volatile("s_waitcnt lgkmcnt(" #n ")" ::: "memory")
#define PG8_BAR __builtin_amdgcn_s_barrier()
#define PG8_SCHED __builtin_amdgcn_sched_barrier(0)
    Unit cur, nxt; int ui = 0;
    if (!S.next(0, cur)) return;
    f32x4 acc[2][2][4][2];
#pragma unroll
    for (int a = 0; a < 2; ++a)
#pragma unroll
        for (int b = 0; b < 2; ++b)
#pragma unroll
            for (int m = 0; m < 4; ++m)
#pragma unroll
                for (int n = 0; n < 2; ++n) acc[a][b][m][n] = (f32x4){0.f, 0.f, 0.f, 0.f};
    bf16x8 At[4][2], B0[2][2], B1[2][2];
    const char* cA = (const char*)g.A + (size_t)cur.pm * tstep; const char* cB = (const char*)g.Bt + (size_t)cur.pn * tstep;
    PG8_STAGE(PG8_SB(0, 0), cB, voffB); PG8_STAGE(PG8_SB(0, 1), cB + hstep, voffB); PG8_STAGE(PG8_SA(0, 0), cA, voffA); PG8_STAGE(PG8_SA(0, 1), cA + hstep, voffA);
    if (wr == 1) PG8_BAR;
    PG8_WAIT_V(2); PG8_BAR;
    PG8_STAGE(PG8_SB(1, 0), cB + kstep, voffB); PG8_STAGE(PG8_SA(1, 0), cA + kstep, voffA); PG8_STAGE(PG8_SB(1, 1), cB + hstep + kstep, voffB);
    PG8_WAIT_V(6); PG8_BAR;
    for (;;) {
        const bool has_next = S.next(ui + 1, nxt);
        const char* nA = has_next ? (const char*)g.A + (size_t)nxt.pm * tstep : cA; const char* nB = has_next ? (const char*)g.Bt + (size_t)nxt.pn * tstep : cB;
        for (int t = 0; t < nt; t += 2) {
            const bool last = (t == nt - 2);
            const char* a1 = cA + (size_t)(t + 1) * kstep;
            const char* a2 = last ? nA : cA + (size_t)(t + 2) * kstep; const char* b2 = last ? nB : cB + (size_t)(t + 2) * kstep;
            const char* a3 = a2 + kstep; const char* b3 = b2 + kstep;
            PG8_LDB(B0, 0, 0); PG8_LDB(B1, 0, 1); PG8_SCHED; PG8_LDA(At, 0, 0); PG8_STAGE(PG8_SA(1, 1), a1 + hstep, voffA);
            PG8_WAIT_V(8); PG8_WAIT_L(0); PG8_BAR; PG8_MMA(0, 0, At, B0); PG8_MMA(0, 1, At, B1); PG8_BAR; PG8_SCHED;
            PG8_LDA(At, 0, 1); PG8_STAGE(PG8_SB(0, 0), b2, voffB); PG8_STAGE(PG8_SB(0, 1), b2 + hstep, voffB); PG8_STAGE(PG8_SA(0, 0), a2, voffA);
            PG8_WAIT_V(8); PG8_WAIT_L(0); PG8_BAR; PG8_MMA(1, 0, At, B0); PG8_MMA(1, 1, At, B1); PG8_BAR; PG8_SCHED;
            PG8_LDB(B0, 1, 0); PG8_LDB(B1, 1, 1); PG8_SCHED; PG8_LDA(At, 1, 0); PG8_STAGE(PG8_SA(0, 1), a2 + hstep, voffA);
            PG8_WAIT_V(8); PG8_WAIT_L(0); PG8_BAR; PG8_MMA(0, 0, At, B0); PG8_MMA(0, 1, At, B1); PG8_BAR; PG8_SCHED;
            PG8_LDA(At, 1, 1); PG8_STAGE(PG8_SB(1, 0), b3, voffB); PG8_STAGE(PG8_SB(1, 1), b3 + hstep, voffB); PG8_STAGE(PG8_SA(1, 0), a3, voffA);
            PG8_WAIT_V(8); PG8_WAIT_L(0); PG8_BAR; PG8_MMA(1, 0, At, B0); PG8_MMA(1, 1, At, B1); PG8_BAR; PG8_SCHED;
        }
        if (wr == 0) PG8_BAR;
        E(acc, cur, wr, wc, fr, fq);
        if (!has_next) break;
#pragma unroll
        for (int a = 0; a < 2; ++a)
#pragma unroll
            for (int b = 0; b < 2; ++b)
#pragma unroll
                for (int m = 0; m < 4; ++m)
#pragma unroll
                    for (int n = 0; n < 2; ++n) acc[a][b][m][n] = (f32x4){0.f, 0.f, 0.f, 0.f};
        cur = nxt; cA = nA; cB = nB; ++ui;
        if (wr == 1) PG8_BAR;
    }
    PG8_WAIT_V(0);
    PG8_BAR;
#undef PG8_SA
#undef PG8_SB
#undef PG8_STAGE
#undef PG8_LDA
#undef PG8_LDB
#undef PG8_MMA
#undef PG8_WAIT_V
#undef PG8_WAIT_L
#undef PG8_BAR
#undef PG8_SCHED
}
}

struct TJob { const float* src; int ld, K, c0, nc; bf16_t* dst; };
constexpr int N_TITEMS = 13824;

__device__ __forceinline__ void rms_rows(const float* x, const float* w, bf16_t* out_bf, float* out_f, int nrows, bool grouped = false) {
    int tid_ = threadIdx.x; asm volatile("" : "+v"(tid_));
    const int lane = tid_ & 63, wave = tid_ >> 6;
    int gw = blockIdx.x * 8 + wave, ngw = gridDim.x * 8;
    if (grouped) {
        const int per = nrows >> 3, lw = (int)(blockIdx.x >> 3) * 8 + wave, nlw = (int)(gridDim.x >> 3) * 8;
        x += (size_t)(blockIdx.x & 7) * per * 1024;
        if (out_bf) out_bf += (size_t)(blockIdx.x & 7) * per * 1024;
        if (out_f) out_f += (size_t)(blockIdx.x & 7) * per * 1024;
        nrows = per; gw = lw; ngw = nlw;
    }
    f32x4 wv[4];
#pragma unroll
    for (int j = 0; j < 4; ++j) wv[j] = ((const f32x4*)w)[lane + 64 * j];
    f32x4 vn[4];
    if (gw < nrows) {
        const f32x4* xr = (const f32x4*)(x + (size_t)gw * 1024) + lane;
#pragma unroll
        for (int j = 0; j < 4; ++j) vn[j] = xr[64 * j];
    }
    for (int r = gw; r < nrows; r += ngw) {
        f32x4 v[4];
#pragma unroll
        for (int j = 0; j < 4; ++j) v[j] = vn[j];
        const int rn = (r + ngw < nrows) ? r + ngw : r;
        {
            const f32x4* xr = (const f32x4*)(x + (size_t)rn * 1024) + lane;
#pragma unroll
            for (int j = 0; j < 4; ++j) vn[j] = xr[64 * j];
        }
        float s = 0.f;
#pragma unroll
        for (int j = 0; j < 4; ++j) s += (v[j][0] * v[j][0] + v[j][1] * v[j][1]) + (v[j][2] * v[j][2] + v[j][3] * v[j][3]);
        s = wave_sum(s);
        const float rs = rsqrtf(s * (1.f / 1024.f) + EPSN);
#pragma unroll
        for (int j = 0; j < 4; ++j) {
            f32x4 o; o[0] = v[j][0] * rs * wv[j][0]; o[1] = v[j][1] * rs * wv[j][1]; o[2] = v[j][2] * rs * wv[j][2]; o[3] = v[j][3] * rs * wv[j][3];
            if (out_bf) { u32x2 pk; pk.x = pk2(o[0], o[1]); pk.y = pk2(o[2], o[3]); st_global_b64(out_bf + (size_t)r * 1024 + (size_t)(lane + 64 * j) * 4, pk); }
            else st_global_f128(out_f + (size_t)r * 1024 + (size_t)(lane + 64 * j) * 4, o);
        }
    }
}

__device__ __forceinline__ void prep_phase(const Params& p, unsigned char* smem) {
    bf16_t* WT = (bf16_t*)(p.ws + WS_WT);
    float* tile = (float*)smem;
    int tid_ = threadIdx.x; asm volatile("" : "+v"(tid_)); const int tid = tid_;
    auto decode = [&](int it, TJob& jb, int& r) {
        r = it; bool found = false; jb.src = nullptr; jb.ld = 0; jb.K = 0; jb.c0 = 0; jb.nc = 64; jb.dst = nullptr;
        auto tj = [&](const float* src, int ld, int K, int c0, int nc, bf16_t* dst) {
            if (!found) { const int ni = (K / 64) * (nc / 64); if (r < ni) { jb.src = src; jb.ld = ld; jb.K = K; jb.c0 = c0; jb.nc = nc; jb.dst = dst; found = true; } else r -= ni; } };
        for (int j = 0; j < 2; ++j) {
            const float* w = p.in[4] + (size_t)j * 1024 * GLA_IN_W; bf16_t* a1 = WT + j * WT_GLA_PER;
            tj(w, GLA_IN_W, 1024, 0, 1024, a1);
            tj(w, GLA_IN_W, 1024, 1024, 2048, a1 + (size_t)1536 * 1024);
            tj(w, GLA_IN_W, 1024, 6160, 1024, a1 + (size_t)3584 * 1024);
            tj(w, GLA_IN_W, 1024, 3088, 3072, a1 + WT_GLA_A2);
        }
        for (int j = 0; j < 2; ++j) {
            const float* w = p.in[8] + (size_t)j * 1024 * S5_IN_W; bf16_t* a1 = WT + WT_S5_BASE + j * WT_S5_PER;
            tj(w, S5_IN_W, 1024, 0, 2048, a1);
            tj(w, S5_IN_W, 1024, 5120, 1024, a1 + (size_t)2048 * 1024);
            tj(w, S5_IN_W, 1024, 2048, 3072, a1 + WT_S5_A2);
            tj(p.in[17] + (size_t)j * 2048 * 2048, 2048, 2048, 0, 2048, a1 + WT_S5_GLU);
        }
        for (int i = 0; i < 4; ++i) tj(p.in[20] + (size_t)i * 3072 * 1024, 1024, 3072, 0, 1024, WT + WT_OUT_BASE + i * WT_OUT_PER);
        for (int i = 0; i < 4; ++i) {
            const float* w = p.in[19] + (size_t)i * 1024 * 2048;
            tj(w, 2048, 1024, 0, 1024, WT + WT_K_BASE + (size_t)i * 1024 * 1024);
            tj(w, 2048, 1024, 1024, 1024, WT + WT_V_BASE + (size_t)i * 1024 * 1024);
        }
    };
    const int lk = tid >> 4, lc4 = (tid & 15) * 4;
    for (int it0 = blockIdx.x * 4; it0 < N_TITEMS; it0 += gridDim.x * 4) {
        TJob jb[4]; int rr[4]; f32x4 v0[4], v1[4];
#pragma unroll
        for (int u = 0; u < 4; ++u) {
            const int it = (it0 + u < N_TITEMS) ? it0 + u : it0;
            decode(it, jb[u], rr[u]);
            const int nblk = jb[u].nc / 64, kb = rr[u] / nblk, nb = rr[u] % nblk;
            const float* sp = jb[u].src + (size_t)(kb * 64 + lk) * jb[u].ld + jb[u].c0 + nb * 64 + lc4;
            v0[u] = *(const f32x4*)sp; v1[u] = *(const f32x4*)(sp + (size_t)32 * jb[u].ld);
        }
#pragma unroll
        for (int u = 0; u < 4; ++u) {
            tile[lk * 65 + lc4 + 0] = v0[u][0]; tile[lk * 65 + lc4 + 1] = v0[u][1]; tile[lk * 65 + lc4 + 2] = v0[u][2]; tile[lk * 65 + lc4 + 3] = v0[u][3];
            tile[(lk + 32) * 65 + lc4 + 0] = v1[u][0]; tile[(lk + 32) * 65 + lc4 + 1] = v1[u][1]; tile[(lk + 32) * 65 + lc4 + 2] = v1[u][2]; tile[(lk + 32) * 65 + lc4 + 3] = v1[u][3];
            LDS_BAR();
            const int nblk = jb[u].nc / 64, kb = rr[u] / nblk, nb = rr[u] % nblk, k0 = kb * 64, n0 = nb * 64;
            const int n = tid >> 3, kc = (tid & 7) * 8;
            u32x4 o;
            o.x = pk2(tile[(kc + 0) * 65 + n], tile[(kc + 1) * 65 + n]); o.y = pk2(tile[(kc + 2) * 65 + n], tile[(kc + 3) * 65 + n]);
            o.z = pk2(tile[(kc + 4) * 65 + n], tile[(kc + 5) * 65 + n]); o.w = pk2(tile[(kc + 6) * 65 + n], tile[(kc + 7) * 65 + n]);
            st_global_b128(jb[u].dst + (size_t)(n0 + n) * jb[u].K + k0 + kc, o);
            LDS_BAR();
        }
    }
    asm volatile("s_waitcnt vmcnt(0)" ::: "memory");
    __syncthreads();
    for (int idx = blockIdx.x * NTHREADS + tid; idx < 2 * 512 * 1024; idx += gridDim.x * NTHREADS) {
        const int j = idx >> 19, n = (idx >> 10) & 511, k = idx & 1023;
        const float* wr_ = p.in[4] + (size_t)j * 1024 * GLA_IN_W + (size_t)k * GLA_IN_W + 3072;
        const float* wg = p.in[5] + (size_t)j * 16 * 512 + n;
        float s = 0.f;
#pragma unroll
        for (int r = 0; r < 16; ++r) s += wr_[r] * wg[r * 512];
        WT[j * WT_GLA_PER + (size_t)(1024 + n) * 1024 + k] = bf1(s);
    }
    rms_rows(p.in[1], p.in[3], (bf16_t*)(p.ws + WS_MEMN), nullptr, 2048);
}

__device__ __forceinline__ void norm_phase(const Params& p, int layer) {
    const float* x = (layer == 0) ? p.in[0] : p.out;
    rms_rows(x, p.in[2] + layer * 1024, (bf16_t*)(p.ws + WS_H), nullptr, T_TOK, layer > 0);
    unsigned long long* ss = (unsigned long long*)(p.ws + WS_SUMSQ);
    for (int i = blockIdx.x * NTHREADS + threadIdx.x; i < T_TOK * 4; i += gridDim.x * NTHREADS) ss[i] = 0ull;
}

__device__ __forceinline__ void attn_phase(const Params& p, int layer, unsigned char* smem) {
    bf16_t* mix = (bf16_t*)(p.ws + WS_MIX);
    const bf16_t* kmem = (const bf16_t*)(p.ws + WS_KMEM);
    const bf16_t* vt = (const bf16_t*)(p.ws + WS_VT);
    bf16_t* KV = (bf16_t*)smem;
    bf16_t* PB = (bf16_t*)(smem + 67584);
    float* RS = (float*)(smem + 135168);
    int tid_ = threadIdx.x; asm volatile("" : "+v"(tid_));
    const int tid = tid_, wave = tid >> 6, lane = tid & 63, fr = lane & 15, fq = lane >> 4;
    const int sr = tid >> 5, sc8 = (tid & 31) * 8;
    u32x4 stg[8];
#define ATT_SRC(unit_, ti_) (((ti_) < 2) \
        ? (kmem + (size_t)((((unit_) >> 2) >> 6) * 256 + (ti_) * 128 + sr) * 4096 + layer * 1024 + ((unit_) & 3) * 256 + sc8) \
        : (vt + (size_t)(layer * 1024 + ((unit_) & 3) * 256 + ((ti_) - 2) * 128 + sr) * 2048 + (((unit_) >> 2) >> 6) * 256 + sc8))
#define ATT_LOAD(unit_, ti_) do { const bf16_t* sp_ = ATT_SRC(unit_, ti_); const size_t rp_ = ((ti_) < 2) ? (size_t)16 * 4096 : (size_t)16 * 2048; \
        _Pragma("unroll") for (int i = 0; i < 8; ++i) stg[i] = *(const u32x4*)(sp_ + i * rp_); } while (0)
#define ATT_STAGE() do { _Pragma("unroll") for (int i = 0; i < 8; ++i) *(u32x4*)(KV + (sr + 16 * i) * 264 + sc8) = stg[i]; } while (0)
    const int ab = blockIdx.x & 7, astep = (int)(gridDim.x >> 3);
#define ATT_UNIT(u_) ((((ab << 6) + ((u_) >> 2)) << 2) | ((u_) & 3))
    int au = blockIdx.x >> 3;
    int unit = (au < 256) ? ATT_UNIT(au) : 2048;
    if (unit < 2048) ATT_LOAD(unit, 0);
    __syncthreads();
    for (; au < 256; au += astep, unit = (au < 256) ? ATT_UNIT(au) : 2048) {
        const int h = unit & 3, tile = unit >> 2;
        const size_t t0 = (size_t)tile * 128;
        const int unext = (au + astep < 256) ? ATT_UNIT(au + astep) : unit;
        bf16x8 qf[8];
        {
            const bf16_t* qrow = mix + (t0 + wave * 16 + fr) * 3072 + 2048 + h * 256 + fq * 8;
#pragma unroll
            for (int ks = 0; ks < 8; ++ks) qf[ks] = *(const bf16x8*)(qrow + ks * 32);
        }
        f32x4 sacc[16];
#pragma unroll
        for (int half = 0; half < 2; ++half) {
            ATT_STAGE();
            LDS_BAR();
            ATT_LOAD(unit, half + 1);
#pragma unroll
            for (int mb = 0; mb < 8; ++mb) {
                f32x4 a = (f32x4){0.f, 0.f, 0.f, 0.f};
#pragma unroll
                for (int ks = 0; ks < 8; ++ks) { const bf16x8 bfr = *(const bf16x8*)(KV + (mb * 16 + fr) * 264 + ks * 32 + fq * 8); a = MFMA16(qf[ks], bfr, a); }
                sacc[half * 8 + mb] = a;
            }
            LDS_BAR();
        }
        const float sc = 0.0625f * L2E;
#pragma unroll
        for (int j = 0; j < 4; ++j) {
            float mx = sacc[0][j];
#pragma unroll
            for (int i = 1; i < 16; ++i) mx = fmaxf(mx, sacc[i][j]);
            mx = fmaxf(mx, __shfl_xor(mx, 1)); mx = fmaxf(mx, __shfl_xor(mx, 2)); mx = fmaxf(mx, __shfl_xor(mx, 4)); mx = fmaxf(mx, __shfl_xor(mx, 8));
            float sum = 0.f;
#pragma unroll
            for (int i = 0; i < 16; ++i) { const float e = __builtin_amdgcn_exp2f((sacc[i][j] - mx) * sc); sacc[i][j] = e; sum += e; }
            sum += __shfl_xor(sum, 1); sum += __shfl_xor(sum, 2); sum += __shfl_xor(sum, 4); sum += __shfl_xor(sum, 8);
            if (fr == 0) RS[wave * 16 + fq * 4 + j] = 1.f / sum;
#pragma unroll
            for (int i = 0; i < 16; ++i) PB[(wave * 16 + fq * 4 + j) * 264 + i * 16 + fr] = bf1(sacc[i][j]);
        }
        ATT_STAGE();
        LDS_BAR();
        bf16x8 pf[8];
#pragma unroll
        for (int ks = 0; ks < 8; ++ks) pf[ks] = *(const bf16x8*)(PB + (wave * 16 + fr) * 264 + ks * 32 + fq * 8);
        const float rinv = RS[wave * 16 + fr];
#pragma unroll
        for (int half = 0; half < 2; ++half) {
            if (half == 0) ATT_LOAD(unit, 3); else ATT_LOAD(unext, 0);
#pragma unroll
            for (int db = 0; db < 8; ++db) {
                f32x4 a = (f32x4){0.f, 0.f, 0.f, 0.f};
#pragma unroll
                for (int ks = 0; ks < 8; ++ks) { const bf16x8 bfr = *(const bf16x8*)(KV + (db * 16 + fr) * 264 + ks * 32 + fq * 8); a = MFMA16(bfr, pf[ks], a); }
                u32x2 o; o.x = pk2(a[0] * rinv, a[1] * rinv); o.y = pk2(a[2] * rinv, a[3] * rinv);
                st_global_b64(mix + (t0 + wave * 16 + fr) * 3072 + 2048 + h * 256 + half * 128 + db * 16 + fq * 4, o);
            }
            LDS_BAR();
            if (half == 0) { ATT_STAGE(); LDS_BAR(); }
        }
    }
#undef ATT_UNIT
#undef ATT_SRC
#undef ATT_LOAD
#undef ATT_STAGE
    asm volatile("s_waitcnt vmcnt(0)" ::: "memory");
    __syncthreads();
}

__device__ __forceinline__ void gla_pre_phase(const Params& p, unsigned char* smem, bool dry = false) {
    bf16_t* qk = (bf16_t*)(p.ws + WS_QK);
    unsigned char* Gb = p.ws + WS_G;
    float* BC = (float*)smem;
    float* SEG = (float*)(smem + 32768);
    float* BL = (float*)(smem + 32768 + 2048);
    bf16_t* QD = (bf16_t*)(smem + 35328);
    bf16_t* KI = QD + 64 * 136;
    bf16_t* KET = KI + 64 * 136;
    bf16_t* ATT = KET + 128 * 72;
    int tid_ = threadIdx.x; asm volatile("" : "+v"(tid_));
    const int tid = tid_, w = tid >> 6, lane = tid & 63, fr = lane & 15, fq = lane >> 4;
    const int cd = tid & 127, seg = tid >> 7;
    const int es = tid >> 3, dseg = tid & 7;
    const int cb = w >> 1;
    for (int pu = blockIdx.x >> 3; pu < 512; pu += (int)(gridDim.x >> 3)) {
        const int h = pu & 3, bc = (int)(blockIdx.x & 7) * 128 + (pu >> 2);
        const size_t t0 = (size_t)bc * 64;
        const float* G = (const float*)Gb;
        float gpre[16];
#pragma unroll
        for (int i = 0; i < 16; ++i) gpre[i] = G[(t0 + seg * 16 + i) * 512 + h * 128 + cd];
        bf16_t* qp = qk + (t0 + es) * 1024 + h * 128 + dseg * 16;
        const u32x4 q0 = *(const u32x4*)qp, q1 = *(const u32x4*)(qp + 8), k0 = *(const u32x4*)(qp + 512), k1 = *(const u32x4*)(qp + 520);
        float run = 0.f;
#pragma unroll
        for (int i = 0; i < 16; ++i) { run += gpre[i]; gpre[i] = run; }
        SEG[seg * 128 + cd] = run;
        __syncthreads();
        {
            const float s0 = SEG[cd], s1 = SEG[128 + cd], s2 = SEG[256 + cd];
            const float off = (seg > 0 ? s0 : 0.f) + (seg > 1 ? s1 : 0.f) + (seg > 2 ? s2 : 0.f);
#pragma unroll
            for (int i = 0; i < 16; ++i) BC[(seg * 16 + i) * 128 + cd] = gpre[i] + off;
            if (seg == 3) BL[cd] = run + off;
        }
        __syncthreads();
        {
            float bc_[16], bl[16];
#pragma unroll
            for (int e4 = 0; e4 < 4; ++e4) {
                const f32x4 t1 = *(const f32x4*)(BC + es * 128 + dseg * 16 + e4 * 4); const f32x4 t2 = *(const f32x4*)(BL + dseg * 16 + e4 * 4);
                bc_[e4 * 4 + 0] = t1[0]; bc_[e4 * 4 + 1] = t1[1]; bc_[e4 * 4 + 2] = t1[2]; bc_[e4 * 4 + 3] = t1[3];
                bl[e4 * 4 + 0] = t2[0]; bl[e4 * 4 + 1] = t2[1]; bl[e4 * 4 + 2] = t2[2]; bl[e4 * 4 + 3] = t2[3];
            }
            const unsigned qw[8] = { q0.x, q0.y, q0.z, q0.w, q1.x, q1.y, q1.z, q1.w };
            const unsigned kw[8] = { k0.x, k0.y, k0.z, k0.w, k1.x, k1.y, k1.z, k1.w };
            unsigned qo[8], ko[8];
#pragma unroll
            for (int e2 = 0; e2 < 8; ++e2) {
                const float e1a = fexp(bc_[2 * e2]), e1b = fexp(bc_[2 * e2 + 1]);
                const float ia = frcp(e1a), ib = frcp(e1b);
                const float e3a = fexp(bl[2 * e2] - bc_[2 * e2]), e3b = fexp(bl[2 * e2 + 1] - bc_[2 * e2 + 1]);
                const float qa = bflo(qw[e2]), qb = bfhi(qw[e2]), ka = bflo(kw[e2]), kb = bfhi(kw[e2]);
                qo[e2] = pk2(qa * e1a, qb * e1b);
                ko[e2] = pk2(ka * ia, kb * ib);
                const unsigned ke = pk2(ka * e3a, kb * e3b);
                KET[(dseg * 16 + 2 * e2) * 72 + es] = (bf16_t)(ke & 0xffffu);
                KET[(dseg * 16 + 2 * e2 + 1) * 72 + es] = (bf16_t)(ke >> 16);
            }
            u32x4 t; t.x = qo[0]; t.y = qo[1]; t.z = qo[2]; t.w = qo[3]; *(u32x4*)(QD + es * 136 + dseg * 16) = t; if (!dry) *(u32x4*)qp = t;
            t.x = qo[4]; t.y = qo[5]; t.z = qo[6]; t.w = qo[7]; *(u32x4*)(QD + es * 136 + dseg * 16 + 8) = t; if (!dry) *(u32x4*)(qp + 8) = t;
            t.x = ko[0]; t.y = ko[1]; t.z = ko[2]; t.w = ko[3]; *(u32x4*)(KI + es * 136 + dseg * 16) = t;
            t.x = ko[4]; t.y = ko[5]; t.z = ko[6]; t.w = ko[7]; *(u32x4*)(KI + es * 136 + dseg * 16 + 8) = t;
        }
        __syncthreads();
#pragma unroll
        for (int n = 0; n < 2; ++n) {
            const int sb = (w & 1) * 2 + n;
            f32x4 a = (f32x4){0.f, 0.f, 0.f, 0.f};
            if (sb <= cb) {
#pragma unroll
                for (int ks = 0; ks < 4; ++ks) {
                    const bf16x8 af = *(const bf16x8*)(QD + (cb * 16 + fr) * 136 + ks * 32 + fq * 8);
                    const bf16x8 bfr = *(const bf16x8*)(KI + (sb * 16 + fr) * 136 + ks * 32 + fq * 8);
                    a = MFMA16(af, bfr, a);
                }
            }
#pragma unroll
            for (int jj = 0; jj < 4; ++jj) {
                const int cc = cb * 16 + fq * 4 + jj, ss = sb * 16 + fr;
                ATT[cc * 72 + ss] = bf1(ss <= cc ? a[jj] : 0.f);
            }
        }
        __syncthreads();
        unsigned char* gbase = Gb + ((t0 * 512) + (size_t)h * 128) * 4;
#pragma unroll
        for (int i = 0; i < 2; ++i) {
            const int idx = tid + i * 512, d = idx >> 3, pc = idx & 7;
            const u32x4 v = *(const u32x4*)(KET + d * 72 + pc * 8);
            if (!dry) *(u32x4*)(gbase + (size_t)(d >> 2) * 2048 + (d & 3) * 128 + pc * 16) = v;
        }
        {
            const int c = tid >> 3, pc = tid & 7;
            const u32x4 v = *(const u32x4*)(ATT + c * 72 + pc * 8);
            if (!dry) *(u32x4*)(gbase + (size_t)(32 + (c >> 2)) * 2048 + (c & 3) * 128 + pc * 16) = v;
        }
        if (tid < 128 && !dry) *(float*)(gbase + (size_t)48 * 2048 + tid * 4) = fexp(BL[tid]);
        __syncthreads();
    }
}

__device__ __forceinline__ void gla_phase(const Params& p, unsigned char* smem, bool dry = false) {
    const unsigned char* qkb = p.ws + WS_QK;
    const unsigned char* Gb = p.ws + WS_G;
    bf16_t* mix = (bf16_t*)(p.ws + WS_MIX);
    float* part = (float*)(p.ws + WS_PART);
    bf16_t* ST = (bf16_t*)smem;
    bf16_t* VT = ST + 64 * 136;
    constexpr int OPB = 26624, OPSZ = 41984, O_KET = 0, O_QD = 16384, O_ATT = 32768, O_DEC = 40960;
    LAS unsigned char* lds = (LAS unsigned char*)smem;
    int tid_ = threadIdx.x; asm volatile("" : "+v"(tid_));
    const int tid = tid_, w = __builtin_amdgcn_readfirstlane(tid >> 6), lane = tid & 63, fr = lane & 15, fq = lane >> 4;
    const int es = tid >> 3, dseg = tid & 7;
    const int cb = w >> 1, wh = w & 1;
    const int crow = cb * 16 + fr;
    unsigned koff[2], qoff[2], aoff, doff;
#pragma unroll
    for (int i = 0; i < 2; ++i) {
        const int P = (2 * w + i) * 64 + lane;
        { const int r = P >> 3, s_ = P & 7, q = s_ ^ (r & 7); koff[i] = (unsigned)((r >> 2) * 2048 + (r & 3) * 128 + q * 16); }
        { const int r = P >> 4, s_ = P & 15, q = s_ ^ (r & 15); qoff[i] = (unsigned)(r * 2048 + q * 16); }
    }
    { const int P = w * 64 + lane, r = P >> 3, s_ = P & 7, q = s_ ^ (r & 7); aoff = (unsigned)((32 + (r >> 2)) * 2048 + (r & 3) * 128 + q * 16); }
    doff = (unsigned)(48 * 2048 + (lane & 31) * 16);
    int r_att[2], r_qd[4], r_ket[4][2], r_dec[4];
#pragma unroll
    for (int ks = 0; ks < 2; ++ks) r_att[ks] = O_ATT + (crow * 8 + ((ks * 4 + fq) ^ (crow & 7))) * 16;
#pragma unroll
    for (int ks = 0; ks < 4; ++ks) r_qd[ks] = O_QD + (crow * 16 + ((ks * 4 + fq) ^ (crow & 15))) * 16;
#pragma unroll
    for (int n = 0; n < 4; ++n) { const int d = (wh * 4 + n) * 16 + fr; r_dec[n] = O_DEC + d * 4;
#pragma unroll
        for (int ks = 0; ks < 2; ++ks) r_ket[n][ks] = O_KET + (d * 8 + ((ks * 4 + fq) ^ (d & 7))) * 16; }
    for (int unit = blockIdx.x; unit < 256; unit += gridDim.x) {
        const int ux = unit & 7, uy = unit >> 3;
        const int bh = ux * 4 + (uy >> 3), sl = uy & 7, h = bh & 3, b = bh >> 2;
        const size_t tb = (size_t)b * SEQ_L;
        f32x4 st[4];
#pragma unroll
        for (int n = 0; n < 4; ++n) st[n] = (f32x4){0.f, 0.f, 0.f, 0.f};
        u32x4 vpre;
#define GLA_DMA(t1, bufoff) do { const unsigned char* gb_ = Gb + (((t1) * 512) + (size_t)h * 128) * 4; const unsigned char* qb_ = qkb + (((t1) * 1024) + (size_t)h * 128) * 2; \
            _Pragma("unroll") for (int i = 0; i < 2; ++i) { \
                __builtin_amdgcn_global_load_lds((const unsigned*)(gb_ + koff[i]), (LAS unsigned*)(lds + (bufoff) + O_KET + (2 * w + i) * 1024), 16, 0, 0); \
                __builtin_amdgcn_global_load_lds((const unsigned*)(qb_ + qoff[i]), (LAS unsigned*)(lds + (bufoff) + O_QD + (2 * w + i) * 1024), 16, 0, 0); } \
            __builtin_amdgcn_global_load_lds((const unsigned*)(gb_ + aoff), (LAS unsigned*)(lds + (bufoff) + O_ATT + w * 1024), 16, 0, 0); \
            if (w == 7) __builtin_amdgcn_global_load_lds((const unsigned*)(gb_ + doff), (LAS unsigned*)(lds + (bufoff) + O_DEC), 16, 0, 0); } while (0)
#define GLA_LOAD_V(t1) vpre = *(const u32x4*)(mix + ((t1) + es) * 3072 + h * 512 + sl * 64 + dseg * 8)
        __syncthreads();
        GLA_DMA(tb, OPB); GLA_LOAD_V(tb);
        u32x2 po[2]; po[0] = (u32x2){0u, 0u}; po[1] = (u32x2){0u, 0u}; float pssq = 0.f;
        for (int c = 0; c < 128; ++c) {
            const size_t t0 = tb + (size_t)c * 64;
            const size_t tn = tb + (size_t)(c < 127 ? c + 1 : 127) * 64;
            const size_t tp = tb + (size_t)(c > 0 ? c - 1 : 0) * 64;
            const int bcur = OPB + (c & 1) * OPSZ, bnxt = OPB + ((c & 1) ^ 1) * OPSZ;
            const unsigned char* OB = smem + bcur;
            {
                const unsigned vw[4] = { vpre.x, vpre.y, vpre.z, vpre.w };
#pragma unroll
                for (int e2 = 0; e2 < 4; ++e2) {
                    VT[(dseg * 8 + 2 * e2) * 72 + es] = (bf16_t)(vw[e2] & 0xffffu);
                    VT[(dseg * 8 + 2 * e2 + 1) * 72 + es] = (bf16_t)(vw[e2] >> 16);
                }
#pragma unroll
                for (int n = 0; n < 4; ++n) {
                    const int db = wh * 4 + n;
#pragma unroll
                    for (int jj = 0; jj < 4; ++jj) ST[(cb * 16 + fq * 4 + jj) * 136 + db * 16 + fr] = bf1(st[n][jj]);
                }
            }
            asm volatile("s_waitcnt vmcnt(0) lgkmcnt(0)" ::: "memory"); __builtin_amdgcn_s_barrier(); asm volatile("" ::: "memory");
            if (!(dry && (PROBE_ABL & 1))) { GLA_DMA(tn, bnxt); GLA_LOAD_V(tn); }
            {
                bf16_t* op = mix + (tp + crow) * 3072 + h * 512 + sl * 64 + wh * 32 + fq * 4;
                if (!dry) { st_global_b64(op, po[0]); st_global_b64(op + 16, po[1]);
                st_global_b32(part + ((tp + crow) * 4 + h) * 16 + sl * 2 + wh, pssq); }
            }
            {
                bf16x8 A_vt[2];
#pragma unroll
                for (int ks = 0; ks < 2; ++ks) A_vt[ks] = *(const bf16x8*)(VT + (cb * 16 + fr) * 72 + ks * 32 + fq * 8);
#pragma unroll
                for (int n = 0; n < 4; ++n) {
                    const float dcn = *(const float*)(OB + r_dec[n]);
                    st[n][0] *= dcn; st[n][1] *= dcn; st[n][2] *= dcn; st[n][3] *= dcn;
#pragma unroll
                    for (int ks = 0; ks < 2; ++ks) st[n] = MFMA16(A_vt[ks], *(const bf16x8*)(OB + r_ket[n][ks]), st[n]);
                }
            }
            {
                bf16x8 A_att[2], A_qd[4];
#pragma unroll
                for (int ks = 0; ks < 2; ++ks) A_att[ks] = *(const bf16x8*)(OB + r_att[ks]);
#pragma unroll
                for (int ks = 0; ks < 4; ++ks) A_qd[ks] = *(const bf16x8*)(OB + r_qd[ks]);
                float ssq = 0.f;
#pragma unroll
                for (int n = 0; n < 2; ++n) {
                    const int eb = wh * 2 + n;
                    f32x4 a = (f32x4){0.f, 0.f, 0.f, 0.f};
#pragma unroll
                    for (int ks = 0; ks < 2; ++ks) { const bf16x8 bfr = *(const bf16x8*)(VT + (eb * 16 + fr) * 72 + ks * 32 + fq * 8); a = MFMA16(bfr, A_att[ks], a); }
#pragma unroll
                    for (int ks = 0; ks < 4; ++ks) { const bf16x8 bfr = *(const bf16x8*)(ST + (eb * 16 + fr) * 136 + ks * 32 + fq * 8); a = MFMA16(bfr, A_qd[ks], a); }
                    po[n].x = pk2(a[0], a[1]); po[n].y = pk2(a[2], a[3]);
                    ssq += (a[0] * a[0] + a[1] * a[1]) + (a[2] * a[2] + a[3] * a[3]);
                }
                ssq += __shfl_xor(ssq, 16); ssq += __shfl_xor(ssq, 32); pssq = ssq;
            }
            LDS_BAR();
        }
        {
            const size_t t0 = tb + (size_t)127 * 64;
            bf16_t* op = mix + (t0 + crow) * 3072 + h * 512 + sl * 64 + wh * 32 + fq * 4;
            if (!dry) { st_global_b64(op, po[0]); st_global_b64(op + 16, po[1]);
            st_global_b32(part + ((t0 + crow) * 4 + h) * 16 + sl * 2 + wh, pssq); }
        }
        asm volatile("s_waitcnt vmcnt(0)" ::: "memory");
#undef GLA_DMA
#undef GLA_LOAD_V
        __syncthreads();
    }
}

#define S5_BAR() LDS_BAR()
__device__ __forceinline__ void s5_phase(const Params& p, int j, unsigned char* smem) {
    const bf16_t* mix = (const bf16_t*)(p.ws + WS_MIX);
    bf16_t* y5 = (bf16_t*)(p.ws + WS_QK);
    int tid_ = threadIdx.x; asm volatile("" : "+v"(tid_));
    const int tid = tid_, w = __builtin_amdgcn_readfirstlane(tid >> 6), lane = tid & 63, fr = lane & 15, fq = lane >> 4;
    const int wp = w & 3;
    float* BUF = (float*)(smem + wp * 25600);
    bf16_t* XB = (bf16_t*)(smem + wp * 25600 + 8448);
    for (int ub = blockIdx.x; ub < 256; ub += gridDim.x) {
        const int b = ub & 7, g = (ub >> 3) * 4 + wp;
        const int jg = j * 128 + g;
        const float lr = p.in[9][jg * 64 + lane], li = p.in[10][jg * 64 + lane];
        const float dt = __expf(p.in[11][jg]);
        const float mag = __expf(lr * dt);
        float rev = li * dt * 0.15915494309189535f; rev -= floorf(rev);
        const float ar = mag * __builtin_amdgcn_cosf(rev), ai = mag * __builtin_amdgcn_sinf(rev);
        const size_t tb0 = (size_t)b * SEQ_L;
        if (w < 4) {
            float xr = 0.f, xi = 0.f; const float nai = -ai;
            S5_BAR();
            for (int step2 = 0; step2 < 512; step2 += 2) {
#pragma unroll
                for (int k = 0; k < 2; ++k) {
                    const float* BUFc = BUF + k * 3200; bf16_t* XBc = XB + k * 6400;
                    f32x2 bu[16];
#pragma unroll
                    for (int t = 0; t < 16; ++t) bu[t] = *(const f32x2*)(BUFc + t * 132 + 2 * lane);
#pragma unroll
                    for (int t = 0; t < 16; ++t) {
                        const float t1 = fma_s(nai, xi, bu[t][0]);
                        const float t2 = fma_s(ai, xr, bu[t][1]);
                        const float nxr = fma_s(ar, xr, t1);
                        const float nxi = fma_s(ar, xi, t2);
                        xr = nxr; xi = nxi;
                        *(unsigned*)(XBc + t * 136 + 2 * lane) = pk2(xr, xi);
                    }
                    S5_BAR();
                }
            }
        } else {
            const float nr = ar - 1.f, ni = ai, den = lr * lr + li * li;
            const float cre = (nr * lr + ni * li) / den, cim = (ni * lr - nr * li) / den;
            bf16x8 bbf[8];
#pragma unroll
            for (int nb = 0; nb < 8; ++nb) {
                const int pp = nb * 8 + (fr >> 1);
                const float c_re = __shfl(cre, pp), c_im = __shfl(cim, pp);
                const int fqc = fq & 1;
                const float* br = p.in[12] + ((size_t)jg * 64 + pp) * 16 + fqc * 8;
                const float* bi = p.in[13] + ((size_t)jg * 64 + pp) * 16 + fqc * 8;
                const f32x4 br0 = *(const f32x4*)br, br1 = *(const f32x4*)(br + 4), bi0 = *(const f32x4*)bi, bi1 = *(const f32x4*)(bi + 4);
                float v[8];
#pragma unroll
                for (int e = 0; e < 4; ++e) {
                    v[e] = (fr & 1) ? (c_re * bi0[e] + c_im * br0[e]) : (c_re * br0[e] - c_im * bi0[e]);
                    v[4 + e] = (fr & 1) ? (c_re * bi1[e] + c_im * br1[e]) : (c_re * br1[e] - c_im * bi1[e]);
                }
                u32x4 t; t.x = pk2(v[0], v[1]); t.y = pk2(v[2], v[3]); t.z = pk2(v[4], v[5]); t.w = pk2(v[6], v[7]);
                if (fq >= 2) { t.x = 0u; t.y = 0u; t.z = 0u; t.w = 0u; }
                bbf[nb] = __builtin_bit_cast(bf16x8, t);
            }
            bf16x8 cf[4];
#pragma unroll
            for (int ks = 0; ks < 4; ++ks) {
                const int pb = ks * 16 + fq * 4;
                const f32x4 cr = *(const f32x4*)(p.in[14] + ((size_t)jg * 16 + fr) * 64 + pb);
                const f32x4 ci = *(const f32x4*)(p.in[15] + ((size_t)jg * 16 + fr) * 64 + pb);
                u32x4 t; t.x = pk2(cr[0], -ci[0]); t.y = pk2(cr[1], -ci[1]); t.z = pk2(cr[2], -ci[2]); t.w = pk2(cr[3], -ci[3]);
                cf[ks] = __builtin_bit_cast(bf16x8, t);
            }
            const f32x4 dv = *(const f32x4*)(p.in[16] + j * 2048 + g * 16 + fq * 4);
            const bf16_t* ubase = mix + (tb0 + fr) * 3072 + g * 16;
            bf16_t* ybase = y5 + (tb0 + fr) * 2048 + g * 16 + fq * 4;
            const bool pad = (fq >= 2);
            u32x4 ufq[4]; u32x2 uoq[4];
            {
                u32x4 uf0 = *(const u32x4*)(ubase + (fq & 1) * 8);
                if (pad) { uf0.x = 0u; uf0.y = 0u; uf0.z = 0u; uf0.w = 0u; }
                const bf16x8 uf = __builtin_bit_cast(bf16x8, uf0);
#pragma unroll
                for (int nb = 0; nb < 8; ++nb) { const f32x4 a = MFMA16(bbf[nb], uf, ((f32x4){0.f, 0.f, 0.f, 0.f})); *(f32x4*)(BUF + fr * 132 + nb * 16 + fq * 4) = a; }
#pragma unroll
                for (int q = 1; q <= 4; ++q) ufq[q & 3] = *(const u32x4*)(ubase + (size_t)q * 16 * 3072 + (fq & 1) * 8);
#pragma unroll
                for (int q = 0; q < 3; ++q) uoq[q] = *(const u32x2*)(ubase + (size_t)q * 16 * 3072 + fq * 4);
                uoq[3] = uoq[0];
                S5_BAR();
            }
            for (int step4 = 0; step4 < 512; step4 += 4) {
#pragma unroll
                for (int k = 0; k < 4; ++k) {
                    const int step = step4 + k;
                    const int cur = k & 1, nxt = cur ^ 1;
                    float* BUFn = BUF + nxt * 3200; const bf16_t* XBn = XB + nxt * 6400;
                    u32x4 ufc = ufq[(k + 1) & 3]; if (pad) { ufc.x = 0u; ufc.y = 0u; ufc.z = 0u; ufc.w = 0u; }
                    { const int s5 = (step + 5 < 512) ? step + 5 : 511; ufq[(k + 1) & 3] = *(const u32x4*)(ubase + (size_t)s5 * 16 * 3072 + (fq & 1) * 8); }
                    const bf16x8 uf = __builtin_bit_cast(bf16x8, ufc);
                    f32x4 ya = (f32x4){0.f, 0.f, 0.f, 0.f};
#pragma unroll
                    for (int ks = 0; ks < 4; ++ks) { const bf16x8 xf = *(const bf16x8*)(XBn + fr * 136 + ks * 32 + fq * 8); ya = MFMA16(cf[ks], xf, ya); }
#pragma unroll
                    for (int nb = 0; nb < 8; ++nb) { const f32x4 a = MFMA16(bbf[nb], uf, ((f32x4){0.f, 0.f, 0.f, 0.f})); *(f32x4*)(BUFn + fr * 132 + nb * 16 + fq * 4) = a; }
                    const u32x2 uo = uoq[(k + 3) & 3];
                    { const int s3 = (step + 3 < 512) ? step + 3 : 511; uoq[(k + 3) & 3] = *(const u32x2*)(ubase + (size_t)s3 * 16 * 3072 + fq * 4); }
                    if (step > 0) {
                        const float u0 = bflo(uo.x), u1 = bfhi(uo.x), u2 = bflo(uo.y), u3 = bfhi(uo.y);
                        float yv[4] = { ya[0] + dv[0] * u0, ya[1] + dv[1] * u1, ya[2] + dv[2] * u2, ya[3] + dv[3] * u3 };
#pragma unroll
                        for (int e = 0; e < 4; ++e) { const float v = yv[e]; const float z = 0.7978845608028654f * (v + 0.044715f * v * v * v); yv[e] = v * fsigmoid(2.f * z); }
                        u32x2 o; o.x = pk2(yv[0], yv[1]); o.y = pk2(yv[2], yv[3]);
                        st_global_b64(ybase + (size_t)(step - 1) * 16 * 2048, o);
                    }
                    S5_BAR();
                }
            }
            {
                const u32x2 uo = uoq[3];
                const bf16_t* XBn = XB + 6400;
                f32x4 ya = (f32x4){0.f, 0.f, 0.f, 0.f};
#pragma unroll
                for (int ks = 0; ks < 4; ++ks) { const bf16x8 xf = *(const bf16x8*)(XBn + fr * 136 + ks * 32 + fq * 8); ya = MFMA16(cf[ks], xf, ya); }
                const float u0 = bflo(uo.x), u1 = bfhi(uo.x), u2 = bflo(uo.y), u3 = bfhi(uo.y);
                float yv[4] = { ya[0] + dv[0] * u0, ya[1] + dv[1] * u1, ya[2] + dv[2] * u2, ya[3] + dv[3] * u3 };
#pragma unroll
                for (int e = 0; e < 4; ++e) { const float v = yv[e]; const float z = 0.7978845608028654f * (v + 0.044715f * v * v * v); yv[e] = v * fsigmoid(2.f * z); }
                u32x2 o; o.x = pk2(yv[0], yv[1]); o.y = pk2(yv[2], yv[3]);
                st_global_b64(ybase + (size_t)511 * 16 * 2048, o);
            }
        }
        __syncthreads();
    }
    __syncthreads();
}

enum { K_PREP = 0, K_KV, K_NORM, K_A1, K_MIX, K_GLU, K_A2, K_A3, K_FINAL, K_MIXB };
constexpr int N_PHASES = 25;
__device__ __forceinline__ void decode_phase(int ph, int& kind, int& layer) {
    if (ph == 0) { kind = K_PREP; layer = 0; return; }
    if (ph >= 24) { kind = K_FINAL; layer = 0; return; }
    int q;
    if (ph < 6) { layer = 0; q = ph; } else { const int q0 = ph - 6; layer = 1 + q0 / 6; q = q0 - (layer - 1) * 6; }
    if (layer & 1) kind = (q == 0) ? K_NORM : (q == 1) ? K_A1 : (q == 2) ? K_MIX : (q == 3) ? K_GLU : (q == 4) ? K_A2 : K_A3;
    else kind = (q == 0) ? K_NORM : (q == 1) ? K_A1 : (q == 2) ? K_MIX : (q == 3) ? K_MIXB : (q == 4) ? K_A2 : K_A3;
}

__device__ __forceinline__ void run_phase(const Params& p, int ph, unsigned char* smem) {
    int kind, layer; decode_phase(ph, kind, layer);
    const int j = layer >> 1; const bool is_gla = !(layer & 1);
    bf16_t* WT = (bf16_t*)(p.ws + WS_WT);
    bf16_t* H = (bf16_t*)(p.ws + WS_H);
    bf16_t* MIX = (bf16_t*)(p.ws + WS_MIX);
#ifndef NO_PREP
    if (kind == K_PREP) { prep_phase(p, smem); norm_phase(p, 0); return; }
#endif
    if (kind == K_NORM) { norm_phase(p, layer); return; }
    if (kind == K_FINAL) { rms_rows(p.out, p.in[21], nullptr, p.out, T_TOK, true); return; }
    if (kind == K_MIX) {
        if (is_gla) { if (PROBE_DUP & 2) { gla_pre_phase(p, smem, true); __syncthreads(); } gla_pre_phase(p, smem); } else s5_phase(p, j, smem);
        __syncthreads();
        attn_phase(p, layer, smem);
        return;
    }
    if (kind == K_MIXB) { if (PROBE_DUP & 1) { gla_phase(p, smem, true); __syncthreads(); } gla_phase(p, smem); return; }
    const bool withkv = (kind == K_A1 && layer == 0);
    const int ngemm = withkv ? 3 : 1;
    for (int q = 0; q < ngemm; ++q) {
        pg8::Gemm g; pg8::Epi E;
        E.mode = pg8::EM_BF16; E.o0 = nullptr; E.ld0 = 0; E.qk = nullptr; E.g = nullptr; E.gbias = nullptr; E.mix = MIX; E.part = nullptr; E.onw = nullptr; E.is_gla = 0;
        E.y5 = nullptr; E.bglu = nullptr; E.xin = nullptr; E.xout = nullptr;
        int ord_c = (int)blockIdx.x;
        if (withkv && q < 2) {
            if (q == 1) ord_c = (int)((blockIdx.x + gridDim.x / 2) % gridDim.x);
            if (q == 0) { g.A = (const bf16_t*)(p.ws + WS_MEMN); g.Bt = WT + WT_K_BASE; g.M = 2048; g.N = 4096; g.K = 1024; E.o0 = (bf16_t*)(p.ws + WS_KMEM); E.ld0 = 4096; }
            else { g.A = WT + WT_V_BASE; g.Bt = (const bf16_t*)(p.ws + WS_MEMN); g.M = 4096; g.N = 2048; g.K = 1024; E.o0 = (bf16_t*)(p.ws + WS_VT); E.ld0 = 2048; }
        } else if (kind == K_A1) {
            g.A = H; g.M = T_TOK; g.K = 1024;
            if (is_gla) { g.Bt = WT + j * WT_GLA_PER; g.N = 4608; E.mode = pg8::EM_A1GLA; E.qk = (bf16_t*)(p.ws + WS_QK); E.g = (float*)(p.ws + WS_G); E.gbias = p.in[6] + j * 512; }
            else { g.Bt = WT + WT_S5_BASE + j * WT_S5_PER; g.N = 3072; E.o0 = MIX; E.ld0 = 3072; }
        } else if (kind == K_A2) {
            g.A = H; g.M = T_TOK; g.K = 1024; g.N = 3072;
            g.Bt = is_gla ? (WT + j * WT_GLA_PER + WT_GLA_A2) : (WT + WT_S5_BASE + j * WT_S5_PER + WT_S5_A2);
            E.mode = pg8::EM_GATE; E.part = (const float*)(p.ws + WS_PART); E.onw = p.in[7] + j * 512; E.is_gla = is_gla ? 1 : 0;
        } else if (kind == K_GLU) {
            g.A = (const bf16_t*)(p.ws + WS_QK); g.M = T_TOK; g.K = 2048; g.N = 2048; g.Bt = WT + WT_S5_BASE + j * WT_S5_PER + WT_S5_GLU;
            E.mode = pg8::EM_GLU; E.y5 = (const bf16_t*)(p.ws + WS_QK); E.bglu = p.in[18] + j * 2048;
        } else {
            g.A = MIX; g.M = T_TOK; g.K = 3072; g.N = 1024; g.Bt = WT + WT_OUT_BASE + layer * WT_OUT_PER;
            E.mode = pg8::EM_RESID; E.xin = (layer == 0) ? p.in[0] : p.out; E.xout = p.out;
        }
        pg8::StaticOrder S; S.init(g.M, g.N, (int)gridDim.x, ord_c);
#ifndef NO_GEMM
        pg8::gemm_phase((LAS unsigned char*)smem, g, S, E);
#endif
        __syncthreads();
    }
}

__device__ __forceinline__ void grid_barrier(unsigned* ctr, unsigned target) {
    asm volatile("s_waitcnt vmcnt(0)" ::: "memory");
    __syncthreads();
    if (threadIdx.x == 0) {
        __builtin_amdgcn_fence(__ATOMIC_RELEASE, "agent");
        atomicAdd(ctr, 1u);
        while (__hip_atomic_load(ctr, __ATOMIC_RELAXED, __HIP_MEMORY_SCOPE_AGENT) < target) __builtin_amdgcn_s_sleep(1);
        __builtin_amdgcn_fence(__ATOMIC_ACQUIRE, "agent");
    }
    __syncthreads();
}

__global__ void __launch_bounds__(NTHREADS, 2) mega(Params p) {
    extern __shared__ __attribute__((aligned(16))) unsigned char smem[];
    cg::grid_group grid = cg::this_grid();
    unsigned* ctr = (unsigned*)(p.ws + WS_CTL);
    unsigned nbar = 0, ngrp = 0;
    for (int ph = p.ph_lo; ph < p.ph_hi; ++ph) {
        run_phase(p, ph, smem);
        if (ph + 1 < p.ph_hi) {
            if (ph == p.ph_lo) { asm volatile("s_waitcnt vmcnt(0)" ::: "memory"); __syncthreads(); grid.sync(); }
            else if (ph == 1 || (gridDim.x & 7) != 0) { ++nbar; grid_barrier(ctr, nbar * gridDim.x); }
            else { ++ngrp; grid_barrier(ctr + 16 * (1 + (blockIdx.x & 7)), ngrp * (gridDim.x >> 3)); }
        }
    }
}

extern "C" void kernel_launch(void* const* d_in, const int* in_sizes, int n_in, void* d_out, int out_size, void* d_ws, size_t ws_size, hipStream_t stream) {
    static int grid = 0;
    if (grid == 0) {
        if (n_in != 22 || out_size != T_TOK * DM || ws_size < WS_END) {
            fprintf(stderr, "kernel_launch: unexpected shapes: n_in %d out %d ws %zu (need %zu)\n", n_in, out_size, ws_size, (size_t)WS_END); grid = -1; return; }
        int dev = 0, cus = 0, per_cu = 0;
        if (hipGetDevice(&dev) != hipSuccess || hipDeviceGetAttribute(&cus, hipDeviceAttributeMultiprocessorCount, dev) != hipSuccess) { grid = -1; return; }
        if (hipFuncSetAttribute((const void*)mega, hipFuncAttributeMaxDynamicSharedMemorySize, LDS_BYTES) != hipSuccess) { fprintf(stderr, "kernel_launch: hipFuncSetAttribute failed\n"); grid = -1; return; }
        if (hipOccupancyMaxActiveBlocksPerMultiprocessor(&per_cu, (const void*)mega, NTHREADS, LDS_BYTES) != hipSuccess || per_cu < 1) { fprintf(stderr, "kernel_launch: occupancy query says %d\n", per_cu); per_cu = 1; }
        (void)hipGetLastError();
        grid = cus * 1;
    }
    if (grid < 0) return;
    if (hipMemsetAsync((char*)d_ws + WS_CTL, 0, 1024, stream) != hipSuccess) { fprintf(stderr, "kernel_launch: memset failed\n"); return; }
    Params p{};
    for (int i = 0; i < 22; ++i) p.in[i] = (const float*)d_in[i];
    p.out = (float*)d_out; p.ws = (unsigned char*)d_ws;
#if MK_COOP
    p.ph_lo = 0; p.ph_hi = N_PHASES;
    void* args[] = { &p };
    hipError_t e = hipLaunchCooperativeKernel((const void*)mega, dim3(grid), dim3(NTHREADS), args, LDS_BYTES, stream);
    if (e != hipSuccess) fprintf(stderr, "cooperative launch failed: %s (grid %d)\n", hipGetErrorString(e), grid);
#else
    for (int ph = 0; ph < N_PHASES; ++ph) {
        p.ph_lo = ph; p.ph_hi = ph + 1;
        hipLaunchKernelGGL(mega, dim3(grid), dim3(NTHREADS), LDS_BYTES, stream, p);
    }
#endif
}
```

```cpp
#include <hip/hip_runtime.h>
#include <hip/hip_cooperative_groups.h>
#include <cstdio>
#include <cstdint>
namespace cg = cooperative_groups;

#ifndef MK_COOP
#define MK_COOP 1
#endif
#ifndef PROBE_DUP
#define PROBE_DUP 0
#endif
#ifndef PROBE_ABL
#define PROBE_ABL 0
#endif

#define LAS __attribute__((address_space(3)))
typedef unsigned short bf16_t;
typedef short bf16x8 __attribute__((ext_vector_type(8)));
typedef float f32x4 __attribute__((ext_vector_type(4)));
typedef float f32x2 __attribute__((ext_vector_type(2)));
typedef unsigned u32x4 __attribute__((ext_vector_type(4)));
typedef unsigned u32x2 __attribute__((ext_vector_type(2)));

constexpr int T_TOK = 65536;
constexpr int SEQ_L = 8192;
constexpr int DM = 1024;
constexpr int GLA_IN_W = 7184, S5_IN_W = 6144;
constexpr float EPSN = 1e-6f;
constexpr float L2E = 1.4426950408889634f;

constexpr size_t MiB = 1024ull * 1024ull;
constexpr size_t WS_H = 0;
constexpr size_t WS_QK = 128 * MiB;
constexpr size_t WS_G = 256 * MiB;
constexpr size_t WS_MIX = 384 * MiB;
constexpr size_t WS_KMEM = 768 * MiB;
constexpr size_t WS_VT = 784 * MiB;
constexpr size_t WS_MEMN = 800 * MiB;
constexpr size_t WS_SUMSQ = 804 * MiB;
constexpr size_t WS_CTL = 806 * MiB;
constexpr size_t WS_WT = 807 * MiB;
constexpr size_t WT_GLA_PER = (size_t)(4608 + 3072) * 1024;
constexpr size_t WT_GLA_A2 = (size_t)4608 * 1024;
constexpr size_t WT_S5_BASE = 2 * WT_GLA_PER;
constexpr size_t WT_S5_PER = (size_t)6144 * 1024 + (size_t)2048 * 2048;
constexpr size_t WT_S5_A2 = (size_t)3072 * 1024;
constexpr size_t WT_S5_GLU = (size_t)6144 * 1024;
constexpr size_t WT_OUT_BASE = WT_S5_BASE + 2 * WT_S5_PER;
constexpr size_t WT_OUT_PER = (size_t)1024 * 3072;
constexpr size_t WT_K_BASE = WT_OUT_BASE + 4 * WT_OUT_PER;
constexpr size_t WT_V_BASE = WT_K_BASE + (size_t)4096 * 1024;
constexpr size_t WT_TOTAL = WT_V_BASE + (size_t)4096 * 1024;
constexpr size_t WS_END = WS_WT + WT_TOTAL * 2;
constexpr size_t WS_PART = 920 * MiB;
static_assert(WS_END <= WS_PART && WS_PART + (size_t)T_TOK * 64 * 4 <= 1024 * MiB, "workspace map");

constexpr int LDS_BYTES = 144 * 1024;
constexpr int NTHREADS = 512;

struct Params {
    const float* in[22];
    float* out;
    unsigned char* ws;
    int ph_lo, ph_hi;
};

typedef __bf16 bf16x2_t __attribute__((ext_vector_type(2)));
__device__ __forceinline__ unsigned pk2(float lo, float hi) { f32x2 v = {lo, hi}; bf16x2_t b = __builtin_convertvector(v, bf16x2_t); return __builtin_bit_cast(unsigned, b); }
__device__ __forceinline__ bf16_t bf1(float v) { return (bf16_t)(pk2(v, 0.f) & 0xffffu); }
__device__ __forceinline__ float bflo(unsigned u) { return __uint_as_float(u << 16); }
__device__ __forceinline__ float bfhi(unsigned u) { return __uint_as_float(u & 0xffff0000u); }
__device__ __forceinline__ float wave_sum(float v) {
#pragma unroll
    for (int o = 1; o < 64; o <<= 1) v += __shfl_xor(v, o);
    return v;
}
__device__ __forceinline__ float fexp(float x) { return __builtin_amdgcn_exp2f(x * L2E); }
__device__ __forceinline__ float frcp(float x) { return __builtin_amdgcn_rcpf(x); }
__device__ __forceinline__ float fsigmoid(float x) { return frcp(1.f + fexp(-x)); }
__device__ __forceinline__ void wave_sync() { asm volatile("s_waitcnt lgkmcnt(0)" ::: "memory"); __builtin_amdgcn_wave_barrier(); }
#define LDS_BAR() do { asm volatile("s_waitcnt lgkmcnt(0)" ::: "memory"); __builtin_amdgcn_s_barrier(); asm volatile("" ::: "memory"); } while (0)
__device__ __forceinline__ void st_global_b64(void* ptr, u32x2 v) { asm volatile("global_store_dwordx2 %0, %1, off" :: "v"(ptr), "v"(v) : "memory"); }
__device__ __forceinline__ void st_global_b128(void* ptr, u32x4 v) { asm volatile("global_store_dwordx4 %0, %1, off\n\ts_nop 1" :: "v"(ptr), "v"(v) : "memory"); }
__device__ __forceinline__ void st_global_f128(void* ptr, f32x4 v) { asm volatile("global_store_dwordx4 %0, %1, off\n\ts_nop 1" :: "v"(ptr), "v"(v) : "memory"); }
__device__ __forceinline__ float fma_s(float a, float b, float c) { float d; asm("v_fma_f32 %0, %1, %2, %3" : "=v"(d) : "v"(a), "v"(b), "v"(c)); return d; }
__device__ __forceinline__ void st_global_b32(void* ptr, float v) { asm volatile("global_store_dword %0, %1, off" :: "v"(ptr), "v"(v) : "memory"); }
__device__ __forceinline__ void atomic_add_u64_noret(unsigned long long* ptr, unsigned long long v) { asm volatile("global_atomic_add_x2 %0, %1, off" :: "v"(ptr), "v"(v) : "memory"); }
#define MFMA16(a, b, c) __builtin_amdgcn_mfma_f32_16x16x32_bf16((a), (b), (c), 0, 0, 0)

namespace pg8 {
constexpr int BM = 256, BK = 64, HALF = 128, HTB = HALF * BK * 2, STAGE_BYTES = 8 * HTB, NXCD = 8, WGM = 8;
__device__ __forceinline__ int lds_byte(int r, int c) { const int st = (r >> 4) * 2 + (c >> 5), rr = r & 15, cc = c & 31, ob = rr * 64 + cc * 2; return st * 1024 + (ob ^ (((ob >> 9) & 1) << 5)); }
__device__ __forceinline__ void stage_rc(int b, int& R, int& C) { const int st = b / 1024, sb = b % 1024, swz = sb ^ (((sb >> 9) & 1) << 5); R = (st >> 1) * 16 + swz / 64; C = (st & 1) * 32 + (swz % 64) / 2; }
__device__ __forceinline__ int perm32(int rho) { const int n = rho >> 4, i = rho & 15; return 8 * (i >> 2) + 4 * n + (i & 3); }
struct Unit { int pm, pn; };
struct Gemm { const bf16_t* A; const bf16_t* Bt; int M, N, K; };
struct StaticOrder {
    int nM, nN, nwg, G, c;
    __device__ void init(int M, int N, int G_, int c_) { nM = M / BM; nN = N / BM; nwg = nM * nN; G = G_; c = c_; }
    __device__ bool next(int i, Unit& u) const {
        const long L = (long)i * G + c; if (L >= nwg) return false;
        int wgid = (int)L; { const int q = nwg / NXCD, r = nwg % NXCD, xcd = wgid % NXCD, off = wgid / NXCD; wgid = (xcd < r ? xcd * (q + 1) : r * (q + 1) + (xcd - r) * q) + off; }
        const int nig = WGM * nN, gid = wgid / nig, fm = gid * WGM, gsz = (nM - fm) < WGM ? (nM - fm) : WGM;
        u.pm = fm + ((wgid % nig) % gsz); u.pn = (wgid % nig) / gsz; return true;
    }
};

enum { EM_BF16 = 0, EM_A1GLA = 1, EM_GATE = 2, EM_GLU = 3, EM_RESID = 4 };
struct Epi {
    int mode;
    bf16_t* o0; int ld0;
    bf16_t* qk; float* g; const float* gbias; bf16_t* mix;
    const float* part; const float* onw; int is_gla;
    const bf16_t* y5; const float* bglu;
    const float* xin; float* xout;
    __device__ __forceinline__ void operator()(const f32x4 (&acc)[2][2][4][2], const Unit& u, int wr, int wc, int fr, int fq) const {
        const int row0 = u.pm * BM + wr * 64 + fr;
        const int cb = u.pn * BM + wc * 32 + 8 * fq;
#define EPI_ROW(it) ((size_t)(row0 + ((it) >> 3) * HALF + (((it) >> 1) & 3) * 16))
#define EPI_COL(it) (cb + ((it) & 1) * HALF)
#define EPI_V0(it) acc[(it) >> 3][(it) & 1][((it) >> 1) & 3][0]
#define EPI_V1(it) acc[(it) >> 3][(it) & 1][((it) >> 1) & 3][1]
        if (mode == EM_BF16) {
#pragma unroll
            for (int it = 0; it < 16; ++it) { const f32x4 v0 = EPI_V0(it), v1 = EPI_V1(it);
                u32x4 o; o.x = pk2(v0[0], v0[1]); o.y = pk2(v0[2], v0[3]); o.z = pk2(v1[0], v1[1]); o.w = pk2(v1[2], v1[3]);
                *(u32x4*)(o0 + EPI_ROW(it) * ld0 + EPI_COL(it)) = o; }
        } else if (mode == EM_A1GLA) {
            if (u.pn < 4) {
                const float sc = (u.pn < 2) ? 0.08838834764831845f : 1.f;
#pragma unroll
                for (int it = 0; it < 16; ++it) { const f32x4 v0 = EPI_V0(it), v1 = EPI_V1(it);
                    u32x4 o; o.x = pk2(v0[0] * sc, v0[1] * sc); o.y = pk2(v0[2] * sc, v0[3] * sc); o.z = pk2(v1[0] * sc, v1[1] * sc); o.w = pk2(v1[2] * sc, v1[3] * sc);
                    *(u32x4*)(qk + EPI_ROW(it) * 1024 + EPI_COL(it)) = o; }
            } else if (u.pn < 6) {
                f32x4 bia[2][2];
#pragma unroll
                for (int bj = 0; bj < 2; ++bj) { bia[bj][0] = *(const f32x4*)(gbias + cb + bj * HALF - 1024); bia[bj][1] = *(const f32x4*)(gbias + cb + bj * HALF - 1024 + 4); }
#pragma unroll
                for (int it = 0; it < 16; ++it) { const f32x4 v0 = EPI_V0(it), v1 = EPI_V1(it); const int gc = EPI_COL(it) - 1024;
                    f32x4 r0, r1;
#pragma unroll
                    for (int e = 0; e < 4; ++e) {
                        const float x0 = v0[e] + bia[it & 1][0][e], x1 = v1[e] + bia[it & 1][1][e];
                        r0[e] = (fminf(x0, 0.f) - __logf(1.f + fexp(-fabsf(x0)))) * 0.0625f;
                        r1[e] = (fminf(x1, 0.f) - __logf(1.f + fexp(-fabsf(x1)))) * 0.0625f;
                    }
                    *(f32x4*)(g + EPI_ROW(it) * 512 + gc) = r0; *(f32x4*)(g + EPI_ROW(it) * 512 + gc + 4) = r1; }
            } else {
#pragma unroll
                for (int it = 0; it < 16; ++it) { const f32x4 v0 = EPI_V0(it), v1 = EPI_V1(it);
                    u32x4 o; o.x = pk2(v0[0], v0[1]); o.y = pk2(v0[2], v0[3]); o.z = pk2(v1[0], v1[1]); o.w = pk2(v1[2], v1[3]);
                    *(u32x4*)(mix + EPI_ROW(it) * 3072 + (EPI_COL(it) - 1536)) = o; }
            }
        } else if (mode == EM_GATE) {
            const bool nrm = is_gla && (cb < 2048);
            float rs[8]; f32x4 wv[2][2];
#pragma unroll
            for (int i = 0; i < 8; ++i) rs[i] = 1.f;
#pragma unroll
            for (int bj = 0; bj < 2; ++bj) { wv[bj][0] = (f32x4){1.f, 1.f, 1.f, 1.f}; wv[bj][1] = (f32x4){1.f, 1.f, 1.f, 1.f}; }
            if (nrm) {
#pragma unroll
                for (int i = 0; i < 8; ++i) {
                    const f32x4* pp = (const f32x4*)(part + (EPI_ROW(2 * i) * 4 + (cb >> 9)) * 16);
                    const f32x4 p0 = pp[0], p1 = pp[1], p2 = pp[2], p3 = pp[3];
                    const float ssum = ((p0[0] + p0[1]) + (p0[2] + p0[3])) + ((p1[0] + p1[1]) + (p1[2] + p1[3])) + ((p2[0] + p2[1]) + (p2[2] + p2[3])) + ((p3[0] + p3[1]) + (p3[2] + p3[3]));
                    rs[i] = rsqrtf(ssum * (1.f / 512.f) + EPSN);
                }
#pragma unroll
                for (int bj = 0; bj < 2; ++bj) { wv[bj][0] = *(const f32x4*)(onw + ((cb + bj * HALF) & 511)); wv[bj][1] = *(const f32x4*)(onw + ((cb + bj * HALF) & 511) + 4); }
            }
#pragma unroll
            for (int hb = 0; hb < 4; ++hb) {
            u32x4 mva[4];
#pragma unroll
            for (int i = 0; i < 4; ++i) mva[i] = *(const u32x4*)(mix + EPI_ROW(hb * 4 + i) * 3072 + EPI_COL(hb * 4 + i));
#pragma unroll
            for (int i = 0; i < 4; ++i) { const int it = hb * 4 + i;
                const u32x4 mv = mva[i];
                const f32x4 v0 = EPI_V0(it), v1 = EPI_V1(it);
                const float f[8] = { bflo(mv.x), bfhi(mv.x), bflo(mv.y), bfhi(mv.y), bflo(mv.z), bfhi(mv.z), bflo(mv.w), bfhi(mv.w) };
                const float r = rs[it >> 1];
                float y[8];
#pragma unroll
                for (int e = 0; e < 4; ++e) { y[e] = f[e] * (r * wv[it & 1][0][e]) * v0[e] * fsigmoid(v0[e]); y[4 + e] = f[4 + e] * (r * wv[it & 1][1][e]) * v1[e] * fsigmoid(v1[e]); }
                u32x4 o; o.x = pk2(y[0], y[1]); o.y = pk2(y[2], y[3]); o.z = pk2(y[4], y[5]); o.w = pk2(y[6], y[7]);
                st_global_b128(mix + EPI_ROW(it) * 3072 + EPI_COL(it), o);
            }
            }
        } else if (mode == EM_GLU) {
            f32x4 bia[2][2];
#pragma unroll
            for (int bj = 0; bj < 2; ++bj) { bia[bj][0] = *(const f32x4*)(bglu + cb + bj * HALF); bia[bj][1] = *(const f32x4*)(bglu + cb + bj * HALF + 4); }
#pragma unroll
            for (int hb = 0; hb < 2; ++hb) {
            u32x4 mva[8];
#pragma unroll
            for (int i = 0; i < 8; ++i) mva[i] = *(const u32x4*)(y5 + EPI_ROW(hb * 8 + i) * 2048 + EPI_COL(hb * 8 + i));
#pragma unroll
            for (int i = 0; i < 8; ++i) { const int it = hb * 8 + i;
                const u32x4 mv = mva[i];
                const f32x4 v0 = EPI_V0(it), v1 = EPI_V1(it);
                const float f[8] = { bflo(mv.x), bfhi(mv.x), bflo(mv.y), bfhi(mv.y), bflo(mv.z), bfhi(mv.z), bflo(mv.w), bfhi(mv.w) };
                float y[8];
#pragma unroll
                for (int e = 0; e < 4; ++e) { y[e] = f[e] * fsigmoid(v0[e] + bia[it & 1][0][e]); y[4 + e] = f[4 + e] * fsigmoid(v1[e] + bia[it & 1][1][e]); }
                u32x4 o; o.x = pk2(y[0], y[1]); o.y = pk2(y[2], y[3]); o.z = pk2(y[4], y[5]); o.w = pk2(y[6], y[7]);
                st_global_b128(mix + EPI_ROW(it) * 3072 + EPI_COL(it), o);
            }
            }
        } else {
#pragma unroll
            for (int hb = 0; hb < 4; ++hb) {
                f32x4 xa[4][2];
#pragma unroll
                for (int i = 0; i < 4; ++i) { const int it = hb * 4 + i; xa[i][0] = *(const f32x4*)(xin + EPI_ROW(it) * 1024 + EPI_COL(it)); xa[i][1] = *(const f32x4*)(xin + EPI_ROW(it) * 1024 + EPI_COL(it) + 4); }
#pragma unroll
                for (int i = 0; i < 4; ++i) { const int it = hb * 4 + i;
                    st_global_f128(xout + EPI_ROW(it) * 1024 + EPI_COL(it), xa[i][0] + EPI_V0(it)); st_global_f128(xout + EPI_ROW(it) * 1024 + EPI_COL(it) + 4, xa[i][1] + EPI_V1(it)); }
            }
        }
#undef EPI_ROW
#undef EPI_COL
#undef EPI_V0
#undef EPI_V1
    }
};

__device__ __forceinline__ void gemm_phase(LAS unsigned char* lds, const Gemm g, const StaticOrder& S, const Epi& E) {
    int tid_ = threadIdx.x; asm volatile("" : "+v"(tid_));
    const int tid = tid_, wid = __builtin_amdgcn_readfirstlane(tid >> 6), lane = tid & 63, wr = wid >> 2, wc = wid & 3, fr = lane & 15, fq = lane >> 4;
    const int K = g.K, nt = K / BK;
    unsigned voffA[2], voffB[2];
#pragma unroll
    for (int i = 0; i < 2; ++i) { int R, C; stage_rc(tid * 16 + i * 8192, R, C); const int Rb = (R & ~31) + perm32(R & 31);
        voffA[i] = (unsigned)(R * K + C) * 2u; voffB[i] = (unsigned)(Rb * K + C) * 2u; }
    const size_t kstep = (size_t)(BK * 2);
    const size_t hstep = (size_t)HALF * K * 2;
    const size_t tstep = 2 * hstep;
    const unsigned ldsw = (unsigned)wid * 1024u;
    const int aoff = lds_byte(wr * 64 + fr, fq * 8), boff = lds_byte(wc * 32 + fr, fq * 8);
#define PG8_SA(b, h) (((b) * 2 + (h)) * HTB)
#define PG8_SB(b, h) ((4 + (b) * 2 + (h)) * HTB)
#define PG8_STAGE(bufoff, gbase, voff) do { _Pragma("unroll") for (int _i = 0; _i < 2; ++_i) \
        __builtin_amdgcn_global_load_lds((const unsigned*)((const char*)(gbase) + (voff)[_i]), (LAS unsigned*)(lds + (bufoff) + ldsw + _i * 8192), 16, 0, 0); } while (0)
#define PG8_LDA(dst, b, h) do { _Pragma("unroll") for (int m = 0; m < 4; ++m) _Pragma("unroll") for (int k = 0; k < 2; ++k) dst[m][k] = *(const LAS bf16x8*)(lds + PG8_SA(b, h) + aoff + m * 2048 + k * 1024); } while (0)
#define PG8_LDB(dst, b, h) do { _Pragma("unroll") for (int n = 0; n < 2; ++n) _Pragma("unroll") for (int k = 0; k < 2; ++k) dst[n][k] = *(const LAS bf16x8*)(lds + PG8_SB(b, h) + boff + n * 2048 + k * 1024); } while (0)
#define PG8_MMA(ai, bj, At, Bt) do { __builtin_amdgcn_s_setprio(1); _Pragma("unroll") for (int m = 0; m < 4; ++m) _Pragma("unroll") for (int n = 0; n < 2; ++n) _Pragma("unroll") for (int k = 0; k < 2; ++k) \
        acc[ai][bj][m][n] = __builtin_amdgcn_mfma_f32_16x16x32_bf16(Bt[n][k], At[m][k], acc[ai][bj][m][n], 0, 0, 0); __builtin_amdgcn_s_setprio(0); } while (0)
#define PG8_WAIT_V(n) asm volatile("s_waitcnt vmcnt(" #n ")" ::: "memory")
#define PG8_WAIT_L(n) asm volatile("s_waitcnt lgkmcnt(" #n ")" ::: "memory")
#define PG8_BAR __builtin_amdgcn_s_barrier()
#define PG8_SCHED __builtin_amdgcn_sched_barrier(0)
    Unit cur, nxt; int ui = 0;
    if (!S.next(0, cur)) return;
    f32x4 acc[2][2][4][2];
#pragma unroll
    for (int a = 0; a < 2; ++a)
#pragma unroll
        for (int b = 0; b < 2; ++b)
#pragma unroll
            for (int m = 0; m < 4; ++m)
#pragma unroll
                for (int n = 0; n < 2; ++n) acc[a][b][m][n] = (f32x4){0.f, 0.f, 0.f, 0.f};
    bf16x8 At[4][2], B0[2][2], B1[2][2];
    const char* cA = (const char*)g.A + (size_t)cur.pm * tstep; const char* cB = (const char*)g.Bt + (size_t)cur.pn * tstep;
    PG8_STAGE(PG8_SB(0, 0), cB, voffB); PG8_STAGE(PG8_SB(0, 1), cB + hstep, voffB); PG8_STAGE(PG8_SA(0, 0), cA, voffA); PG8_STAGE(PG8_SA(0, 1), cA + hstep, voffA);
    if (wr == 1) PG8_BAR;
    PG8_WAIT_V(2); PG8_BAR;
    PG8_STAGE(PG8_SB(1, 0), cB + kstep, voffB); PG8_STAGE(PG8_SA(1, 0), cA + kstep, voffA); PG8_STAGE(PG8_SB(1, 1), cB + hstep + kstep, voffB);
    PG8_WAIT_V(6); PG8_BAR;
    for (;;) {
        const bool has_next = S.next(ui + 1, nxt);
        const char* nA = has_next ? (const char*)g.A + (size_t)nxt.pm * tstep : cA; const char* nB = has_next ? (const char*)g.Bt + (size_t)nxt.pn * tstep : cB;
        for (int t = 0; t < nt; t += 2) {
            const bool last = (t == nt - 2);
            const char* a1 = cA + (size_t)(t + 1) * kstep;
            const char* a2 = last ? nA : cA + (size_t)(t + 2) * kstep; const char* b2 = last ? nB : cB + (size_t)(t + 2) * kstep;
            const char* a3 = a2 + kstep; const char* b3 = b2 + kstep;
            PG8_LDB(B0, 0, 0); PG8_LDB(B1, 0, 1); PG8_SCHED; PG8_LDA(At, 0, 0); PG8_STAGE(PG8_SA(1, 1), a1 + hstep, voffA);
            PG8_WAIT_V(8); PG8_WAIT_L(0); PG8_BAR; PG8_MMA(0, 0, At, B0); PG8_MMA(0, 1, At, B1); PG8_BAR; PG8_SCHED;
            PG8_LDA(At, 0, 1); PG8_STAGE(PG8_SB(0, 0), b2, voffB); PG8_STAGE(PG8_SB(0, 1), b2 + hstep, voffB); PG8_STAGE(PG8_SA(0, 0), a2, voffA);
            PG8_WAIT_V(8); PG8_WAIT_L(0); PG8_BAR; PG8_MMA(1, 0, At, B0); PG8_MMA(1, 1, At, B1); PG8_BAR; PG8_SCHED;
            PG8_LDB(B0, 1, 0); PG8_LDB(B1, 1, 1); PG8_SCHED; PG8_LDA(At, 1, 0); PG8_STAGE(PG8_SA(0, 1), a2 + hstep, voffA);
            PG8_WAIT_V(8); PG8_WAIT_L(0); PG8_BAR; PG8_MMA(0, 0, At, B0); PG8_MMA(0, 1, At, B1); PG8_BAR; PG8_SCHED;
            PG8_LDA(At, 1, 1); PG8_STAGE(PG8_SB(1, 0), b3, voffB); PG8_STAGE(PG8_SB(1, 1), b3 + hstep, voffB); PG8_STAGE(PG8_SA(1, 0), a3, voffA);
            PG8_WAIT_V(8); PG8_WAIT_L(0); PG8_BAR; PG8_MMA(1, 0, At, B0); PG8_MMA(1, 1, At, B1); PG8_BAR; PG8_SCHED;
        }
        if (wr == 0) PG8_BAR;
        E(acc, cur, wr, wc, fr, fq);
        if (!has_next) break;
#pragma unroll
        for (int a = 0; a < 2; ++a)
#pragma unroll
            for (int b = 0; b < 2; ++b)
#pragma unroll
                for (int m = 0; m < 4; ++m)
#pragma unroll
                    for (int n = 0; n < 2; ++n) acc[a][b][m][n] = (f32x4){0.f, 0.f, 0.f, 0.f};
        cur = nxt; cA = nA; cB = nB; ++ui;
        if (wr == 1) PG8_BAR;
    }
    PG8_WAIT_V(0);
    PG8_BAR;
#undef PG8_SA
#undef PG8_SB
#undef PG8_STAGE
#undef PG8_LDA
#undef PG8_LDB
#undef PG8_MMA
#undef PG8_WAIT_V
#undef PG8_WAIT_L
#undef PG8_BAR
#undef PG8_SCHED
}
}

struct TJob { const float* src; int ld, K, c0, nc; bf16_t* dst; };
constexpr int N_TITEMS = 13824;

__device__ __forceinline__ void rms_rows(const float* x, const float* w, bf16_t* out_bf, float* out_f, int nrows, bool grouped = false) {
    int tid_ = threadIdx.x; asm volatile("" : "+v"(tid_));
    const int lane = tid_ & 63, wave = tid_ >> 6;
    int gw = blockIdx.x * 8 + wave, ngw = gridDim.x * 8;
    if (grouped) {
        const int per = nrows >> 3, lw = (int)(blockIdx.x >> 3) * 8 + wave, nlw = (int)(gridDim.x >> 3) * 8;
        x += (size_t)(blockIdx.x & 7) * per * 1024;
        if (out_bf) out_bf += (size_t)(blockIdx.x & 7) * per * 1024;
        if (out_f) out_f += (size_t)(blockIdx.x & 7) * per * 1024;
        nrows = per; gw = lw; ngw = nlw;
    }
    f32x4 wv[4];
#pragma unroll
    for (int j = 0; j < 4; ++j) wv[j] = ((const f32x4*)w)[lane + 64 * j];
    f32x4 va[4], vb[4];
    {
        const int r0 = (gw < nrows) ? gw : 0, r1 = (gw + ngw < nrows) ? gw + ngw : r0;
        const f32x4* x0 = (const f32x4*)(x + (size_t)r0 * 1024) + lane; const f32x4* x1 = (const f32x4*)(x + (size_t)r1 * 1024) + lane;
#pragma unroll
        for (int j = 0; j < 4; ++j) { va[j] = x0[64 * j]; vb[j] = x1[64 * j]; }
    }
    for (int r = gw; r < nrows; r += ngw) {
        f32x4 v[4];
#pragma unroll
        for (int j = 0; j < 4; ++j) { v[j] = va[j]; va[j] = vb[j]; }
        const int rn = (r + 2 * ngw < nrows) ? r + 2 * ngw : r;
        {
            const f32x4* xr = (const f32x4*)(x + (size_t)rn * 1024) + lane;
#pragma unroll
            for (int j = 0; j < 4; ++j) vb[j] = xr[64 * j];
        }
        float s = 0.f;
#pragma unroll
        for (int j = 0; j < 4; ++j) s += (v[j][0] * v[j][0] + v[j][1] * v[j][1]) + (v[j][2] * v[j][2] + v[j][3] * v[j][3]);
        s = wave_sum(s);
        const float rs = rsqrtf(s * (1.f / 1024.f) + EPSN);
#pragma unroll
        for (int j = 0; j < 4; ++j) {
            f32x4 o; o[0] = v[j][0] * rs * wv[j][0]; o[1] = v[j][1] * rs * wv[j][1]; o[2] = v[j][2] * rs * wv[j][2]; o[3] = v[j][3] * rs * wv[j][3];
            if (out_bf) { u32x2 pk; pk.x = pk2(o[0], o[1]); pk.y = pk2(o[2], o[3]); st_global_b64(out_bf + (size_t)r * 1024 + (size_t)(lane + 64 * j) * 4, pk); }
            else st_global_f128(out_f + (size_t)r * 1024 + (size_t)(lane + 64 * j) * 4, o);
        }
    }
}

__device__ __forceinline__ void prep_phase(const Params& p, unsigned char* smem) {
    bf16_t* WT = (bf16_t*)(p.ws + WS_WT);
    float* tile = (float*)smem;
    int tid_ = threadIdx.x; asm volatile("" : "+v"(tid_)); const int tid = tid_;
    auto decode = [&](int it, TJob& jb, int& r) {
        r = it; bool found = false; jb.src = nullptr; jb.ld = 0; jb.K = 0; jb.c0 = 0; jb.nc = 64; jb.dst = nullptr;
        auto tj = [&](const float* src, int ld, int K, int c0, int nc, bf16_t* dst) {
            if (!found) { const int ni = (K / 64) * (nc / 64); if (r < ni) { jb.src = src; jb.ld = ld; jb.K = K; jb.c0 = c0; jb.nc = nc; jb.dst = dst; found = true; } else r -= ni; } };
        for (int j = 0; j < 2; ++j) {
            const float* w = p.in[4] + (size_t)j * 1024 * GLA_IN_W; bf16_t* a1 = WT + j * WT_GLA_PER;
            tj(w, GLA_IN_W, 1024, 0, 1024, a1);
            tj(w, GLA_IN_W, 1024, 1024, 2048, a1 + (size_t)1536 * 1024);
            tj(w, GLA_IN_W, 1024, 6160, 1024, a1 + (size_t)3584 * 1024);
            tj(w, GLA_IN_W, 1024, 3088, 3072, a1 + WT_GLA_A2);
        }
        for (int j = 0; j < 2; ++j) {
            const float* w = p.in[8] + (size_t)j * 1024 * S5_IN_W; bf16_t* a1 = WT + WT_S5_BASE + j * WT_S5_PER;
            tj(w, S5_IN_W, 1024, 0, 2048, a1);
            tj(w, S5_IN_W, 1024, 5120, 1024, a1 + (size_t)2048 * 1024);
            tj(w, S5_IN_W, 1024, 2048, 3072, a1 + WT_S5_A2);
            tj(p.in[17] + (size_t)j * 2048 * 2048, 2048, 2048, 0, 2048, a1 + WT_S5_GLU);
        }
        for (int i = 0; i < 4; ++i) tj(p.in[20] + (size_t)i * 3072 * 1024, 1024, 3072, 0, 1024, WT + WT_OUT_BASE + i * WT_OUT_PER);
        for (int i = 0; i < 4; ++i) {
            const float* w = p.in[19] + (size_t)i * 1024 * 2048;
            tj(w, 2048, 1024, 0, 1024, WT + WT_K_BASE + (size_t)i * 1024 * 1024);
            tj(w, 2048, 1024, 1024, 1024, WT + WT_V_BASE + (size_t)i * 1024 * 1024);
        }
    };
    const int lk = tid >> 4, lc4 = (tid & 15) * 4;
    for (int it0 = blockIdx.x * 4; it0 < N_TITEMS; it0 += gridDim.x * 4) {
        TJob jb[4]; int rr[4]; f32x4 v0[4], v1[4];
#pragma unroll
        for (int u = 0; u < 4; ++u) {
            const int it = (it0 + u < N_TITEMS) ? it0 + u : it0;
            decode(it, jb[u], rr[u]);
            const int nblk = jb[u].nc / 64, kb = rr[u] / nblk, nb = rr[u] % nblk;
            const float* sp = jb[u].src + (size_t)(kb * 64 + lk) * jb[u].ld + jb[u].c0 + nb * 64 + lc4;
            v0[u] = *(const f32x4*)sp; v1[u] = *(const f32x4*)(sp + (size_t)32 * jb[u].ld);
        }
#pragma unroll
        for (int u = 0; u < 4; ++u) {
            tile[lk * 65 + lc4 + 0] = v0[u][0]; tile[lk * 65 + lc4 + 1] = v0[u][1]; tile[lk * 65 + lc4 + 2] = v0[u][2]; tile[lk * 65 + lc4 + 3] = v0[u][3];
            tile[(lk + 32) * 65 + lc4 + 0] = v1[u][0]; tile[(lk + 32) * 65 + lc4 + 1] = v1[u][1]; tile[(lk + 32) * 65 + lc4 + 2] = v1[u][2]; tile[(lk + 32) * 65 + lc4 + 3] = v1[u][3];
            LDS_BAR();
            const int nblk = jb[u].nc / 64, kb = rr[u] / nblk, nb = rr[u] % nblk, k0 = kb * 64, n0 = nb * 64;
            const int n = tid >> 3, kc = (tid & 7) * 8;
            u32x4 o;
            o.x = pk2(tile[(kc + 0) * 65 + n], tile[(kc + 1) * 65 + n]); o.y = pk2(tile[(kc + 2) * 65 + n], tile[(kc + 3) * 65 + n]);
            o.z = pk2(tile[(kc + 4) * 65 + n], tile[(kc + 5) * 65 + n]); o.w = pk2(tile[(kc + 6) * 65 + n], tile[(kc + 7) * 65 + n]);
            st_global_b128(jb[u].dst + (size_t)(n0 + n) * jb[u].K + k0 + kc, o);
            LDS_BAR();
        }
    }
    asm volatile("s_waitcnt vmcnt(0)" ::: "memory");
    __syncthreads();
    for (int idx = blockIdx.x * NTHREADS + tid; idx < 2 * 512 * 1024; idx += gridDim.x * NTHREADS) {
        const int j = idx >> 19, n = (idx >> 10) & 511, k = idx & 1023;
        const float* wr_ = p.in[4] + (size_t)j * 1024 * GLA_IN_W + (size_t)k * GLA_IN_W + 3072;
        const float* wg = p.in[5] + (size_t)j * 16 * 512 + n;
        float s = 0.f;
#pragma unroll
        for (int r = 0; r < 16; ++r) s += wr_[r] * wg[r * 512];
        WT[j * WT_GLA_PER + (size_t)(1024 + n) * 1024 + k] = bf1(s);
    }
    rms_rows(p.in[1], p.in[3], (bf16_t*)(p.ws + WS_MEMN), nullptr, 2048);
}

__device__ __forceinline__ void norm_phase(const Params& p, int layer) {
    const float* x = (layer == 0) ? p.in[0] : p.out;
    rms_rows(x, p.in[2] + layer * 1024, (bf16_t*)(p.ws + WS_H), nullptr, T_TOK, layer > 0);
    unsigned long long* ss = (unsigned long long*)(p.ws + WS_SUMSQ);
    for (int i = blockIdx.x * NTHREADS + threadIdx.x; i < T_TOK * 4; i += gridDim.x * NTHREADS) ss[i] = 0ull;
}

__device__ __forceinline__ void attn_phase(const Params& p, int layer, unsigned char* smem) {
    bf16_t* mix = (bf16_t*)(p.ws + WS_MIX);
    const bf16_t* kmem = (const bf16_t*)(p.ws + WS_KMEM);
    const bf16_t* vt = (const bf16_t*)(p.ws + WS_VT);
    bf16_t* KV = (bf16_t*)smem;
    bf16_t* PB = (bf16_t*)(smem + 67584);
    float* RS = (float*)(smem + 135168);
    int tid_ = threadIdx.x; asm volatile("" : "+v"(tid_));
    const int tid = tid_, wave = tid >> 6, lane = tid & 63, fr = lane & 15, fq = lane >> 4;
    const int sr = tid >> 5, sc8 = (tid & 31) * 8;
    u32x4 stg[8];
#define ATT_SRC(unit_, ti_) (((ti_) < 2) \
        ? (kmem + (size_t)((((unit_) >> 2) >> 6) * 256 + (ti_) * 128 + sr) * 4096 + layer * 1024 + ((unit_) & 3) * 256 + sc8) \
        : (vt + (size_t)(layer * 1024 + ((unit_) & 3) * 256 + ((ti_) - 2) * 128 + sr) * 2048 + (((unit_) >> 2) >> 6) * 256 + sc8))
#define ATT_LOAD(unit_, ti_) do { const bf16_t* sp_ = ATT_SRC(unit_, ti_); const size_t rp_ = ((ti_) < 2) ? (size_t)16 * 4096 : (size_t)16 * 2048; \
        _Pragma("unroll") for (int i = 0; i < 8; ++i) stg[i] = *(const u32x4*)(sp_ + i * rp_); } while (0)
#define ATT_STAGE() do { _Pragma("unroll") for (int i = 0; i < 8; ++i) *(u32x4*)(KV + (sr + 16 * i) * 264 + sc8) = stg[i]; } while (0)
    const int ab = blockIdx.x & 7, astep = (int)(gridDim.x >> 3);
#define ATT_UNIT(u_) ((((ab << 6) + ((u_) >> 2)) << 2) | ((u_) & 3))
    int au = blockIdx.x >> 3;
    int unit = (au < 256) ? ATT_UNIT(au) : 2048;
    if (unit < 2048) ATT_LOAD(unit, 0);
    __syncthreads();
    for (; au < 256; au += astep, unit = (au < 256) ? ATT_UNIT(au) : 2048) {
        const int h = unit & 3, tile = unit >> 2;
        const size_t t0 = (size_t)tile * 128;
        const int unext = (au + astep < 256) ? ATT_UNIT(au + astep) : unit;
        bf16x8 qf[8];
        {
            const bf16_t* qrow = mix + (t0 + wave * 16 + fr) * 3072 + 2048 + h * 256 + fq * 8;
#pragma unroll
            for (int ks = 0; ks < 8; ++ks) qf[ks] = *(const bf16x8*)(qrow + ks * 32);
        }
        f32x4 sacc[16];
#pragma unroll
        for (int half = 0; half < 2; ++half) {
            ATT_STAGE();
            LDS_BAR();
            ATT_LOAD(unit, half + 1);
#pragma unroll
            for (int mb = 0; mb < 8; ++mb) {
                f32x4 a = (f32x4){0.f, 0.f, 0.f, 0.f};
#pragma unroll
                for (int ks = 0; ks < 8; ++ks) { const bf16x8 bfr = *(const bf16x8*)(KV + (mb * 16 + fr) * 264 + ks * 32 + fq * 8); a = MFMA16(qf[ks], bfr, a); }
                sacc[half * 8 + mb] = a;
            }
            LDS_BAR();
        }
        const float sc = 0.0625f * L2E;
#pragma unroll
        for (int j = 0; j < 4; ++j) {
            float mx = sacc[0][j];
#pragma unroll
            for (int i = 1; i < 16; ++i) mx = fmaxf(mx, sacc[i][j]);
            mx = fmaxf(mx, __shfl_xor(mx, 1)); mx = fmaxf(mx, __shfl_xor(mx, 2)); mx = fmaxf(mx, __shfl_xor(mx, 4)); mx = fmaxf(mx, __shfl_xor(mx, 8));
            float sum = 0.f;
#pragma unroll
            for (int i = 0; i < 16; ++i) { const float e = __builtin_amdgcn_exp2f((sacc[i][j] - mx) * sc); sacc[i][j] = e; sum += e; }
            sum += __shfl_xor(sum, 1); sum += __shfl_xor(sum, 2); sum += __shfl_xor(sum, 4); sum += __shfl_xor(sum, 8);
            if (fr == 0) RS[wave * 16 + fq * 4 + j] = 1.f / sum;
#pragma unroll
            for (int i = 0; i < 16; ++i) PB[(wave * 16 + fq * 4 + j) * 264 + i * 16 + fr] = bf1(sacc[i][j]);
        }
        ATT_STAGE();
        LDS_BAR();
        bf16x8 pf[8];
#pragma unroll
        for (int ks = 0; ks < 8; ++ks) pf[ks] = *(const bf16x8*)(PB + (wave * 16 + fr) * 264 + ks * 32 + fq * 8);
        const float rinv = RS[wave * 16 + fr];
#pragma unroll
        for (int half = 0; half < 2; ++half) {
            if (half == 0) ATT_LOAD(unit, 3); else ATT_LOAD(unext, 0);
#pragma unroll
            for (int db = 0; db < 8; ++db) {
                f32x4 a = (f32x4){0.f, 0.f, 0.f, 0.f};
#pragma unroll
                for (int ks = 0; ks < 8; ++ks) { const bf16x8 bfr = *(const bf16x8*)(KV + (db * 16 + fr) * 264 + ks * 32 + fq * 8); a = MFMA16(bfr, pf[ks], a); }
                u32x2 o; o.x = pk2(a[0] * rinv, a[1] * rinv); o.y = pk2(a[2] * rinv, a[3] * rinv);
                st_global_b64(mix + (t0 + wave * 16 + fr) * 3072 + 2048 + h * 256 + half * 128 + db * 16 + fq * 4, o);
            }
            LDS_BAR();
            if (half == 0) { ATT_STAGE(); LDS_BAR(); }
        }
    }
#undef ATT_UNIT
#undef ATT_SRC
#undef ATT_LOAD
#undef ATT_STAGE
    asm volatile("s_waitcnt vmcnt(0)" ::: "memory");
    __syncthreads();
}

__device__ __forceinline__ void gla_pre_phase(const Params& p, unsigned char* smem, bool dry = false) {
    bf16_t* qk = (bf16_t*)(p.ws + WS_QK);
    unsigned char* Gb = p.ws + WS_G;
    float* BC = (float*)smem;
    float* SEG = (float*)(smem + 32768);
    float* BL = (float*)(smem + 32768 + 2048);
    bf16_t* QD = (bf16_t*)(smem + 35328);
    bf16_t* KI = QD + 64 * 136;
    bf16_t* KET = KI + 64 * 136;
    bf16_t* ATT = KET + 128 * 72;
    int tid_ = threadIdx.x; asm volatile("" : "+v"(tid_));
    const int tid = tid_, w = tid >> 6, lane = tid & 63, fr = lane & 15, fq = lane >> 4;
    const int cd = tid & 127, seg = tid >> 7;
    const int es = tid >> 3, dseg = tid & 7;
    const int cb = w >> 1;
    for (int pu = blockIdx.x >> 3; pu < 512; pu += (int)(gridDim.x >> 3)) {
        const int h = pu & 3, bc = (int)(blockIdx.x & 7) * 128 + (pu >> 2);
        const size_t t0 = (size_t)bc * 64;
        const float* G = (const float*)Gb;
        float gpre[16];
#pragma unroll
        for (int i = 0; i < 16; ++i) gpre[i] = G[(t0 + seg * 16 + i) * 512 + h * 128 + cd];
        bf16_t* qp = qk + (t0 + es) * 1024 + h * 128 + dseg * 16;
        const u32x4 q0 = *(const u32x4*)qp, q1 = *(const u32x4*)(qp + 8), k0 = *(const u32x4*)(qp + 512), k1 = *(const u32x4*)(qp + 520);
        float run = 0.f;
#pragma unroll
        for (int i = 0; i < 16; ++i) { run += gpre[i]; gpre[i] = run; }
        SEG[seg * 128 + cd] = run;
        __syncthreads();
        {
            const float s0 = SEG[cd], s1 = SEG[128 + cd], s2 = SEG[256 + cd];
            const float off = (seg > 0 ? s0 : 0.f) + (seg > 1 ? s1 : 0.f) + (seg > 2 ? s2 : 0.f);
#pragma unroll
            for (int i = 0; i < 16; ++i) BC[(seg * 16 + i) * 128 + cd] = gpre[i] + off;
            if (seg == 3) BL[cd] = run + off;
        }
        __syncthreads();
        {
            float bc_[16], bl[16];
#pragma unroll
            for (int e4 = 0; e4 < 4; ++e4) {
                const f32x4 t1 = *(const f32x4*)(BC + es * 128 + dseg * 16 + e4 * 4); const f32x4 t2 = *(const f32x4*)(BL + dseg * 16 + e4 * 4);
                bc_[e4 * 4 + 0] = t1[0]; bc_[e4 * 4 + 1] = t1[1]; bc_[e4 * 4 + 2] = t1[2]; bc_[e4 * 4 + 3] = t1[3];
                bl[e4 * 4 + 0] = t2[0]; bl[e4 * 4 + 1] = t2[1]; bl[e4 * 4 + 2] = t2[2]; bl[e4 * 4 + 3] = t2[3];
            }
            const unsigned qw[8] = { q0.x, q0.y, q0.z, q0.w, q1.x, q1.y, q1.z, q1.w };
            const unsigned kw[8] = { k0.x, k0.y, k0.z, k0.w, k1.x, k1.y, k1.z, k1.w };
            unsigned qo[8], ko[8];
#pragma unroll
            for (int e2 = 0; e2 < 8; ++e2) {
                const float e1a = fexp(bc_[2 * e2]), e1b = fexp(bc_[2 * e2 + 1]);
                const float ia = frcp(e1a), ib = frcp(e1b);
                const float e3a = fexp(bl[2 * e2] - bc_[2 * e2]), e3b = fexp(bl[2 * e2 + 1] - bc_[2 * e2 + 1]);
                const float qa = bflo(qw[e2]), qb = bfhi(qw[e2]), ka = bflo(kw[e2]), kb = bfhi(kw[e2]);
                qo[e2] = pk2(qa * e1a, qb * e1b);
                ko[e2] = pk2(ka * ia, kb * ib);
                const unsigned ke = pk2(ka * e3a, kb * e3b);
                KET[(dseg * 16 + 2 * e2) * 72 + es] = (bf16_t)(ke & 0xffffu);
                KET[(dseg * 16 + 2 * e2 + 1) * 72 + es] = (bf16_t)(ke >> 16);
            }
            u32x4 t; t.x = qo[0]; t.y = qo[1]; t.z = qo[2]; t.w = qo[3]; *(u32x4*)(QD + es * 136 + dseg * 16) = t; if (!dry) *(u32x4*)qp = t;
            t.x = qo[4]; t.y = qo[5]; t.z = qo[6]; t.w = qo[7]; *(u32x4*)(QD + es * 136 + dseg * 16 + 8) = t; if (!dry) *(u32x4*)(qp + 8) = t;
            t.x = ko[0]; t.y = ko[1]; t.z = ko[2]; t.w = ko[3]; *(u32x4*)(KI + es * 136 + dseg * 16) = t;
            t.x = ko[4]; t.y = ko[5]; t.z = ko[6]; t.w = ko[7]; *(u32x4*)(KI + es * 136 + dseg * 16 + 8) = t;
        }
        __syncthreads();
#pragma unroll
        for (int n = 0; n < 2; ++n) {
            const int sb = (w & 1) * 2 + n;
            f32x4 a = (f32x4){0.f, 0.f, 0.f, 0.f};
            if (sb <= cb) {
#pragma unroll
                for (int ks = 0; ks < 4; ++ks) {
                    const bf16x8 af = *(const bf16x8*)(QD + (cb * 16 + fr) * 136 + ks * 32 + fq * 8);
                    const bf16x8 bfr = *(const bf16x8*)(KI + (sb * 16 + fr) * 136 + ks * 32 + fq * 8);
                    a = MFMA16(af, bfr, a);
                }
            }
#pragma unroll
            for (int jj = 0; jj < 4; ++jj) {
                const int cc = cb * 16 + fq * 4 + jj, ss = sb * 16 + fr;
                ATT[cc * 72 + ss] = bf1(ss <= cc ? a[jj] : 0.f);
            }
        }
        __syncthreads();
        unsigned char* gbase = Gb + ((t0 * 512) + (size_t)h * 128) * 4;
#pragma unroll
        for (int i = 0; i < 2; ++i) {
            const int idx = tid + i * 512, d = idx >> 3, pc = idx & 7;
            const u32x4 v = *(const u32x4*)(KET + d * 72 + pc * 8);
            if (!dry) *(u32x4*)(gbase + (size_t)(d >> 2) * 2048 + (d & 3) * 128 + pc * 16) = v;
        }
        {
            const int c = tid >> 3, pc = tid & 7;
            const u32x4 v = *(const u32x4*)(ATT + c * 72 + pc * 8);
            if (!dry) *(u32x4*)(gbase + (size_t)(32 + (c >> 2)) * 2048 + (c & 3) * 128 + pc * 16) = v;
        }
        if (tid < 128 && !dry) *(float*)(gbase + (size_t)48 * 2048 + tid * 4) = fexp(BL[tid]);
        __syncthreads();
    }
}

__device__ __forceinline__ void gla_phase(const Params& p, unsigned char* smem, bool dry = false) {
    const unsigned char* qkb = p.ws + WS_QK;
    const unsigned char* Gb = p.ws + WS_G;
    bf16_t* mix = (bf16_t*)(p.ws + WS_MIX);
    float* part = (float*)(p.ws + WS_PART);
    bf16_t* ST = (bf16_t*)smem;
    bf16_t* VT = ST + 64 * 136;
    constexpr int OPB = 26624, OPSZ = 41984, O_KET = 0, O_QD = 16384, O_ATT = 32768, O_DEC = 40960;
    LAS unsigned char* lds = (LAS unsigned char*)smem;
    int tid_ = threadIdx.x; asm volatile("" : "+v"(tid_));
    const int tid = tid_, w = __builtin_amdgcn_readfirstlane(tid >> 6), lane = tid & 63, fr = lane & 15, fq = lane >> 4;
    const int es = tid >> 3, dseg = tid & 7;
    const int cb = w >> 1, wh = w & 1;
    const int crow = cb * 16 + fr;
    unsigned koff[2], qoff[2], aoff, doff;
#pragma unroll
    for (int i = 0; i < 2; ++i) {
        const int P = (2 * w + i) * 64 + lane;
        { const int r = P >> 3, s_ = P & 7, q = s_ ^ (r & 7); koff[i] = (unsigned)((r >> 2) * 2048 + (r & 3) * 128 + q * 16); }
        { const int r = P >> 4, s_ = P & 15, q = s_ ^ (r & 15); qoff[i] = (unsigned)(r * 2048 + q * 16); }
    }
    { const int P = w * 64 + lane, r = P >> 3, s_ = P & 7, q = s_ ^ (r & 7); aoff = (unsigned)((32 + (r >> 2)) * 2048 + (r & 3) * 128 + q * 16); }
    doff = (unsigned)(48 * 2048 + (lane & 31) * 16);
    int r_att[2], r_qd[4], r_ket[4][2], r_dec[4];
#pragma unroll
    for (int ks = 0; ks < 2; ++ks) r_att[ks] = O_ATT + (crow * 8 + ((ks * 4 + fq) ^ (crow & 7))) * 16;
#pragma unroll
    for (int ks = 0; ks < 4; ++ks) r_qd[ks] = O_QD + (crow * 16 + ((ks * 4 + fq) ^ (crow & 15))) * 16;
#pragma unroll
    for (int n = 0; n < 4; ++n) { const int d = (wh * 4 + n) * 16 + fr; r_dec[n] = O_DEC + d * 4;
#pragma unroll
        for (int ks = 0; ks < 2; ++ks) r_ket[n][ks] = O_KET + (d * 8 + ((ks * 4 + fq) ^ (d & 7))) * 16; }
    for (int unit = blockIdx.x; unit < 256; unit += gridDim.x) {
        const int ux = unit & 7, uy = unit >> 3;
        const int bh = ux * 4 + (uy >> 3), sl = uy & 7, h = bh & 3, b = bh >> 2;
        const size_t tb = (size_t)b * SEQ_L;
        f32x4 st[4];
#pragma unroll
        for (int n = 0; n < 4; ++n) st[n] = (f32x4){0.f, 0.f, 0.f, 0.f};
        u32x4 vpre;
#define GLA_DMA(t1, bufoff) do { const unsigned char* gb_ = Gb + (((t1) * 512) + (size_t)h * 128) * 4; const unsigned char* qb_ = qkb + (((t1) * 1024) + (size_t)h * 128) * 2; \
            _Pragma("unroll") for (int i = 0; i < 2; ++i) { \
                __builtin_amdgcn_global_load_lds((const unsigned*)(gb_ + koff[i]), (LAS unsigned*)(lds + (bufoff) + O_KET + (2 * w + i) * 1024), 16, 0, 0); \
                __builtin_amdgcn_global_load_lds((const unsigned*)(qb_ + qoff[i]), (LAS unsigned*)(lds + (bufoff) + O_QD + (2 * w + i) * 1024), 16, 0, 0); } \
            __builtin_amdgcn_global_load_lds((const unsigned*)(gb_ + aoff), (LAS unsigned*)(lds + (bufoff) + O_ATT + w * 1024), 16, 0, 0); \
            if (w == 7) __builtin_amdgcn_global_load_lds((const unsigned*)(gb_ + doff), (LAS unsigned*)(lds + (bufoff) + O_DEC), 16, 0, 0); } while (0)
#define GLA_LOAD_V(t1) vpre = *(const u32x4*)(mix + ((t1) + es) * 3072 + h * 512 + sl * 64 + dseg * 8)
        __syncthreads();
        GLA_DMA(tb, OPB); GLA_LOAD_V(tb);
        u32x2 po[2]; po[0] = (u32x2){0u, 0u}; po[1] = (u32x2){0u, 0u}; float pssq = 0.f;
        for (int c = 0; c < 128; ++c) {
            const size_t t0 = tb + (size_t)c * 64;
            const size_t tn = tb + (size_t)(c < 127 ? c + 1 : 127) * 64;
            const size_t tp = tb + (size_t)(c > 0 ? c - 1 : 0) * 64;
            const int bcur = OPB + (c & 1) * OPSZ, bnxt = OPB + ((c & 1) ^ 1) * OPSZ;
            const unsigned char* OB = smem + bcur;
            {
                const unsigned vw[4] = { vpre.x, vpre.y, vpre.z, vpre.w };
#pragma unroll
                for (int e2 = 0; e2 < 4; ++e2) {
                    VT[(dseg * 8 + 2 * e2) * 72 + es] = (bf16_t)(vw[e2] & 0xffffu);
                    VT[(dseg * 8 + 2 * e2 + 1) * 72 + es] = (bf16_t)(vw[e2] >> 16);
                }
#pragma unroll
                for (int n = 0; n < 4; ++n) {
                    const int db = wh * 4 + n;
#pragma unroll
                    for (int jj = 0; jj < 4; ++jj) ST[(cb * 16 + fq * 4 + jj) * 136 + db * 16 + fr] = bf1(st[n][jj]);
                }
            }
            asm volatile("s_waitcnt vmcnt(0) lgkmcnt(0)" ::: "memory"); __builtin_amdgcn_s_barrier(); asm volatile("" ::: "memory");
            if (!(dry && (PROBE_ABL & 1))) { GLA_DMA(tn, bnxt); GLA_LOAD_V(tn); }
            {
                bf16_t* op = mix + (tp + crow) * 3072 + h * 512 + sl * 64 + wh * 32 + fq * 4;
                if (!dry) { st_global_b64(op, po[0]); st_global_b64(op + 16, po[1]);
                st_global_b32(part + ((tp + crow) * 4 + h) * 16 + sl * 2 + wh, pssq); }
            }
            {
                bf16x8 A_vt[2];
#pragma unroll
                for (int ks = 0; ks < 2; ++ks) A_vt[ks] = *(const bf16x8*)(VT + (cb * 16 + fr) * 72 + ks * 32 + fq * 8);
#pragma unroll
                for (int n = 0; n < 4; ++n) {
                    const float dcn = *(const float*)(OB + r_dec[n]);
                    st[n][0] *= dcn; st[n][1] *= dcn; st[n][2] *= dcn; st[n][3] *= dcn;
#pragma unroll
                    for (int ks = 0; ks < 2; ++ks) st[n] = MFMA16(A_vt[ks], *(const bf16x8*)(OB + r_ket[n][ks]), st[n]);
                }
            }
            {
                bf16x8 A_att[2], A_qd[4];
#pragma unroll
                for (int ks = 0; ks < 2; ++ks) A_att[ks] = *(const bf16x8*)(OB + r_att[ks]);
#pragma unroll
                for (int ks = 0; ks < 4; ++ks) A_qd[ks] = *(const bf16x8*)(OB + r_qd[ks]);
                float ssq = 0.f;
#pragma unroll
                for (int n = 0; n < 2; ++n) {
                    const int eb = wh * 2 + n;
                    f32x4 a = (f32x4){0.f, 0.f, 0.f, 0.f};
#pragma unroll
                    for (int ks = 0; ks < 2; ++ks) { const bf16x8 bfr = *(const bf16x8*)(VT + (eb * 16 + fr) * 72 + ks * 32 + fq * 8); a = MFMA16(bfr, A_att[ks], a); }
#pragma unroll
                    for (int ks = 0; ks < 4; ++ks) { const bf16x8 bfr = *(const bf16x8*)(ST + (eb * 16 + fr) * 136 + ks * 32 + fq * 8); a = MFMA16(bfr, A_qd[ks], a); }
                    po[n].x = pk2(a[0], a[1]); po[n].y = pk2(a[2], a[3]);
                    ssq += (a[0] * a[0] + a[1] * a[1]) + (a[2] * a[2] + a[3] * a[3]);
                }
                ssq += __shfl_xor(ssq, 16); ssq += __shfl_xor(ssq, 32); pssq = ssq;
            }
            LDS_BAR();
        }
        {
            const size_t t0 = tb + (size_t)127 * 64;
            bf16_t* op = mix + (t0 + crow) * 3072 + h * 512 + sl * 64 + wh * 32 + fq * 4;
            if (!dry) { st_global_b64(op, po[0]); st_global_b64(op + 16, po[1]);
            st_global_b32(part + ((t0 + crow) * 4 + h) * 16 + sl * 2 + wh, pssq); }
        }
        asm volatile("s_waitcnt vmcnt(0)" ::: "memory");
#undef GLA_DMA
#undef GLA_LOAD_V
        __syncthreads();
    }
}

#define S5_BAR() LDS_BAR()
__device__ __forceinline__ void s5_phase(const Params& p, int j, unsigned char* smem) {
    const bf16_t* mix = (const bf16_t*)(p.ws + WS_MIX);
    bf16_t* y5 = (bf16_t*)(p.ws + WS_QK);
    int tid_ = threadIdx.x; asm volatile("" : "+v"(tid_));
    const int tid = tid_, w = __builtin_amdgcn_readfirstlane(tid >> 6), lane = tid & 63, fr = lane & 15, fq = lane >> 4;
    const int wp = w & 3;
    float* BUF = (float*)(smem + wp * 25600);
    bf16_t* XB = (bf16_t*)(smem + wp * 25600 + 8448);
    for (int ub = blockIdx.x; ub < 256; ub += gridDim.x) {
        const int b = ub & 7, g = (ub >> 3) * 4 + wp;
        const int jg = j * 128 + g;
        const float lr = p.in[9][jg * 64 + lane], li = p.in[10][jg * 64 + lane];
        const float dt = __expf(p.in[11][jg]);
        const float mag = __expf(lr * dt);
        float rev = li * dt * 0.15915494309189535f; rev -= floorf(rev);
        const float ar = mag * __builtin_amdgcn_cosf(rev), ai = mag * __builtin_amdgcn_sinf(rev);
        const size_t tb0 = (size_t)b * SEQ_L;
        if (w < 4) {
            float xr = 0.f, xi = 0.f; const float nai = -ai;
            S5_BAR();
            for (int step2 = 0; step2 < 512; step2 += 2) {
#pragma unroll
                for (int k = 0; k < 2; ++k) {
                    const float* BUFc = BUF + k * 3200; bf16_t* XBc = XB + k * 6400;
                    f32x2 bu[16];
#pragma unroll
                    for (int t = 0; t < 16; ++t) bu[t] = *(const f32x2*)(BUFc + t * 132 + 2 * lane);
#pragma unroll
                    for (int t = 0; t < 16; ++t) {
                        const float t1 = fma_s(nai, xi, bu[t][0]);
                        const float t2 = fma_s(ai, xr, bu[t][1]);
                        const float nxr = fma_s(ar, xr, t1);
                        const float nxi = fma_s(ar, xi, t2);
                        xr = nxr; xi = nxi;
                        *(unsigned*)(XBc + t * 136 + 2 * lane) = pk2(xr, xi);
                    }
                    S5_BAR();
                }
            }
        } else {
            const float nr = ar - 1.f, ni = ai, den = lr * lr + li * li;
            const float cre = (nr * lr + ni * li) / den, cim = (ni * lr - nr * li) / den;
            bf16x8 bbf[8];
#pragma unroll
            for (int nb = 0; nb < 8; ++nb) {
                const int pp = nb * 8 + (fr >> 1);
                const float c_re = __shfl(cre, pp), c_im = __shfl(cim, pp);
                const int fqc = fq & 1;
                const float* br = p.in[12] + ((size_t)jg * 64 + pp) * 16 + fqc * 8;
                const float* bi = p.in[13] + ((size_t)jg * 64 + pp) * 16 + fqc * 8;
                const f32x4 br0 = *(const f32x4*)br, br1 = *(const f32x4*)(br + 4), bi0 = *(const f32x4*)bi, bi1 = *(const f32x4*)(bi + 4);
                float v[8];
#pragma unroll
                for (int e = 0; e < 4; ++e) {
                    v[e] = (fr & 1) ? (c_re * bi0[e] + c_im * br0[e]) : (c_re * br0[e] - c_im * bi0[e]);
                    v[4 + e] = (fr & 1) ? (c_re * bi1[e] + c_im * br1[e]) : (c_re * br1[e] - c_im * bi1[e]);
                }
                u32x4 t; t.x = pk2(v[0], v[1]); t.y = pk2(v[2], v[3]); t.z = pk2(v[4], v[5]); t.w = pk2(v[6], v[7]);
                if (fq >= 2) { t.x = 0u; t.y = 0u; t.z = 0u; t.w = 0u; }
                bbf[nb] = __builtin_bit_cast(bf16x8, t);
            }
            bf16x8 cf[4];
#pragma unroll
            for (int ks = 0; ks < 4; ++ks) {
                const int pb = ks * 16 + fq * 4;
                const f32x4 cr = *(const f32x4*)(p.in[14] + ((size_t)jg * 16 + fr) * 64 + pb);
                const f32x4 ci = *(const f32x4*)(p.in[15] + ((size_t)jg * 16 + fr) * 64 + pb);
                u32x4 t; t.x = pk2(cr[0], -ci[0]); t.y = pk2(cr[1], -ci[1]); t.z = pk2(cr[2], -ci[2]); t.w = pk2(cr[3], -ci[3]);
                cf[ks] = __builtin_bit_cast(bf16x8, t);
            }
            const f32x4 dv = *(const f32x4*)(p.in[16] + j * 2048 + g * 16 + fq * 4);
            const bf16_t* ubase = mix + (tb0 + fr) * 3072 + g * 16;
            bf16_t* ybase = y5 + (tb0 + fr) * 2048 + g * 16 + fq * 4;
            const bool pad = (fq >= 2);
            u32x4 ufq[4]; u32x2 uoq[4];
            {
                u32x4 uf0 = *(const u32x4*)(ubase + (fq & 1) * 8);
                if (pad) { uf0.x = 0u; uf0.y = 0u; uf0.z = 0u; uf0.w = 0u; }
                const bf16x8 uf = __builtin_bit_cast(bf16x8, uf0);
#pragma unroll
                for (int nb = 0; nb < 8; ++nb) { const f32x4 a = MFMA16(bbf[nb], uf, ((f32x4){0.f, 0.f, 0.f, 0.f})); *(f32x4*)(BUF + fr * 132 + nb * 16 + fq * 4) = a; }
#pragma unroll
                for (int q = 1; q <= 4; ++q) ufq[q & 3] = *(const u32x4*)(ubase + (size_t)q * 16 * 3072 + (fq & 1) * 8);
#pragma unroll
                for (int q = 0; q < 3; ++q) uoq[q] = *(const u32x2*)(ubase + (size_t)q * 16 * 3072 + fq * 4);
                uoq[3] = uoq[0];
                S5_BAR();
            }
            for (int step4 = 0; step4 < 512; step4 += 4) {
#pragma unroll
                for (int k = 0; k < 4; ++k) {
                    const int step = step4 + k;
                    const int cur = k & 1, nxt = cur ^ 1;
                    float* BUFn = BUF + nxt * 3200; const bf16_t* XBn = XB + nxt * 6400;
                    u32x4 ufc = ufq[(k + 1) & 3]; if (pad) { ufc.x = 0u; ufc.y = 0u; ufc.z = 0u; ufc.w = 0u; }
                    { const int s5 = (step + 5 < 512) ? step + 5 : 511; ufq[(k + 1) & 3] = *(const u32x4*)(ubase + (size_t)s5 * 16 * 3072 + (fq & 1) * 8); }
                    const bf16x8 uf = __builtin_bit_cast(bf16x8, ufc);
                    f32x4 ya = (f32x4){0.f, 0.f, 0.f, 0.f};
#pragma unroll
                    for (int ks = 0; ks < 4; ++ks) { const bf16x8 xf = *(const bf16x8*)(XBn + fr * 136 + ks * 32 + fq * 8); ya = MFMA16(cf[ks], xf, ya); }
#pragma unroll
                    for (int nb = 0; nb < 8; ++nb) { const f32x4 a = MFMA16(bbf[nb], uf, ((f32x4){0.f, 0.f, 0.f, 0.f})); *(f32x4*)(BUFn + fr * 132 + nb * 16 + fq * 4) = a; }
                    const u32x2 uo = uoq[(k + 3) & 3];
                    { const int s3 = (step + 3 < 512) ? step + 3 : 511; uoq[(k + 3) & 3] = *(const u32x2*)(ubase + (size_t)s3 * 16 * 3072 + fq * 4); }
                    if (step > 0) {
                        const float u0 = bflo(uo.x), u1 = bfhi(uo.x), u2 = bflo(uo.y), u3 = bfhi(uo.y);
                        float yv[4] = { ya[0] + dv[0] * u0, ya[1] + dv[1] * u1, ya[2] + dv[2] * u2, ya[3] + dv[3] * u3 };
#pragma unroll
                        for (int e = 0; e < 4; ++e) { const float v = yv[e]; const float z = 0.7978845608028654f * (v + 0.044715f * v * v * v); yv[e] = v * fsigmoid(2.f * z); }
                        u32x2 o; o.x = pk2(yv[0], yv[1]); o.y = pk2(yv[2], yv[3]);
                        st_global_b64(ybase + (size_t)(step - 1) * 16 * 2048, o);
                    }
                    S5_BAR();
                }
            }
            {
                const u32x2 uo = uoq[3];
                const bf16_t* XBn = XB + 6400;
                f32x4 ya = (f32x4){0.f, 0.f, 0.f, 0.f};
#pragma unroll
                for (int ks = 0; ks < 4; ++ks) { const bf16x8 xf = *(const bf16x8*)(XBn + fr * 136 + ks * 32 + fq * 8); ya = MFMA16(cf[ks], xf, ya); }
                const float u0 = bflo(uo.x), u1 = bfhi(uo.x), u2 = bflo(uo.y), u3 = bfhi(uo.y);
                float yv[4] = { ya[0] + dv[0] * u0, ya[1] + dv[1] * u1, ya[2] + dv[2] * u2, ya[3] + dv[3] * u3 };
#pragma unroll
                for (int e = 0; e < 4; ++e) { const float v = yv[e]; const float z = 0.7978845608028654f * (v + 0.044715f * v * v * v); yv[e] = v * fsigmoid(2.f * z); }
                u32x2 o; o.x = pk2(yv[0], yv[1]); o.y = pk2(yv[2], yv[3]);
                st_global_b64(ybase + (size_t)511 * 16 * 2048, o);
            }
        }
        __syncthreads();
    }
    __syncthreads();
}

enum { K_PREP = 0, K_KV, K_NORM, K_A1, K_MIX, K_GLU, K_A2, K_A3, K_FINAL, K_MIXB };
constexpr int N_PHASES = 25;
__device__ __forceinline__ void decode_phase(int ph, int& kind, int& layer) {
    if (ph == 0) { kind = K_PREP; layer = 0; return; }
    if (ph >= 24) { kind = K_FINAL; layer = 0; return; }
    int q;
    if (ph < 6) { layer = 0; q = ph; } else { const int q0 = ph - 6; layer = 1 + q0 / 6; q = q0 - (layer - 1) * 6; }
    if (layer & 1) kind = (q == 0) ? K_NORM : (q == 1) ? K_A1 : (q == 2) ? K_MIX : (q == 3) ? K_GLU : (q == 4) ? K_A2 : K_A3;
    else kind = (q == 0) ? K_NORM : (q == 1) ? K_A1 : (q == 2) ? K_MIX : (q == 3) ? K_MIXB : (q == 4) ? K_A2 : K_A3;
}

__device__ __forceinline__ void run_phase(const Params& p, int ph, unsigned char* smem) {
    int kind, layer; decode_phase(ph, kind, layer);
    const int j = layer >> 1; const bool is_gla = !(layer & 1);
    bf16_t* WT = (bf16_t*)(p.ws + WS_WT);
    bf16_t* H = (bf16_t*)(p.ws + WS_H);
    bf16_t* MIX = (bf16_t*)(p.ws + WS_MIX);
#ifndef NO_PREP
    if (kind == K_PREP) { prep_phase(p, smem); norm_phase(p, 0); return; }
#endif
    if (kind == K_NORM) { norm_phase(p, layer); return; }
    if (kind == K_FINAL) { rms_rows(p.out, p.in[21], nullptr, p.out, T_TOK, true); return; }
    if (kind == K_MIX) {
        if (is_gla) { if (PROBE_DUP & 2) { gla_pre_phase(p, smem, true); __syncthreads(); } gla_pre_phase(p, smem); } else s5_phase(p, j, smem);
        __syncthreads();
        attn_phase(p, layer, smem);
        return;
    }
    if (kind == K_MIXB) { if (PROBE_DUP & 1) { gla_phase(p, smem, true); __syncthreads(); } gla_phase(p, smem); return; }
    const bool withkv = (kind == K_A1 && layer == 0);
    const int ngemm = withkv ? 3 : 1;
    for (int q = 0; q < ngemm; ++q) {
        pg8::Gemm g; pg8::Epi E;
        E.mode = pg8::EM_BF16; E.o0 = nullptr; E.ld0 = 0; E.qk = nullptr; E.g = nullptr; E.gbias = nullptr; E.mix = MIX; E.part = nullptr; E.onw = nullptr; E.is_gla = 0;
        E.y5 = nullptr; E.bglu = nullptr; E.xin = nullptr; E.xout = nullptr;
        int ord_c = (int)blockIdx.x;
        if (withkv && q < 2) {
            if (q == 1) ord_c = (int)((blockIdx.x + gridDim.x / 2) % gridDim.x);
            if (q == 0) { g.A = (const bf16_t*)(p.ws + WS_MEMN); g.Bt = WT + WT_K_BASE; g.M = 2048; g.N = 4096; g.K = 1024; E.o0 = (bf16_t*)(p.ws + WS_KMEM); E.ld0 = 4096; }
            else { g.A = WT + WT_V_BASE; g.Bt = (const bf16_t*)(p.ws + WS_MEMN); g.M = 4096; g.N = 2048; g.K = 1024; E.o0 = (bf16_t*)(p.ws + WS_VT); E.ld0 = 2048; }
        } else if (kind == K_A1) {
            g.A = H; g.M = T_TOK; g.K = 1024;
            if (is_gla) { g.Bt = WT + j * WT_GLA_PER; g.N = 4608; E.mode = pg8::EM_A1GLA; E.qk = (bf16_t*)(p.ws + WS_QK); E.g = (float*)(p.ws + WS_G); E.gbias = p.in[6] + j * 512; }
            else { g.Bt = WT + WT_S5_BASE + j * WT_S5_PER; g.N = 3072; E.o0 = MIX; E.ld0 = 3072; }
        } else if (kind == K_A2) {
            g.A = H; g.M = T_TOK; g.K = 1024; g.N = 3072;
            g.Bt = is_gla ? (WT + j * WT_GLA_PER + WT_GLA_A2) : (WT + WT_S5_BASE + j * WT_S5_PER + WT_S5_A2);
            E.mode = pg8::EM_GATE; E.part = (const float*)(p.ws + WS_PART); E.onw = p.in[7] + j * 512; E.is_gla = is_gla ? 1 : 0;
        } else if (kind == K_GLU) {
            g.A = (const bf16_t*)(p.ws + WS_QK); g.M = T_TOK; g.K = 2048; g.N = 2048; g.Bt = WT + WT_S5_BASE + j * WT_S5_PER + WT_S5_GLU;
            E.mode = pg8::EM_GLU; E.y5 = (const bf16_t*)(p.ws + WS_QK); E.bglu = p.in[18] + j * 2048;
        } else {
            g.A = MIX; g.M = T_TOK; g.K = 3072; g.N = 1024; g.Bt = WT + WT_OUT_BASE + layer * WT_OUT_PER;
            E.mode = pg8::EM_RESID; E.xin = (layer == 0) ? p.in[0] : p.out; E.xout = p.out;
        }
        pg8::StaticOrder S; S.init(g.M, g.N, (int)gridDim.x, ord_c);
#ifndef NO_GEMM
        pg8::gemm_phase((LAS unsigned char*)smem, g, S, E);
#endif
        __syncthreads();
    }
}

__device__ __forceinline__ void grid_barrier(unsigned* ctr, unsigned target) {
    asm volatile("s_waitcnt vmcnt(0)" ::: "memory");
    __syncthreads();
    if (threadIdx.x == 0) {
        __builtin_amdgcn_fence(__ATOMIC_RELEASE, "agent");
        atomicAdd(ctr, 1u);
        while (__hip_atomic_load(ctr, __ATOMIC_RELAXED, __HIP_MEMORY_SCOPE_AGENT) < target) __builtin_amdgcn_s_sleep(1);
        __builtin_amdgcn_fence(__ATOMIC_ACQUIRE, "agent");
    }
    __syncthreads();
}

__global__ void __launch_bounds__(NTHREADS, 2) mega(Params p) {
    extern __shared__ __attribute__((aligned(16))) unsigned char smem[];
    cg::grid_group grid = cg::this_grid();
    unsigned* ctr = (unsigned*)(p.ws + WS_CTL);
    unsigned nbar = 0, ngrp = 0;
    for (int ph = p.ph_lo; ph < p.ph_hi; ++ph) {
        run_phase(p, ph, smem);
        if (ph + 1 < p.ph_hi) {
            if (ph == p.ph_lo) { asm volatile("s_waitcnt vmcnt(0)" ::: "memory"); __syncthreads(); grid.sync(); }
            else if (ph == 1 || (gridDim.x & 7) != 0) { ++nbar; grid_barrier(ctr, nbar * gridDim.x); }
            else { ++ngrp; grid_barrier(ctr + 16 * (1 + (blockIdx.x & 7)), ngrp * (gridDim.x >> 3)); }
        }
    }
}

extern "C" void kernel_launch(void* const* d_in, const int* in_sizes, int n_in, void* d_out, int out_size, void* d_ws, size_t ws_size, hipStream_t stream) {
    static int grid = 0;
    if (grid == 0) {
        if (n_in != 22 || out_size != T_TOK * DM || ws_size < WS_END) {
            fprintf(stderr, "kernel_launch: unexpected shapes: n_in %d out %d ws %zu (need %zu)\n", n_in, out_size, ws_size, (size_t)WS_END); grid = -1; return; }
        int dev = 0, cus = 0, per_cu = 0;
        if (hipGetDevice(&dev) != hipSuccess || hipDeviceGetAttribute(&cus, hipDeviceAttributeMultiprocessorCount, dev) != hipSuccess) { grid = -1; return; }
        if (hipFuncSetAttribute((const void*)mega, hipFuncAttributeMaxDynamicSharedMemorySize, LDS_BYTES) != hipSuccess) { fprintf(stderr, "kernel_launch: hipFuncSetAttribute failed\n"); grid = -1; return; }
        if (hipOccupancyMaxActiveBlocksPerMultiprocessor(&per_cu, (const void*)mega, NTHREADS, LDS_BYTES) != hipSuccess || per_cu < 1) { fprintf(stderr, "kernel_launch: occupancy query says %d\n", per_cu); per_cu = 1; }
        (void)hipGetLastError();
        grid = cus * 1;
    }
    if (grid < 0) return;
    if (hipMemsetAsync((char*)d_ws + WS_CTL, 0, 1024, stream) != hipSuccess) { fprintf(stderr, "kernel_launch: memset failed\n"); return; }
    Params p{};
    for (int i = 0; i < 22; ++i) p.in[i] = (const float*)d_in[i];
    p.out = (float*)d_out; p.ws = (unsigned char*)d_ws;
#if MK_COOP
    p.ph_lo = 0; p.ph_hi = N_PHASES;
    void* args[] = { &p };
    hipError_t e = hipLaunchCooperativeKernel((const void*)mega, dim3(grid), dim3(NTHREADS), args, LDS_BYTES, stream);
    if (e != hipSuccess) fprintf(stderr, "cooperative launch failed: %s (grid %d)\n", hipGetErrorString(e), grid);
#else
    for (int ph = 0; ph < N_PHASES; ++ph) {
        p.ph_lo = ph; p.ph_hi = ph + 1;
        hipLaunchKernelGGL(mega, dim3(grid), dim3(NTHREADS), LDS_BYTES, stream, p);
    }
#endif
}
```
